# Optimizing an MI355X kernel written in HIP

```python
import math
import jax
import jax.numpy as jnp
from jax import lax
import numpy as np

D_MODEL = 2048
BATCH = 4
SEQ = 2048
DEPTH = 1
DEC_BATCH = 128
DEC_SEQ = 1
PAST_LEN = 8192
PAGE_SIZE = 128

N_HEADS = 16
N_KV_HEADS = 4
HEAD_DIM = 64
Q_PER_KV = N_HEADS // N_KV_HEADS
D_ATTN = N_HEADS * HEAD_DIM
D_KV = N_KV_HEADS * HEAD_DIM
WINDOW = 128
SSD_HEADS = 32
SSD_HEAD_DIM = 64
D_SSD = SSD_HEADS * SSD_HEAD_DIM
SSD_GROUPS = 4
HEADS_PER_GROUP = SSD_HEADS // SSD_GROUPS
D_STATE = 128
SSD_CONV = 4
SSD_CHUNK = 128
CONV_DIM = D_SSD + 2 * SSD_GROUPS * D_STATE
D_MIX = D_ATTN + D_SSD
IN_SPLITS = (D_ATTN, D_ATTN + D_KV, D_ATTN + 2 * D_KV, D_ATTN + 2 * D_KV + D_SSD,
             D_ATTN + 2 * D_KV + D_SSD + CONV_DIM)
D_IN = D_ATTN + 2 * D_KV + D_SSD + CONV_DIM + SSD_HEADS
N_MEM = 256
MEM_HEADS = 4
MEM_HEAD_DIM = 128
D_XATTN = MEM_HEADS * MEM_HEAD_DIM
D_FF = 11 * D_MODEL // 4
FFN_CONV = 3
EPS = 1e-6

kernel_name = 'hymba_swa_ssd_memxattn_convffn_step'


def rms_norm(x, g):
    xf = x.astype(jnp.float32)
    y = xf * lax.rsqrt(jnp.mean(xf * xf, axis=-1, keepdims=True) + EPS)
    return (y * g.astype(jnp.float32)).astype(x.dtype)


def causal_dwconv(u, past, w, b):
    k, t = w.shape[0], u.shape[1]
    full = jnp.concatenate([past.astype(u.dtype), u], axis=1)
    out = sum((full[:, i:i + t] * w[i] for i in range(k)), b)
    return out, full[:, t:]


def sink_softmax(logits, mask, sink):
    logits = jnp.where(mask, logits, -jnp.inf)
    sink = jnp.broadcast_to(sink.astype(jnp.float32), logits.shape[:-1] + (1,))
    return jax.nn.softmax(jnp.concatenate([logits, sink], axis=-1), axis=-1)[..., :-1]


def swa_banded(q, k, v, sinks):
    b, t = q.shape[:2]
    nb = t // WINDOW
    qb = q.reshape(b, nb, WINDOW, N_KV_HEADS, Q_PER_KV, HEAD_DIM)

    def band(a):
        a = a.reshape(b, nb, WINDOW, N_KV_HEADS, HEAD_DIM)
        prev = jnp.concatenate([jnp.zeros_like(a[:, :1]), a[:, :-1]], axis=1)
        return jnp.concatenate([prev, a], axis=2)

    kk, vv = band(k), band(v)
    logits = jnp.einsum('bnqkgd,bnskd->bnkgqs', qb, kk,
                        preferred_element_type=jnp.float32) * HEAD_DIM ** -0.5
    qi = jnp.arange(WINDOW)[:, None]
    sj = jnp.arange(2 * WINDOW)[None, :]
    diff = qi + WINDOW - sj
    blk = jnp.arange(nb)[:, None, None]
    mask = ((diff >= 0) & (diff <= WINDOW))[None] & ((blk > 0) | (sj >= WINDOW)[None])
    p = sink_softmax(logits, mask[None, :, None, None],
                     sinks.reshape(1, 1, N_KV_HEADS, Q_PER_KV, 1, 1))
    o = jnp.einsum('bnkgqs,bnskd->bnqkgd', p.astype(v.dtype), vv)
    return o.reshape(b, t, D_ATTN)


def swa_step(q, k, v, k_buf, v_buf, sinks):
    b, t = q.shape[:2]
    w = k_buf.shape[1]
    kk = jnp.concatenate([k_buf.astype(k.dtype), k], axis=1)
    vv = jnp.concatenate([v_buf.astype(v.dtype), v], axis=1)
    qg = q.reshape(b, t, N_KV_HEADS, Q_PER_KV, HEAD_DIM)
    logits = jnp.einsum('bqkgd,bskd->bkgqs', qg, kk,
                        preferred_element_type=jnp.float32) * HEAD_DIM ** -0.5
    diff = jnp.arange(t)[:, None] + w - jnp.arange(w + t)[None, :]
    mask = (diff >= 0) & (diff <= WINDOW)
    p = sink_softmax(logits, mask, sinks.reshape(1, N_KV_HEADS, Q_PER_KV, 1, 1))
    o = jnp.einsum('bkgqs,bskd->bqkgd', p.astype(v.dtype), vv).reshape(b, t, D_ATTN)
    return o, kk[:, t:], vv[:, t:]


def ssd_scan(xs, dt, a, bm, cm, h0, chunk):
    b, t = xs.shape[:2]
    nc = t // chunk
    xs = xs.reshape(b, nc, chunk, *xs.shape[2:])
    dt = dt.reshape(b, nc, chunk, *dt.shape[2:])
    bm = bm.reshape(b, nc, chunk, *bm.shape[2:])
    cm = cm.reshape(b, nc, chunk, *cm.shape[2:])
    la = jnp.cumsum(dt * a, axis=2)
    xdt = xs * dt[..., None]
    causal = jnp.tril(jnp.ones((chunk, chunk), dtype=bool))[:, :, None, None]
    seg = la[:, :, :, None] - la[:, :, None, :]
    decay = jnp.exp(jnp.where(causal, seg, -jnp.inf))
    cb = jnp.einsum('bclgn,bcsgn->bclsg', cm, bm)
    y = jnp.einsum('bclsgh,bcsghp->bclghp', cb[..., None] * decay, xdt)
    decay_end = jnp.exp(la[:, :, -1:] - la)
    states = jnp.einsum('bcsgn,bcsghp->bcghpn', bm, xdt * decay_end[..., None])
    chunk_decay = jnp.exp(la[:, :, -1])

    def carry_step(h, inp):
        s_c, d_c = inp
        return h * d_c[..., None, None] + s_c, h

    h_last, h_prev = lax.scan(carry_step, h0,
                              (jnp.moveaxis(states, 1, 0), jnp.moveaxis(chunk_decay, 1, 0)))
    h_prev = jnp.moveaxis(h_prev, 0, 1)
    y = y + jnp.einsum('bclgn,bcghpn->bclghp', cm, h_prev) * jnp.exp(la)[..., None]
    return y.reshape(b, t, *y.shape[3:]), h_last


def ssd_mixer(z, xbc, dt_raw, conv_past, h0, conv_w, conv_b, dt_bias, a_log, d_skip, norm_g):
    b, t = z.shape[:2]
    xbc, conv_new = causal_dwconv(xbc, conv_past, conv_w, conv_b)
    xbc = jax.nn.silu(xbc.astype(jnp.float32))
    xs, bm, cm = jnp.split(xbc, (D_SSD, D_SSD + SSD_GROUPS * D_STATE), axis=-1)
    dt = jax.nn.softplus(dt_raw.astype(jnp.float32) + dt_bias.astype(jnp.float32))
    a = -jnp.exp(a_log.astype(jnp.float32))
    chunk = SSD_CHUNK if t % SSD_CHUNK == 0 else t
    xs = xs.reshape(b, t, SSD_GROUPS, HEADS_PER_GROUP, SSD_HEAD_DIM)
    y, h_last = ssd_scan(
        xs,
        dt.reshape(b, t, SSD_GROUPS, HEADS_PER_GROUP),
        a.reshape(SSD_GROUPS, HEADS_PER_GROUP),
        bm.reshape(b, t, SSD_GROUPS, D_STATE),
        cm.reshape(b, t, SSD_GROUPS, D_STATE),
        h0.astype(jnp.float32).reshape(b, SSD_GROUPS, HEADS_PER_GROUP, SSD_HEAD_DIM, D_STATE),
        chunk)
    y = y + xs * d_skip.astype(jnp.float32).reshape(SSD_GROUPS, HEADS_PER_GROUP, 1)
    y = y.reshape(b, t, D_SSD) * jax.nn.silu(z.astype(jnp.float32))
    y = rms_norm(y, norm_g).astype(z.dtype)
    h_last = h_last.reshape(b, SSD_HEADS, SSD_HEAD_DIM, D_STATE).astype(h0.dtype)
    return y, conv_new, h_last


def memory_kv(mem, g_mem, w_ck, w_cv, ck_norm_g):
    b, m = mem.shape[:2]
    h = rms_norm(mem, g_mem)
    k = rms_norm((h @ w_ck).reshape(b, m, MEM_HEADS, MEM_HEAD_DIM), ck_norm_g)
    v = (h @ w_cv).reshape(b, m, MEM_HEADS, MEM_HEAD_DIM)
    return k, v


def cross_attend(x, mem_k, mem_v, g_cross, w_cq, cq_norm_g, w_co):
    b, t = x.shape[:2]
    q = rms_norm((rms_norm(x, g_cross) @ w_cq).reshape(b, t, MEM_HEADS, MEM_HEAD_DIM), cq_norm_g)
    logits = jnp.einsum('bqhd,bshd->bhqs', q, mem_k.astype(q.dtype),
                        preferred_element_type=jnp.float32) * MEM_HEAD_DIM ** -0.5
    p = jax.nn.softmax(logits, axis=-1)
    o = jnp.einsum('bhqs,bshd->bqhd', p.astype(x.dtype), mem_v.astype(x.dtype))
    return o.reshape(b, t, D_XATTN) @ w_co


def conv_ffn(x, past, g_ffn, w_up, conv_w, conv_b, w_down):
    u, new_past = causal_dwconv(rms_norm(x, g_ffn) @ w_up, past, conv_w, conv_b)
    gate, val = jnp.split(u, 2, axis=-1)
    return (jax.nn.silu(gate) * val) @ w_down, new_past


def _layer(x, mem_k, mem_v, k_buf, v_buf, ssd_conv_past, ssd_h0, ffn_past, w):
    b, t = x.shape[:2]
    proj = rms_norm(x, w['g_mix']) @ w['w_in']
    q, k, v, z, xbc, dt_raw = jnp.split(proj, IN_SPLITS, axis=-1)
    q = rms_norm(q.reshape(b, t, N_HEADS, HEAD_DIM), w['q_norm_g'])
    k = rms_norm(k.reshape(b, t, N_KV_HEADS, HEAD_DIM), w['k_norm_g'])
    v = v.reshape(b, t, N_KV_HEADS, HEAD_DIM)
    if k_buf is None:
        attn = swa_banded(q, k, v, w['sinks'])
        new_k, new_v = k[:, -WINDOW:], v[:, -WINDOW:]
    else:
        attn, new_k, new_v = swa_step(q, k, v, k_buf, v_buf, w['sinks'])
    ssd, new_conv, new_h = ssd_mixer(z, xbc, dt_raw, ssd_conv_past, ssd_h0, w['ssd_conv_w'],
                                     w['ssd_conv_b'], w['dt_bias'], w['a_log'], w['d_skip'],
                                     w['ssd_norm_g'])
    x = x + jnp.concatenate([attn, ssd], axis=-1) @ w['w_out']
    x = x + cross_attend(x, mem_k, mem_v, w['g_cross'], w['w_cq'], w['cq_norm_g'], w['w_co'])
    f, new_ffn = conv_ffn(x, ffn_past, w['g_ffn'], w['w_up'], w['ffn_conv_w'], w['ffn_conv_b'],
                          w['w_down'])
    return x + f, (new_k, new_v, new_conv, new_h, new_ffn)


def setup_inputs(seed: int = 0) -> dict:
    key = jax.random.key(seed)
    keys = iter(jax.random.split(key, 48))
    L = DEPTH
    swa_buf = min(WINDOW, PAST_LEN)

    def nrm(shape, scale=1.0):
        return jax.random.normal(next(keys), shape, jnp.float32) * scale

    def gain(n):
        return 1.0 + nrm((L, n), 0.05)

    dt0 = jnp.exp(jax.random.uniform(next(keys), (L, SSD_HEADS), jnp.float32,
                                     math.log(1e-3), math.log(1e-1)))
    dt_bias = dt0 + jnp.log(-jnp.expm1(-dt0))
    a_log = jnp.log(jax.random.uniform(next(keys), (L, SSD_HEADS), jnp.float32, 1.0, 16.0))
    return {
        'x_prompt': nrm((BATCH, SEQ, D_MODEL)),
        'x_sample': nrm((DEC_BATCH, DEC_SEQ, D_MODEL)),
        'cache_swa_k': nrm((L, DEC_BATCH, swa_buf, N_KV_HEADS, HEAD_DIM)),
        'cache_swa_v': nrm((L, DEC_BATCH, swa_buf, N_KV_HEADS, HEAD_DIM)),
        'state_ssd_conv': nrm((L, DEC_BATCH, SSD_CONV - 1, CONV_DIM)),
        'state_ssd': nrm((L, DEC_BATCH, SSD_HEADS, SSD_HEAD_DIM, D_STATE), 0.5),
        'cache_mem_k': nrm((L, DEC_BATCH, N_MEM, MEM_HEADS, MEM_HEAD_DIM)),
        'cache_mem_v': nrm((L, DEC_BATCH, N_MEM, MEM_HEADS, MEM_HEAD_DIM)),
        'state_ffn_conv': nrm((L, DEC_BATCH, FFN_CONV - 1, 2 * D_FF)),
        'mem_prompt': nrm((BATCH, N_MEM, D_MODEL)),
        'g_mix': gain(D_MODEL),
        'w_in': nrm((L, D_MODEL, D_IN), D_MODEL ** -0.5),
        'q_norm_g': gain(HEAD_DIM),
        'k_norm_g': gain(HEAD_DIM),
        'sinks': nrm((L, N_HEADS)),
        'ssd_conv_w': nrm((L, SSD_CONV, CONV_DIM), SSD_CONV ** -0.5),
        'ssd_conv_b': nrm((L, CONV_DIM), 0.02),
        'dt_bias': dt_bias,
        'a_log': a_log,
        'd_skip': 1.0 + nrm((L, SSD_HEADS), 0.1),
        'ssd_norm_g': gain(D_SSD),
        'w_out': nrm((L, D_MIX, D_MODEL), D_MIX ** -0.5),
        'g_cross': gain(D_MODEL),
        'g_mem': gain(D_MODEL),
        'w_cq': nrm((L, D_MODEL, D_XATTN), D_MODEL ** -0.5),
        'w_ck': nrm((L, D_MODEL, D_XATTN), D_MODEL ** -0.5),
        'w_cv': nrm((L, D_MODEL, D_XATTN), D_MODEL ** -0.5),
        'cq_norm_g': gain(MEM_HEAD_DIM),
        'ck_norm_g': gain(MEM_HEAD_DIM),
        'w_co': nrm((L, D_XATTN, D_MODEL), D_XATTN ** -0.5),
        'g_ffn': gain(D_MODEL),
        'w_up': nrm((L, D_MODEL, 2 * D_FF), D_MODEL ** -0.5),
        'ffn_conv_w': nrm((L, FFN_CONV, 2 * D_FF), FFN_CONV ** -0.5),
        'ffn_conv_b': nrm((L, 2 * D_FF), 0.02),
        'w_down': nrm((L, D_FF, D_MODEL), D_FF ** -0.5),
    }


def reference(x_prompt, x_sample, cache_swa_k, cache_swa_v, state_ssd_conv, state_ssd,
              cache_mem_k, cache_mem_v, state_ffn_conv, mem_prompt,
              g_mix, w_in, q_norm_g, k_norm_g, sinks, ssd_conv_w, ssd_conv_b, dt_bias, a_log,
              d_skip, ssd_norm_g, w_out, g_cross, g_mem, w_cq, w_ck, w_cv, cq_norm_g, ck_norm_g,
              w_co, g_ffn, w_up, ffn_conv_w, ffn_conv_b, w_down):
    y_prompt, y_sample = x_prompt, x_sample
    bp = x_prompt.shape[0]
    new_p, new_s = [], []
    for l in range(DEPTH):
        w = dict(g_mix=g_mix[l], w_in=w_in[l], q_norm_g=q_norm_g[l], k_norm_g=k_norm_g[l],
                 sinks=sinks[l], ssd_conv_w=ssd_conv_w[l], ssd_conv_b=ssd_conv_b[l],
                 dt_bias=dt_bias[l], a_log=a_log[l], d_skip=d_skip[l], ssd_norm_g=ssd_norm_g[l],
                 w_out=w_out[l], g_cross=g_cross[l], w_cq=w_cq[l], cq_norm_g=cq_norm_g[l],
                 w_co=w_co[l], g_ffn=g_ffn[l], w_up=w_up[l], ffn_conv_w=ffn_conv_w[l],
                 ffn_conv_b=ffn_conv_b[l], w_down=w_down[l])
        mk_p, mv_p = memory_kv(mem_prompt, g_mem[l], w_ck[l], w_cv[l], ck_norm_g[l])
        dt_x = x_prompt.dtype
        y_prompt, st_p = _layer(
            y_prompt, mk_p, mv_p, None, None,
            jnp.zeros((bp, SSD_CONV - 1, CONV_DIM), dt_x),
            jnp.zeros((bp, SSD_HEADS, SSD_HEAD_DIM, D_STATE), dt_x),
            jnp.zeros((bp, FFN_CONV - 1, 2 * D_FF), dt_x), w)
        y_sample, st_s = _layer(
            y_sample, cache_mem_k[l], cache_mem_v[l], cache_swa_k[l], cache_swa_v[l],
            state_ssd_conv[l], state_ssd[l], state_ffn_conv[l], w)
        new_p.append(st_p + (mk_p, mv_p))
        new_s.append(st_s)
    (swa_k_prompt, swa_v_prompt, ssd_conv_prompt, ssd_state_prompt, ffn_conv_prompt,
     mem_k_prompt, mem_v_prompt) = [jnp.stack(a) for a in zip(*new_p)]
    (swa_k_sample, swa_v_sample, ssd_conv_sample, ssd_state_sample,
     ffn_conv_sample) = [jnp.stack(a) for a in zip(*new_s)]
    return (y_prompt, y_sample, swa_k_prompt, swa_v_prompt, swa_k_sample, swa_v_sample,
            ssd_conv_prompt, ssd_conv_sample, ssd_state_prompt, ssd_state_sample,
            mem_k_prompt, mem_v_prompt, ffn_conv_prompt, ffn_conv_sample)
```

```cpp
#include <hip/hip_runtime.h>
#include <hip/hip_cooperative_groups.h>
#include <cstdio>
#include <cstdint>
namespace cg = cooperative_groups;

#define DI __device__ __forceinline__
#define LAS __attribute__((address_space(3)))
typedef unsigned short bf16_t;
typedef short bf16x8 __attribute__((ext_vector_type(8)));
typedef short s16x4 __attribute__((ext_vector_type(4)));
typedef float f32x4 __attribute__((ext_vector_type(4)));
typedef float f32x2 __attribute__((ext_vector_type(2)));
typedef unsigned u32x4 __attribute__((ext_vector_type(4)));
typedef unsigned u32x2 __attribute__((ext_vector_type(2)));
typedef __bf16 bf16x2_t __attribute__((ext_vector_type(2)));

DI unsigned pk2(float lo, float hi) { f32x2 v = {lo, hi}; bf16x2_t b = __builtin_convertvector(v, bf16x2_t); return __builtin_bit_cast(unsigned, b); }
DI float bflo(unsigned w) { return __uint_as_float(w << 16); }
DI float bfhi(unsigned w) { return __uint_as_float(w & 0xffff0000u); }
DI float bf1(bf16_t h) { return __uint_as_float(((unsigned)h) << 16); }
DI bf16_t f2bf(float f) { return (bf16_t)(pk2(f, 0.f) & 0xffffu); }
DI void unpack8(u32x4 r, float* o) { o[0] = bflo(r.x); o[1] = bfhi(r.x); o[2] = bflo(r.y); o[3] = bfhi(r.y); o[4] = bflo(r.z); o[5] = bfhi(r.z); o[6] = bflo(r.w); o[7] = bfhi(r.w); }
DI float wave_sum(float v) {
#pragma unroll
    for (int o = 1; o < 64; o <<= 1) v += __shfl_xor(v, o);
    return v;
}
DI float wave_max(float v) {
#pragma unroll
    for (int o = 1; o < 64; o <<= 1) v = fmaxf(v, __shfl_xor(v, o));
    return v;
}
DI float silu_f(float x) { return x / (1.f + __expf(-x)); }
DI float softplus_f(float x) { return x > 20.f ? x : log1pf(__expf(x)); }
#define MFMA16(a, b, c) __builtin_amdgcn_mfma_f32_16x16x32_bf16((a), (b), (c), 0, 0, 0)
#define LDS_FENCE() asm volatile("s_waitcnt lgkmcnt(0)" ::: "memory")

constexpr int DM = 2048, MP = 8192, MS = 128, MTOK = MP + MS, MPAD = 8448, SEQ = 2048, NB = 4;
constexpr int DIN = 6688, DINP = 6912, DMIX = 3072, DXA = 512, DFF = 5632, DFF2 = 11264, CONVD = 3072;
constexpr int C_Q = 0, C_K = 1024, C_V = 1280, C_Z = 1536, C_XBC = 3584, C_DT = 6656;
constexpr float EPS = 1e-6f;
constexpr size_t O_Y = 0, O_YS = O_Y + (size_t)MP * DM, O_SKP = O_YS + (size_t)MS * DM, O_SVP = O_SKP + 131072, O_SKS = O_SVP + 131072,
    O_SVS = O_SKS + 4194304, O_SCP = O_SVS + 4194304, O_SCS = O_SCP + 36864, O_SSP = O_SCS + 1179648, O_SSS = O_SSP + 1048576,
    O_MKP = O_SSS + 33554432, O_MVP = O_MKP + 524288, O_FCP = O_MVP + 524288, O_FCS = O_FCP + 90112, O_END = O_FCS + 2883584;
constexpr size_t MiB = 1u << 20;
constexpr size_t WS_SSQ = 0;
constexpr size_t WS_WIN = 1 * MiB;
constexpr size_t WS_WOUT = WS_WIN + 27 * MiB;
constexpr size_t WS_WCQ = WS_WOUT + 12 * MiB;
constexpr size_t WS_WCKV = WS_WCQ + 2 * MiB;
constexpr size_t WS_WCO = WS_WCKV + 4 * MiB;
constexpr size_t WS_WUP = WS_WCO + 2 * MiB;
constexpr size_t WS_WDN = WS_WUP + 44 * MiB;
constexpr size_t WS_A0 = WS_WDN + 22 * MiB;
constexpr size_t WS_MEMN = WS_A0 + 33 * MiB;
constexpr size_t WS_X1 = WS_MEMN + 4 * MiB;
constexpr size_t WS_QC = WS_X1 + 66 * MiB;
constexpr size_t WS_OC = WS_QC + 9 * MiB;
constexpr size_t WS_DT = WS_OC + 9 * MiB;
constexpr size_t WS_H = WS_DT + 2 * MiB;
constexpr size_t WS_R1 = WS_H + 91 * MiB;
constexpr size_t WS_PROJ = WS_R1, WS_MIX = WS_R1 + 112 * MiB, WS_U = WS_R1;
constexpr size_t WS_END = WS_R1 + 182 * MiB;
constexpr int LDS_BYTES = 147456;

namespace pg8 {
constexpr int BM = 256, BK = 64, HALF = 128, HTB = HALF * BK * 2, STAGE_BYTES = 8 * HTB, NXCD = 8, WGM = 8;
__host__ __device__ __forceinline__ int lds_byte(int r, int c) { const int st = (r >> 4) * 2 + (c >> 5), rr = r & 15, cc = c & 31, ob = rr * 64 + cc * 2; return st * 1024 + (ob ^ (((ob >> 9) & 1) << 5)); }
__host__ __device__ __forceinline__ void stage_rc(int b, int& R, int& C) { const int st = b / 1024, sb = b % 1024, swz = sb ^ (((sb >> 9) & 1) << 5); R = (st >> 1) * 16 + swz / 64; C = (st & 1) * 32 + (swz % 64) / 2; }
__host__ __device__ __forceinline__ int perm32(int rho) { const int n = rho >> 4, i = rho & 15; return 8 * (i >> 2) + 4 * n + (i & 3); }
struct Unit { int pm, pn; };
struct Gemm { const bf16_t* A; const bf16_t* Bt; int M, N, K; };
struct StaticOrder {
    int nM, nN, nwg, G, c;
    __host__ __device__ void init(int M, int N, int G_, int c_) { nM = M / BM; nN = N / BM; nwg = nM * nN; G = G_; c = c_; }
    __host__ __device__ bool next(int i, Unit& u) const {
        const long L = (long)i * G + c; if (L >= nwg) return false;
        int wgid = (int)L; { const int q = nwg / NXCD, r = nwg % NXCD, xcd = wgid % NXCD, off = wgid / NXCD; wgid = (xcd < r ? xcd * (q + 1) : r * (q + 1) + (xcd - r) * q) + off; }
        const int nig = WGM * nN, gid = wgid / nig, fm = gid * WGM, gsz = (nM - fm) < WGM ? (nM - fm) : WGM;
        u.pm = fm + ((wgid % nig) % gsz); u.pn = (wgid % nig) / gsz; return true;
    }
};
template <class Epi, class Sched>
__device__ __forceinline__ void gemm_phase(LAS unsigned char* lds, const Gemm g, const Sched& S, const Epi& E) {
    const int tid = threadIdx.x, wid = __builtin_amdgcn_readfirstlane(tid >> 6), lane = tid & 63, wr = wid >> 2, wc = wid & 3, fr = lane & 15, fq = lane >> 4;
    const int K = g.K, nt = K / BK;
    unsigned voffA[2], voffB[2];
#pragma unroll
    for (int i = 0; i < 2; ++i) { int R, C; stage_rc(tid * 16 + i * 8192, R, C); const int Rb = Epi::PERM ? ((R & ~31) + perm32(R & 31)) : R;
        voffA[i] = (unsigned)(R * K + C) * 2u; voffB[i] = (unsigned)(Rb * K + C) * 2u; }
    const size_t kstep = (size_t)(BK * 2);
    const size_t hstep = (size_t)HALF * K * 2;
    const size_t tstep = 2 * hstep;
    const unsigned ldsw = (unsigned)wid * 1024u;
    const int aoff = lds_byte(wr * 64 + fr, fq * 8), boff = lds_byte(wc * 32 + fr, fq * 8);
#define PG8_SA(b, h) (((b) * 2 + (h)) * HTB)
#define PG8_SB(b, h) ((4 + (b) * 2 + (h)) * HTB)
#define PG8_STAGE(bufoff, gbase, voff) do { _Pragma("unroll") for (int _i = 0; _i < 2; ++_i) \
        __builtin_amdgcn_global_load_lds((const unsigned*)((const char*)(gbase) + (voff)[_i]), (LAS unsigned*)(lds + (bufoff) + ldsw + _i * 8192), 16, 0, 0); } while (0)
#define PG8_LDA(dst, b, h) do { _Pragma("unroll") for (int m = 0; m < 4; ++m) _Pragma("unroll") for (int k = 0; k < 2; ++k) dst[m][k] = *(const LAS bf16x8*)(lds + PG8_SA(b, h) + aoff + m * 2048 + k * 1024); } while (0)
#define PG8_LDB(dst, b, h) do { _Pragma("unroll") for (int n = 0; n < 2; ++n) _Pragma("unroll") for (int k = 0; k < 2; ++k) dst[n][k] = *(const LAS bf16x8*)(lds + PG8_SB(b, h) + boff + n * 2048 + k * 1024); } while (0)
#define PG8_MMA(ai, bj, At, Bt) do { __builtin_amdgcn_s_setprio(1); _Pragma("unroll") for (int m = 0; m < 4; ++m) _Pragma("unroll") for (int n = 0; n < 2; ++n) _Pragma("unroll") for (int k = 0; k < 2; ++k) \
        acc[ai][bj][m][n] = __builtin_amdgcn_mfma_f32_16x16x32_bf16(Bt[n][k], At[m][k], acc[ai][bj][m][n], 0, 0, 0); __builtin_amdgcn_s_setprio(0); } while (0)
#define PG8_WAIT_V(n) asm volatile("s_waitcnt vmcnt(" #n ")" ::: "memory")
#define PG8_WAIT_L(n) asm volatile("s_waitcnt lgkmcnt(" #n ")" ::: "memory")
#define PG8_BAR __builtin_amdgcn_s_barrier()
#define PG8_SCHED __builtin_amdgcn_sched_barrier(0)
    Unit cur, nxt; int ui = 0;
    if (!S.next(0, cur)) return;
    f32x4 acc[2][2][4][2];
#pragma unroll
    for (int a = 0; a < 2; ++a)
#pragma unroll
        for (int b = 0; b < 2; ++b)
#pragma unroll
            for (int m = 0; m < 4; ++m)
#pragma unroll
                for (int n = 0; n < 2; ++n) acc[a][b][m][n] = (f32x4){0.f, 0.f, 0.f, 0.f};
    bf16x8 At[4][2], B0[2][2], B1[2][2];
    const char* cA = (const char*)g.A + (size_t)cur.pm * tstep; const char* cB = (const char*)g.Bt + (size_t)cur.pn * tstep;
    PG8_STAGE(PG8_SB(0, 0), cB, voffB); PG8_STAGE(PG8_SB(0, 1), cB + hstep, voffB); PG8_STAGE(PG8_SA(0, 0), cA, voffA); PG8_STAGE(PG8_SA(0, 1), cA + hstep, voffA);
    if (wr == 1) PG8_BAR;
    PG8_WAIT_V(2); PG8_BAR;
    PG8_STAGE(PG8_SB(1, 0), cB + kstep, voffB); PG8_STAGE(PG8_SA(1, 0), cA + kstep, voffA); PG8_STAGE(PG8_SB(1, 1), cB + hstep + kstep, voffB);
    PG8_WAIT_V(6); PG8_BAR;
    for (;;) {
        const bool has_next = S.next(ui + 1, nxt);
        const char* nA = has_next ? (const char*)g.A + (size_t)nxt.pm * tstep : cA; const char* nB = has_next ? (const char*)g.Bt + (size_t)nxt.pn * tstep : cB;
        for (int t = 0; t < nt; t += 2) {
            const bool last = (t == nt - 2);
            const char* a1 = cA + (size_t)(t + 1) * kstep;
            const char* a2 = last ? nA : cA + (size_t)(t + 2) * kstep; const char* b2 = last ? nB : cB + (size_t)(t + 2) * kstep;
            const char* a3 = a2 + kstep; const char* b3 = b2 + kstep;
            if constexpr (Epi::MID) { if (t == E.tsplit) E.midscale(acc, cur, wr, fr); }
            PG8_LDB(B0, 0, 0); PG8_LDB(B1, 0, 1); PG8_SCHED; PG8_LDA(At, 0, 0); PG8_STAGE(PG8_SA(1, 1), a1 + hstep, voffA);
            PG8_WAIT_V(8); PG8_WAIT_L(0); PG8_BAR; PG8_MMA(0, 0, At, B0); PG8_MMA(0, 1, At, B1); PG8_BAR; PG8_SCHED;
            PG8_LDA(At, 0, 1); PG8_STAGE(PG8_SB(0, 0), b2, voffB); PG8_STAGE(PG8_SB(0, 1), b2 + hstep, voffB); PG8_STAGE(PG8_SA(0, 0), a2, voffA);
            PG8_WAIT_V(8); PG8_WAIT_L(0); PG8_BAR; PG8_MMA(1, 0, At, B0); PG8_MMA(1, 1, At, B1); PG8_BAR; PG8_SCHED;
            PG8_LDB(B0, 1, 0); PG8_LDB(B1, 1, 1); PG8_SCHED; PG8_LDA(At, 1, 0); PG8_STAGE(PG8_SA(0, 1), a2 + hstep, voffA);
            PG8_WAIT_V(8); PG8_WAIT_L(0); PG8_BAR; PG8_MMA(0, 0, At, B0); PG8_MMA(0, 1, At, B1); PG8_BAR; PG8_SCHED;
            PG8_LDA(At, 1, 1); PG8_STAGE(PG8_SB(1, 0), b3, voffB); PG8_STAGE(PG8_SB(1, 1), b3 + hstep, voffB); PG8_STAGE(PG8_SA(1, 0), a3, voffA);
            PG8_WAIT_V(8); PG8_WAIT_L(0); PG8_BAR; PG8_MMA(1, 0, At, B0); PG8_MMA(1, 1, At, B1); PG8_BAR; PG8_SCHED;
        }
        if (wr == 0) PG8_BAR;
        E(acc, cur, wr, wc, fr, fq);
        if (!has_next) break;
#pragma unroll
        for (int a = 0; a < 2; ++a)
#pragma unroll
            for (int b = 0; b < 2; ++b)
#pragma unroll
                for (int m = 0; m < 4; ++m)
#pragma unroll
                    for (int n = 0; n < 2; ++n) acc[a][b][m][n] = (f32x4){0.f, 0.f, 0.f, 0.f};
        cur = nxt; cA = nA; cB = nB; ++ui;
        if (wr == 1) PG8_BAR;
    }
    PG8_WAIT_V(0);
    PG8_BAR;
#undef PG8_SA
#undef PG8_SB
#undef PG8_STAGE
#undef PG8_LDA
#undef PG8_LDB
#undef PG8_MMA
#undef PG8_WAIT_V
#undef PG8_WAIT_L
#undef PG8_BAR
#undef PG8_SCHED
}
}
using pg8::Unit;
typedef f32x4 Acc[2][2][4][2];

struct EpiProj {
    static constexpr bool PERM = true, MID = false; bf16_t* O; float* dt; int tsplit;
    DI void midscale(Acc&, const Unit&, int, int) const {}
    DI void operator()(const Acc& acc, const Unit& u, int wr, int wc, int fr, int fq) const {
        const int row0 = u.pm * 256 + wr * 64 + fr, col0 = u.pn * 256 + wc * 32 + 8 * fq;
#pragma unroll
        for (int ai = 0; ai < 2; ++ai)
#pragma unroll
            for (int m = 0; m < 4; ++m) { const int row = row0 + ai * 128 + m * 16; bf16_t* rowp = O + (size_t)row * DINP + col0;
#pragma unroll
                for (int bj = 0; bj < 2; ++bj) { const f32x4 v0 = acc[ai][bj][m][0], v1 = acc[ai][bj][m][1]; u32x4 w; w.x = pk2(v0[0], v0[1]); w.y = pk2(v0[2], v0[3]); w.z = pk2(v1[0], v1[1]); w.w = pk2(v1[2], v1[3]);
                    *(u32x4*)(rowp + bj * 128) = w; }
                if (u.pn == 26 && wc == 0) { float* d = dt + (size_t)row * 32 + 8 * fq; *(f32x4*)d = acc[ai][0][m][0]; *(f32x4*)(d + 4) = acc[ai][0][m][1]; } }
    }
};
struct EpiMem {
    static constexpr bool PERM = false, MID = false; float* outK; float* outV; int tsplit;
    DI void midscale(Acc&, const Unit&, int, int) const {}
    DI void operator()(const Acc& acc, const Unit& u, int wr, int wc, int fr, int fq) const {
        float* base = (u.pn < 2) ? outK : outV; const int colt = (u.pn & 1) * 256 + wc * 32 + 4 * fq;
#pragma unroll
        for (int ai = 0; ai < 2; ++ai)
#pragma unroll
            for (int m = 0; m < 4; ++m) { const int row = u.pm * 256 + ai * 128 + wr * 64 + m * 16 + fr;
#pragma unroll
                for (int bj = 0; bj < 2; ++bj)
#pragma unroll
                    for (int n = 0; n < 2; ++n) *(f32x4*)(base + (size_t)row * 512 + colt + bj * 128 + n * 16) = acc[ai][bj][m][n]; }
    }
};
template <bool MIDS> struct EpiRes {
    static constexpr bool PERM = false, MID = MIDS;
    const float* baseP; const float* baseS; float* outP; float* outS; bf16_t* abf; float* ssq; const float* ssq_in; int tsplit;
    DI void midscale(Acc& acc, const Unit& u, int wr, int fr) const {
        int rbase = u.pm * 256 + wr * 64 + fr; asm volatile("" : "+v"(rbase));
#pragma unroll
        for (int ai = 0; ai < 2; ++ai)
#pragma unroll
            for (int m = 0; m < 4; ++m) { const int row = rbase + ai * 128 + m * 16; const float s = rsqrtf(ssq_in[row] * (1.f / 2048.f) + EPS);
#pragma unroll
                for (int bj = 0; bj < 2; ++bj)
#pragma unroll
                    for (int n = 0; n < 2; ++n) acc[ai][bj][m][n] = acc[ai][bj][m][n] * s; }
    }
    DI void operator()(const Acc& acc, const Unit& u, int wr, int wc, int fr, int fq) const {
        const int col0 = u.pn * 256 + wc * 32 + 4 * fq;
#pragma unroll
        for (int ai = 0; ai < 2; ++ai)
#pragma unroll
            for (int m = 0; m < 4; ++m) { const int row = u.pm * 256 + ai * 128 + wr * 64 + m * 16 + fr;
                if (row < MTOK) {
                    const float* bp = row < MP ? baseP + (size_t)row * DM : baseS + (size_t)(row - MP) * DM;
                    float* op = row < MP ? outP + (size_t)row * DM : outS + (size_t)(row - MP) * DM;
                    float sq = 0.f;
#pragma unroll
                    for (int bj = 0; bj < 2; ++bj)
#pragma unroll
                        for (int n = 0; n < 2; ++n) { const int c = col0 + bj * 128 + n * 16; const f32x4 o = *(const f32x4*)(bp + c) + acc[ai][bj][m][n]; *(f32x4*)(op + c) = o;
                            if (abf) { u32x2 w; w.x = pk2(o[0], o[1]); w.y = pk2(o[2], o[3]); *(u32x2*)(abf + (size_t)row * DM + c) = w; sq += (o[0] * o[0] + o[1] * o[1]) + (o[2] * o[2] + o[3] * o[3]); } }
                    if (abf) { sq += __shfl_xor(sq, 16); sq += __shfl_xor(sq, 32); if (fq == 0) atomicAdd(ssq + row, sq); }
                }
                asm volatile("" ::: "memory"); }
    }
};
struct EpiScale {
    static constexpr bool PERM = true, MID = false; bf16_t* O; int ldc; const float* ssq_in; int tsplit;
    DI void midscale(Acc&, const Unit&, int, int) const {}
    DI void operator()(const Acc& acc, const Unit& u, int wr, int wc, int fr, int fq) const {
        const int row0 = u.pm * 256 + wr * 64 + fr, col0 = u.pn * 256 + wc * 32 + 8 * fq;
#pragma unroll
        for (int ai = 0; ai < 2; ++ai)
#pragma unroll
            for (int m = 0; m < 4; ++m) { const int row = row0 + ai * 128 + m * 16; bf16_t* rowp = O + (size_t)row * ldc + col0; const float s = rsqrtf(ssq_in[row] * (1.f / 2048.f) + EPS);
#pragma unroll
                for (int bj = 0; bj < 2; ++bj) { const f32x4 v0 = acc[ai][bj][m][0] * s, v1 = acc[ai][bj][m][1] * s; u32x4 w; w.x = pk2(v0[0], v0[1]); w.y = pk2(v0[2], v0[3]); w.z = pk2(v1[0], v1[1]); w.w = pk2(v1[2], v1[3]);
                    *(u32x4*)(rowp + bj * 128) = w; } }
    }
};

struct Args { const float* in[35]; float* out; unsigned char* ws; int ph_lo, ph_hi; };
struct Ctx {
    LAS unsigned char* lds; int tid, lane, wave, G, bid;
    const float* const* in; float* out; unsigned char* ws;
};
#define IN_(i) (c.in[i])
enum { I_XP = 0, I_XS, I_CSK, I_CSV, I_SSC, I_SS, I_CMK, I_CMV, I_SFC, I_MEM, I_GMIX, I_WIN, I_QG, I_KG, I_SINK, I_SCW, I_SCB, I_DTB, I_ALOG, I_DSK, I_SNG, I_WOUT, I_GCR, I_GMEM, I_WCQ, I_WCK, I_WCV, I_CQG, I_CKG, I_WCO, I_GFFN, I_WUP, I_FCW, I_FCB, I_WDN };

DI void transpose_item(const float* W, int N, bf16_t* WT, int ldk, int ksrc0, int kdst0, int n0, int nrow_off, const float* gain, LAS float* scr, int lane) {
#pragma unroll 8
    for (int i = 0; i < 32; ++i) { const int kk = 2 * i + (lane >> 5); const float gg = gain ? gain[kk] : 1.f; scr[kk * 33 + (lane & 31)] = W[(size_t)(ksrc0 + kk) * N + n0 + (lane & 31)] * gg; }
    LDS_FENCE();
    const int cc = lane & 7;
#pragma unroll
    for (int j = 0; j < 4; ++j) { const int n = (lane >> 3) + 8 * j; const LAS float* s = scr + (8 * cc) * 33 + n;
        u32x4 o; o.x = pk2(s[0 * 33], s[1 * 33]); o.y = pk2(s[2 * 33], s[3 * 33]); o.z = pk2(s[4 * 33], s[5 * 33]); o.w = pk2(s[6 * 33], s[7 * 33]);
        *(u32x4*)(WT + (size_t)(nrow_off + n0 + n) * ldk + kdst0 + 8 * cc) = o; }
    LDS_FENCE();
}
DI void norm_row_to_bf16(const float* xrow, bf16_t* orow, int lane) {
    f32x4 v[8]; float s = 0.f;
    if (xrow) {
#pragma unroll
        for (int j = 0; j < 8; ++j) { v[j] = ((const f32x4*)xrow)[lane + 64 * j]; s += (v[j].x * v[j].x + v[j].y * v[j].y) + (v[j].z * v[j].z + v[j].w * v[j].w); }
    } else {
#pragma unroll
        for (int j = 0; j < 8; ++j) v[j] = (f32x4){0.f, 0.f, 0.f, 0.f};
    }
    const float rs = rsqrtf(wave_sum(s) * (1.f / 2048.f) + EPS);
#pragma unroll
    for (int j = 0; j < 8; ++j) { u32x2 w; w.x = pk2(v[j].x * rs, v[j].y * rs); w.y = pk2(v[j].z * rs, v[j].w * rs); ((u32x2*)orow)[lane + 64 * j] = w; }
}
DI void p0_prologue(const Ctx& c) {
    LAS float* scr = (LAS float*)(c.lds + c.wave * 16384);
    const int gw = c.bid * 8 + c.wave, NGW = c.G * 8, lane = c.lane;
    bf16_t* WINT = (bf16_t*)(c.ws + WS_WIN); bf16_t* WOUTT = (bf16_t*)(c.ws + WS_WOUT); bf16_t* WCQT = (bf16_t*)(c.ws + WS_WCQ); bf16_t* WCKVT = (bf16_t*)(c.ws + WS_WCKV);
    bf16_t* WCOT = (bf16_t*)(c.ws + WS_WCO); bf16_t* WUPT = (bf16_t*)(c.ws + WS_WUP); bf16_t* WDNT = (bf16_t*)(c.ws + WS_WDN);
    constexpr int I0 = 32 * 209, I1 = 48 * 64, I2 = 32 * 16, I3 = I2, I4 = I2, I5 = 8 * 64, I6 = 32 * 352, I7 = 88 * 64;
    constexpr int NITEMS = I0 + I1 + I2 + I3 + I4 + I5 + I6 + I7;
    for (int it = gw; it < NITEMS; it += NGW) {
        int r = it;
        if (r < I0) { const int kb = r / 209, nb = r % 209; transpose_item(IN_(I_WIN), DIN, WINT, 2048, kb * 64, kb * 64, nb * 32, 0, IN_(I_GMIX) + kb * 64, scr, lane); continue; } r -= I0;
        if (r < I1) { const int kb = r / 64, nb = r % 64; const int ks = kb * 64; const bool ssd = ks >= 1024;
            transpose_item(IN_(I_WOUT), 2048, WOUTT, 3072, ks, ssd ? ks - 1024 : ks + 2048, nb * 32, 0, ssd ? IN_(I_SNG) + (ks - 1024) : nullptr, scr, lane); continue; } r -= I1;
        if (r < I2) { const int kb = r / 16, nb = r % 16; transpose_item(IN_(I_WCQ), 512, WCQT, 2048, kb * 64, kb * 64, nb * 32, 0, IN_(I_GCR) + kb * 64, scr, lane); continue; } r -= I2;
        if (r < I3) { const int kb = r / 16, nb = r % 16; transpose_item(IN_(I_WCK), 512, WCKVT, 2048, kb * 64, kb * 64, nb * 32, 0, IN_(I_GMEM) + kb * 64, scr, lane); continue; } r -= I3;
        if (r < I4) { const int kb = r / 16, nb = r % 16; transpose_item(IN_(I_WCV), 512, WCKVT, 2048, kb * 64, kb * 64, nb * 32, 512, IN_(I_GMEM) + kb * 64, scr, lane); continue; } r -= I4;
        if (r < I5) { const int kb = r / 64, nb = r % 64; transpose_item(IN_(I_WCO), 2048, WCOT, 512, kb * 64, kb * 64, nb * 32, 0, nullptr, scr, lane); continue; } r -= I5;
        if (r < I6) { const int kb = r / 352, nb = r % 352; transpose_item(IN_(I_WUP), DFF2, WUPT, 2048, kb * 64, kb * 64, nb * 32, 0, IN_(I_GFFN) + kb * 64, scr, lane); continue; } r -= I6;
        { const int kb = r / 64, nb = r % 64; transpose_item(IN_(I_WDN), 2048, WDNT, DFF, kb * 64, kb * 64, nb * 32, 0, nullptr, scr, lane); }
    }
    { u32x4* z = (u32x4*)(WINT + (size_t)DIN * 2048); const int n16 = (DINP - DIN) * 2048 * 2 / 16;
        for (int i = c.bid * 512 + c.tid; i < n16; i += c.G * 512) z[i] = (u32x4){0u, 0u, 0u, 0u}; }
    { float* z = (float*)(c.ws + WS_SSQ); for (int i = c.bid * 512 + c.tid; i < 3 * MPAD; i += c.G * 512) z[i] = 0.f; }
    bf16_t* A0 = (bf16_t*)(c.ws + WS_A0); bf16_t* MEMN = (bf16_t*)(c.ws + WS_MEMN);
    for (int m = gw; m < MPAD + 1024; m += NGW) {
        if (m < MPAD) { const float* xr = m < MP ? IN_(I_XP) + (size_t)m * DM : (m < MTOK ? IN_(I_XS) + (size_t)(m - MP) * DM : nullptr); norm_row_to_bf16(xr, A0 + (size_t)m * DM, lane); }
        else { const int r = m - MPAD; norm_row_to_bf16(IN_(I_MEM) + (size_t)r * DM, MEMN + (size_t)r * DM, lane); }
    }
}

constexpr int SP = 136;
DI void conv_load_w(const float* cw, const float* cb, int cch, float (&w)[4][8], float (&bias)[8]) {
#pragma unroll
    for (int i = 0; i < 4; ++i) { const f32x4 a = *(const f32x4*)(cw + (size_t)i * CONVD + cch), b = *(const f32x4*)(cw + (size_t)i * CONVD + cch + 4);
        w[i][0] = a.x; w[i][1] = a.y; w[i][2] = a.z; w[i][3] = a.w; w[i][4] = b.x; w[i][5] = b.y; w[i][6] = b.z; w[i][7] = b.w; }
    const f32x4 a = *(const f32x4*)(cb + cch), b = *(const f32x4*)(cb + cch + 4);
    bias[0] = a.x; bias[1] = a.y; bias[2] = a.z; bias[3] = a.w; bias[4] = b.x; bias[5] = b.y; bias[6] = b.z; bias[7] = b.w;
}
DI void conv8(const bf16_t* p, int tloc, const float (&w)[4][8], const float (&bias)[8], float (&o)[8]) {
#pragma unroll
    for (int j = 0; j < 8; ++j) o[j] = bias[j];
#pragma unroll
    for (int i = 0; i < 4; ++i) { const int back = (3 - i) < tloc ? (3 - i) : tloc; const float msk = (tloc - 3 + i >= 0) ? 1.f : 0.f;
        const u32x4 r = *(const u32x4*)(p - (ptrdiff_t)back * DINP); float f[8]; unpack8(r, f);
#pragma unroll
        for (int j = 0; j < 8; ++j) o[j] += w[i][j] * (f[j] * msk); }
#pragma unroll
    for (int j = 0; j < 8; ++j) o[j] = silu_f(o[j]);
}
DI void ssd_prompt_unit(const Ctx& c, int unit) {
    const int b = unit >> 6, h = (unit >> 1) & 31, ph = unit & 1, g = h >> 3;
    int tid_ = c.tid; asm volatile("" : "+v"(tid_)); const int tid = tid_, lane = tid & 63, w = __builtin_amdgcn_readfirstlane(tid >> 6), fr = lane & 15, fq = lane >> 4;
    LAS bf16_t* Cs = (LAS bf16_t*)(c.lds); LAS bf16_t* Bs = (LAS bf16_t*)(c.lds + 34816); LAS bf16_t* BtT = (LAS bf16_t*)(c.lds + 69632);
    LAS bf16_t* Xt = (LAS bf16_t*)(c.lds + 104448); LAS bf16_t* Hb = (LAS bf16_t*)(c.lds + 113152);
    LAS float* dts = (LAS float*)(c.lds + 121856); LAS float* las = (LAS float*)(c.lds + 122368);
    const bf16_t* PROJ = (const bf16_t*)(c.ws + WS_PROJ); const float* DTR = (const float*)(c.ws + WS_DT);
    bf16_t* MIX = (bf16_t*)(c.ws + WS_MIX); float* SSQS = (float*)(c.ws + WS_SSQ);
    const float av = -__expf(IN_(I_ALOG)[h]), dtb = IN_(I_DTB)[h], Dh = IN_(I_DSK)[h];
    const float* cw = IN_(I_SCW); const float* cbias = IN_(I_SCB);
    f32x4 st[2] = {(f32x4){0.f, 0.f, 0.f, 0.f}, (f32x4){0.f, 0.f, 0.f, 0.f}};
    for (int i = tid; i < 32 * SP / 2; i += 512) ((LAS unsigned*)Hb)[i] = 0u;
    for (int ck = 0; ck < 16; ++ck) {
        const int t0 = ck * 128; const size_t row0 = (size_t)b * SEQ + t0;
        if (tid < 128) dts[tid] = softplus_f(DTR[(row0 + tid) * 32 + h] + dtb);
        {
            const int s = tid >> 2, c8 = tid & 3, cch = h * 64 + ph * 32 + c8 * 8; float wv[4][8], bias[8], o[8];
            conv_load_w(cw, cbias, cch, wv, bias);
            conv8(PROJ + (row0 + s) * DINP + C_XBC + cch, t0 + s, wv, bias, o);
#pragma unroll
            for (int j = 0; j < 8; ++j) Xt[(c8 * 8 + j) * SP + s] = f2bf(o[j]);
        }
        u32x4 bq[4];
        {
            const int c8 = tid & 15, s0 = tid >> 4; float wv[4][8], bias[8], o[8];
            int cch = 2048 + g * 128 + c8 * 8; conv_load_w(cw, cbias, cch, wv, bias);
#pragma unroll
            for (int i = 0; i < 4; ++i) { asm volatile("" ::: "memory"); const int s = s0 + 32 * i; conv8(PROJ + (row0 + s) * DINP + C_XBC + cch, t0 + s, wv, bias, o);
                u32x4 q; q.x = pk2(o[0], o[1]); q.y = pk2(o[2], o[3]); q.z = pk2(o[4], o[5]); q.w = pk2(o[6], o[7]); bq[i] = q; *(LAS u32x4*)(Bs + s * SP + c8 * 8) = q; }
            asm volatile("" ::: "memory");
            cch = 2560 + g * 128 + c8 * 8; conv_load_w(cw, cbias, cch, wv, bias);
#pragma unroll 1
            for (int i = 0; i < 4; ++i) { const int s = s0 + 32 * i; conv8(PROJ + (row0 + s) * DINP + C_XBC + cch, t0 + s, wv, bias, o);
                u32x4 q; q.x = pk2(o[0], o[1]); q.y = pk2(o[2], o[3]); q.z = pk2(o[4], o[5]); q.w = pk2(o[6], o[7]); *(LAS u32x4*)(Cs + s * SP + c8 * 8) = q; }
        }
        __syncthreads();
        if (tid < 128) { float a = 0.f; for (int i = 0; i <= tid; ++i) a += dts[i]; las[tid] = a * av; }
        __syncthreads();
        {
            const int c8 = tid & 15, s0 = tid >> 4; const float le = las[127];
#pragma unroll
            for (int i = 0; i < 4; ++i) { const int s = s0 + 32 * i; const float sc = __expf(le - las[s]) * dts[s]; float f[8]; unpack8(bq[i], f);
#pragma unroll
                for (int j = 0; j < 8; ++j) BtT[(c8 * 8 + j) * SP + s] = f2bf(f[j] * sc); }
        }
        __syncthreads();
        const int l = 16 * w + fr; const float la_l = las[l];
        f32x4 cbm[8];
#pragma unroll
        for (int ni = 0; ni < 8; ++ni) cbm[ni] = (f32x4){0.f, 0.f, 0.f, 0.f};
#pragma unroll
        for (int kk = 0; kk < 4; ++kk) { __builtin_amdgcn_sched_barrier(0); const bf16x8 af = *(const LAS bf16x8*)(Cs + l * SP + kk * 32 + fq * 8);
#pragma unroll
            for (int ni = 0; ni < 8; ++ni) { const bf16x8 bf = *(const LAS bf16x8*)(Bs + (16 * ni + fr) * SP + kk * 32 + fq * 8); cbm[ni] = MFMA16(bf, af, cbm[ni]); } }
        int lim = l - 4 * fq; asm volatile("" : "+v"(lim));
#pragma unroll
        for (int ni = 0; ni < 8; ++ni) { const int s = 16 * ni + 4 * fq; const f32x4 ls = *(const LAS f32x4*)(las + s), ds = *(const LAS f32x4*)(dts + s);
#pragma unroll
            for (int j = 0; j < 4; ++j) cbm[ni][j] = (16 * ni + j <= lim) ? cbm[ni][j] * __expf(la_l - ls[j]) * ds[j] : 0.f; }
        f32x4 y[2] = {(f32x4){0.f, 0.f, 0.f, 0.f}, (f32x4){0.f, 0.f, 0.f, 0.f}}, yi[2] = {(f32x4){0.f, 0.f, 0.f, 0.f}, (f32x4){0.f, 0.f, 0.f, 0.f}};
#pragma unroll
        for (int k2 = 0; k2 < 4; ++k2) { __builtin_amdgcn_sched_barrier(0); u32x4 pa; pa.x = pk2(cbm[2 * k2][0], cbm[2 * k2][1]); pa.y = pk2(cbm[2 * k2][2], cbm[2 * k2][3]); pa.z = pk2(cbm[2 * k2 + 1][0], cbm[2 * k2 + 1][1]); pa.w = pk2(cbm[2 * k2 + 1][2], cbm[2 * k2 + 1][3]);
            const bf16x8 af = __builtin_bit_cast(bf16x8, pa);
#pragma unroll
            for (int np = 0; np < 2; ++np) { const s16x4 lo = *(const LAS s16x4*)(Xt + (16 * np + fr) * SP + 32 * k2 + 4 * fq), hi = *(const LAS s16x4*)(Xt + (16 * np + fr) * SP + 32 * k2 + 16 + 4 * fq);
                const bf16x8 bf = __builtin_shufflevector(lo, hi, 0, 1, 2, 3, 4, 5, 6, 7); y[np] = MFMA16(bf, af, y[np]); } }
#pragma unroll
        for (int kk = 0; kk < 4; ++kk) { const bf16x8 af = *(const LAS bf16x8*)(Cs + l * SP + kk * 32 + fq * 8);
#pragma unroll
            for (int np = 0; np < 2; ++np) { const bf16x8 bf = *(const LAS bf16x8*)(Hb + (16 * np + fr) * SP + kk * 32 + fq * 8); yi[np] = MFMA16(bf, af, yi[np]); } }
        {
            const float el = __expf(la_l); const size_t row = row0 + l; float sq = 0.f;
#pragma unroll
            for (int np = 0; np < 2; ++np) { const int p0 = 16 * np + 4 * fq; const u32x2 zr = *(const u32x2*)(PROJ + row * DINP + C_Z + h * 64 + ph * 32 + p0);
                const float zf[4] = {bflo(zr.x), bfhi(zr.x), bflo(zr.y), bfhi(zr.y)}; float o[4];
#pragma unroll
                for (int j = 0; j < 4; ++j) { const float xv = bf1(Xt[(p0 + j) * SP + l]); float v = y[np][j] + el * yi[np][j] + Dh * xv; v *= silu_f(zf[j]); o[j] = v; sq += v * v; }
                u32x2 wv; wv.x = pk2(o[0], o[1]); wv.y = pk2(o[2], o[3]); *(u32x2*)(MIX + row * DMIX + h * 64 + ph * 32 + p0) = wv; }
            sq += __shfl_xor(sq, 16); sq += __shfl_xor(sq, 32); if (fq == 0) atomicAdd(SSQS + row, sq);
        }
        {
            f32x4 sa[2] = {(f32x4){0.f, 0.f, 0.f, 0.f}, (f32x4){0.f, 0.f, 0.f, 0.f}};
#pragma unroll
            for (int kk = 0; kk < 4; ++kk) { const bf16x8 bf = *(const LAS bf16x8*)(BtT + (16 * w + fr) * SP + kk * 32 + fq * 8);
#pragma unroll
                for (int mi = 0; mi < 2; ++mi) { const bf16x8 af = *(const LAS bf16x8*)(Xt + (16 * mi + fr) * SP + kk * 32 + fq * 8); sa[mi] = MFMA16(bf, af, sa[mi]); } }
            const float ee = __expf(las[127]);
#pragma unroll
            for (int mi = 0; mi < 2; ++mi) st[mi] = st[mi] * ee + sa[mi];
        }
        __syncthreads();
#pragma unroll
        for (int mi = 0; mi < 2; ++mi) { u32x2 wv; wv.x = pk2(st[mi][0], st[mi][1]); wv.y = pk2(st[mi][2], st[mi][3]); *(LAS u32x2*)(Hb + (16 * mi + fr) * SP + 16 * w + 4 * fq) = wv; }
    }
    float* so = c.out + O_SSP;
#pragma unroll
    for (int mi = 0; mi < 2; ++mi) *(f32x4*)(so + ((size_t)(b * 32 + h) * 64 + ph * 32 + 16 * mi + fr) * 128 + 16 * w + 4 * fq) = st[mi];
    __syncthreads();
}

DI void swa_prompt_unit(const Ctx& c, int unit) {
    const int b = unit >> 6, blk = (unit >> 2) & 15, kvh = unit & 3;
    int tid_ = c.tid; asm volatile("" : "+v"(tid_)); const int tid = tid_, lane = tid & 63, w = __builtin_amdgcn_readfirstlane(tid >> 6), fr = lane & 15, fq = lane >> 4;
    constexpr int KP = 72, VP = 264;
    LAS bf16_t* Ks = (LAS bf16_t*)(c.lds); LAS bf16_t* Vt = (LAS bf16_t*)(c.lds + 36864);
    const bf16_t* PROJ = (const bf16_t*)(c.ws + WS_PROJ); bf16_t* MIX = (bf16_t*)(c.ws + WS_MIX);
    {
        const int key = tid >> 1, half = tid & 1, tk = blk * 128 - 128 + key;
        const bf16_t* pr = PROJ + ((size_t)b * SEQ + (tk >= 0 ? tk : 0)) * DINP;
        const bool wout = (blk == 15 && key >= 128);
        unsigned ooff = (unsigned)(((b * 128 + (key & 127)) * 4 + kvh) * 64 + half * 32); asm volatile("" : "+v"(ooff));
        {
            float kf[32]; float sq = 0.f;
#pragma unroll
            for (int i = 0; i < 4; ++i) unpack8(*(const u32x4*)(pr + C_K + kvh * 64 + half * 32 + i * 8), kf + 8 * i);
#pragma unroll
            for (int i = 0; i < 32; ++i) sq += kf[i] * kf[i];
            sq += __shfl_xor(sq, 1); const float rs = (tk >= 0) ? rsqrtf(sq * (1.f / 64.f) + EPS) : 0.f; const float* kg = IN_(I_KG) + half * 32;
#pragma unroll
            for (int i = 0; i < 4; ++i) { const f32x4 g0 = *(const f32x4*)(kg + 8 * i), g1 = *(const f32x4*)(kg + 8 * i + 4);
                const f32x4 k0 = (f32x4){kf[8 * i], kf[8 * i + 1], kf[8 * i + 2], kf[8 * i + 3]} * g0 * rs, k1 = (f32x4){kf[8 * i + 4], kf[8 * i + 5], kf[8 * i + 6], kf[8 * i + 7]} * g1 * rs;
                u32x4 q; q.x = pk2(k0[0], k0[1]); q.y = pk2(k0[2], k0[3]); q.z = pk2(k1[0], k1[1]); q.w = pk2(k1[2], k1[3]);
                *(LAS u32x4*)(Ks + key * KP + half * 32 + i * 8) = q;
                if (wout) { float* ok = c.out + O_SKP + ooff; *(f32x4*)(ok + 8 * i) = k0; *(f32x4*)(ok + 8 * i + 4) = k1; } }
        }
        asm volatile("" ::: "memory");
        {
            float vf[32];
#pragma unroll
            for (int i = 0; i < 4; ++i) unpack8(*(const u32x4*)(pr + C_V + kvh * 64 + half * 32 + i * 8), vf + 8 * i);
            if (tk < 0) {
#pragma unroll
                for (int i = 0; i < 32; ++i) vf[i] = 0.f;
            }
#pragma unroll
            for (int i = 0; i < 32; ++i) Vt[(half * 32 + i) * VP + key] = f2bf(vf[i]);
            if (wout) { float* ov = c.out + O_SVP + ooff;
#pragma unroll
                for (int i = 0; i < 8; ++i) *(f32x4*)(ov + 4 * i) = (f32x4){vf[4 * i], vf[4 * i + 1], vf[4 * i + 2], vf[4 * i + 3]}; }
        }
    }
    __syncthreads();
#pragma unroll 1
    for (int it = 0; it < 4; ++it) {
        const int combo = w * 2 + (it >> 1), mi = it & 1, gq = combo & 3, rg = combo >> 2, head = kvh * 4 + gq; const float sink = IN_(I_SINK)[head];
        const int r = 16 * mi + fr; const size_t row = (size_t)b * SEQ + blk * 128 + 32 * rg + r;
        bf16x8 qf[2];
        { float f[16]; float sq = 0.f;
#pragma unroll
            for (int kk = 0; kk < 2; ++kk) unpack8(*(const u32x4*)(PROJ + row * DINP + C_Q + head * 64 + kk * 32 + fq * 8), f + 8 * kk);
#pragma unroll
            for (int i = 0; i < 16; ++i) sq += f[i] * f[i];
            sq += __shfl_xor(sq, 16); sq += __shfl_xor(sq, 32); const float rs = rsqrtf(sq * (1.f / 64.f) + EPS) * 0.125f;
#pragma unroll
            for (int kk = 0; kk < 2; ++kk) { const float* qg = IN_(I_QG) + kk * 32 + fq * 8; u32x4 q; q.x = pk2(f[8 * kk] * rs * qg[0], f[8 * kk + 1] * rs * qg[1]); q.y = pk2(f[8 * kk + 2] * rs * qg[2], f[8 * kk + 3] * rs * qg[3]);
                q.z = pk2(f[8 * kk + 4] * rs * qg[4], f[8 * kk + 5] * rs * qg[5]); q.w = pk2(f[8 * kk + 6] * rs * qg[6], f[8 * kk + 7] * rs * qg[7]); qf[kk] = __builtin_bit_cast(bf16x8, q); } }
        f32x4 S[10];
#pragma unroll
        for (int ni = 0; ni < 10; ++ni) S[ni] = (f32x4){0.f, 0.f, 0.f, 0.f};
#pragma unroll
        for (int ni = 0; ni < 10; ++ni)
#pragma unroll
            for (int kk = 0; kk < 2; ++kk) { __builtin_amdgcn_sched_barrier(0); const bf16x8 bf = *(const LAS bf16x8*)(Ks + (32 * rg + 16 * ni + fr) * KP + kk * 32 + fq * 8); S[ni] = MFMA16(bf, qf[kk], S[ni]); }
        float mx = sink;
        const int lowlim = blk > 0 ? -100000 : 128 - 32 * rg; const int lo_ = r > lowlim ? r : lowlim;
        int xoff = 4 * fq - lo_; const unsigned hi_ = (unsigned)(r + 128 - lo_); asm volatile("" : "+v"(xoff));
#pragma unroll
        for (int ni = 0; ni < 10; ++ni)
#pragma unroll
            for (int j = 0; j < 4; ++j) { const bool ok = (unsigned)(xoff + (16 * ni + j)) <= hi_;
                S[ni][j] = ok ? S[ni][j] : -1e30f; mx = fmaxf(mx, S[ni][j]); }
        mx = fmaxf(mx, __shfl_xor(mx, 16)); mx = fmaxf(mx, __shfl_xor(mx, 32));
        float sm = 0.f;
#pragma unroll
        for (int ni = 0; ni < 10; ++ni)
#pragma unroll
            for (int j = 0; j < 4; ++j) { const float p = __expf(S[ni][j] - mx); S[ni][j] = p; sm += p; }
        sm += __shfl_xor(sm, 16); sm += __shfl_xor(sm, 32); sm += __expf(sink - mx);
        const float inv = 1.f / sm;
        f32x4 O[4];
#pragma unroll
        for (int nd = 0; nd < 4; ++nd) O[nd] = (f32x4){0.f, 0.f, 0.f, 0.f};
#pragma unroll
        for (int k2 = 0; k2 < 5; ++k2) { __builtin_amdgcn_sched_barrier(0); u32x4 pa; pa.x = pk2(S[2 * k2][0], S[2 * k2][1]); pa.y = pk2(S[2 * k2][2], S[2 * k2][3]); pa.z = pk2(S[2 * k2 + 1][0], S[2 * k2 + 1][1]); pa.w = pk2(S[2 * k2 + 1][2], S[2 * k2 + 1][3]);
            const bf16x8 af = __builtin_bit_cast(bf16x8, pa);
#pragma unroll
            for (int nd = 0; nd < 4; ++nd) { const LAS bf16_t* vp = Vt + (16 * nd + fr) * VP + 32 * rg + 32 * k2 + 4 * fq; const s16x4 lo = *(const LAS s16x4*)vp, hi = *(const LAS s16x4*)(vp + 16);
                O[nd] = MFMA16(__builtin_shufflevector(lo, hi, 0, 1, 2, 3, 4, 5, 6, 7), af, O[nd]); } }
#pragma unroll
        for (int nd = 0; nd < 4; ++nd) { const f32x4 o = O[nd] * inv; u32x2 wv; wv.x = pk2(o[0], o[1]); wv.y = pk2(o[2], o[3]); *(u32x2*)(MIX + row * DMIX + 2048 + head * 64 + 16 * nd + 4 * fq) = wv; }
    }
    __syncthreads();
}

DI void swa_sample_wave(const Ctx& c, int wu) {
    int lane_ = c.lane; asm volatile("" : "+v"(lane_)); const int b = wu >> 2, kvh = wu & 3, lane = lane_;
    LAS float* qs = (LAS float*)(c.lds + c.wave * 4096); LAS float* kn = qs + 256; LAS float* ps = qs + 384;
    const bf16_t* pr = (const bf16_t*)(c.ws + WS_PROJ) + (size_t)(MP + b) * DINP; bf16_t* MIX = (bf16_t*)(c.ws + WS_MIX);
    const float* ck = IN_(I_CSK); const float* cv = IN_(I_CSV); float* ok = c.out + O_SKS; float* ov = c.out + O_SVS;
    float kraw = bf1(pr[C_K + kvh * 64 + lane]); float ss = wave_sum(kraw * kraw); const float knew = kraw * rsqrtf(ss * (1.f / 64.f) + EPS) * IN_(I_KG)[lane];
    const float vnew = bf1(pr[C_V + kvh * 64 + lane]);
    kn[lane] = knew;
    float sink[4];
#pragma unroll
    for (int g = 0; g < 4; ++g) { const float qr = bf1(pr[C_Q + (kvh * 4 + g) * 64 + lane]); const float s2 = wave_sum(qr * qr); qs[g * 64 + lane] = qr * rsqrtf(s2 * (1.f / 64.f) + EPS) * IN_(I_QG)[lane] * 0.125f; sink[g] = IN_(I_SINK)[kvh * 4 + g]; }
    ok[((size_t)(b * 128 + 127) * 4 + kvh) * 64 + lane] = knew; ov[((size_t)(b * 128 + 127) * 4 + kvh) * 64 + lane] = vnew;
    LDS_FENCE();
    float lg[2][4], lnew[4];
#pragma unroll
    for (int i = 0; i < 2; ++i) { asm volatile("" ::: "memory"); const int s = lane + 64 * i; const float* kr = ck + ((size_t)(b * 128 + s) * 4 + kvh) * 64; float* kw = ok + ((size_t)(b * 128 + s - 1) * 4 + kvh) * 64;
        float a[4] = {0.f, 0.f, 0.f, 0.f};
#pragma unroll 4
        for (int d4 = 0; d4 < 16; ++d4) { const f32x4 kv = *(const f32x4*)(kr + 4 * d4); if (s >= 1) *(f32x4*)(kw + 4 * d4) = kv;
#pragma unroll
            for (int g = 0; g < 4; ++g) { const f32x4 qv = *(const LAS f32x4*)(qs + g * 64 + 4 * d4); a[g] += (kv.x * qv.x + kv.y * qv.y) + (kv.z * qv.z + kv.w * qv.w); } }
#pragma unroll
        for (int g = 0; g < 4; ++g) lg[i][g] = a[g]; }
    float inv[4];
#pragma unroll
    for (int g = 0; g < 4; ++g) { lnew[g] = wave_sum(qs[g * 64 + lane] * knew);
        float mx = wave_max(fmaxf(lg[0][g], lg[1][g])); mx = fmaxf(mx, fmaxf(lnew[g], sink[g]));
        const float p0 = __expf(lg[0][g] - mx), p1 = __expf(lg[1][g] - mx), pn = __expf(lnew[g] - mx);
        const float sm = wave_sum(p0 + p1) + pn + __expf(sink[g] - mx); inv[g] = 1.f / sm;
        ps[g * 132 + lane] = p0; ps[g * 132 + lane + 64] = p1; if (lane == 0) ps[g * 132 + 128] = pn; }
    LDS_FENCE();
    float o[4] = {0.f, 0.f, 0.f, 0.f};
#pragma unroll 4
    for (int s = 0; s < 128; ++s) { const float v = cv[((size_t)(b * 128 + s) * 4 + kvh) * 64 + lane]; if (s >= 1) ov[((size_t)(b * 128 + s - 1) * 4 + kvh) * 64 + lane] = v;
#pragma unroll
        for (int g = 0; g < 4; ++g) o[g] += ps[g * 132 + s] * v; }
#pragma unroll
    for (int g = 0; g < 4; ++g) { o[g] += ps[g * 132 + 128] * vnew; MIX[(size_t)(MP + b) * DMIX + 2048 + (kvh * 4 + g) * 64 + lane] = f2bf(o[g] * inv[g]); }
    LDS_FENCE();
}

DI void ssd_sample_wave(const Ctx& c, int wu) {
    int lane_ = c.lane; asm volatile("" : "+v"(lane_)); const int b = wu >> 5, h = wu & 31, g = h >> 3, lane = lane_;
    LAS float* xs = (LAS float*)(c.lds + c.wave * 4096); LAS float* Bsm = xs + 64; LAS float* Csm = xs + 192;
    const bf16_t* pr = (const bf16_t*)(c.ws + WS_PROJ) + (size_t)(MP + b) * DINP; bf16_t* MIX = (bf16_t*)(c.ws + WS_MIX);
    const float* cw = IN_(I_SCW); const float* cb = IN_(I_SCB); const float* scs = IN_(I_SSC) + (size_t)b * 3 * CONVD;
#pragma unroll
    for (int q = 0; q < 5; ++q) { const int cch = q == 0 ? h * 64 + lane : (q < 3 ? 2048 + g * 128 + (q - 1) * 64 + lane : 2560 + g * 128 + (q - 3) * 64 + lane);
        float v = cb[cch] + cw[cch] * scs[cch] + cw[CONVD + cch] * scs[CONVD + cch] + cw[2 * CONVD + cch] * scs[2 * CONVD + cch] + cw[3 * CONVD + cch] * bf1(pr[C_XBC + cch]);
        v = silu_f(v); if (q == 0) xs[lane] = v; else if (q < 3) Bsm[(q - 1) * 64 + lane] = v; else Csm[(q - 3) * 64 + lane] = v; }
    LDS_FENCE();
    const float dt = softplus_f(((const float*)(c.ws + WS_DT))[(size_t)(MP + b) * 32 + h] + IN_(I_DTB)[h]); const float dA = __expf(-dt * __expf(IN_(I_ALOG)[h])), Dh = IN_(I_DSK)[h];
    const int n4 = (lane & 31) * 4, psub = lane >> 5;
    const f32x4 Bv = *(const LAS f32x4*)(Bsm + n4), Cv = *(const LAS f32x4*)(Csm + n4);
    const float* hs = IN_(I_SS) + (size_t)(b * 32 + h) * 64 * 128; float* ho = c.out + O_SSS + (size_t)(b * 32 + h) * 64 * 128;
    float sq = 0.f;
#pragma unroll 4
    for (int it = 0; it < 32; ++it) { const int p = 2 * it + psub; const f32x4 hv = *(const f32x4*)(hs + p * 128 + n4); const float xv = xs[p], xb = dt * xv;
        const f32x4 hn = hv * dA + Bv * xb; *(f32x4*)(ho + p * 128 + n4) = hn;
        float part = (hn.x * Cv.x + hn.y * Cv.y) + (hn.z * Cv.z + hn.w * Cv.w);
#pragma unroll
        for (int o = 1; o < 32; o <<= 1) part += __shfl_xor(part, o);
        if ((lane & 31) == 0) { float yv = part + Dh * xv; yv *= silu_f(bf1(pr[C_Z + h * 64 + p])); sq += yv * yv; MIX[(size_t)(MP + b) * DMIX + h * 64 + p] = f2bf(yv); } }
    sq = wave_sum(sq); if (lane == 0) atomicAdd((float*)(c.ws + WS_SSQ) + MP + b, sq);
    LDS_FENCE();
}

DI void p2_mixers(const Ctx& c) {
#ifndef P2SEL
#define P2SEL 15
#endif
    if (P2SEL & 1) for (int u = c.bid; u < 256; u += c.G) ssd_prompt_unit(c, u);
    if (P2SEL & 2) for (int u = c.bid; u < 256; u += c.G) swa_prompt_unit(c, u);
    const int gw = c.bid * 8 + c.wave, NGW = c.G * 8, lane = c.lane;
    if (P2SEL & 4) for (int u = gw; u < 4096; u += NGW) ssd_sample_wave(c, u);
    if (P2SEL & 8) for (int u = gw; u < 512; u += NGW) swa_sample_wave(c, u);
    for (int u = gw; u < 4096; u += NGW) { float* p = c.out + O_MKP + (size_t)u * 128; f32x2 v = ((f32x2*)p)[lane]; const float rs = rsqrtf(wave_sum(v.x * v.x + v.y * v.y) * (1.f / 128.f) + EPS);
        const f32x2 gg = ((const f32x2*)IN_(I_CKG))[lane]; v.x *= rs * gg.x; v.y *= rs * gg.y; ((f32x2*)p)[lane] = v; }
    const bf16_t* PROJ = (const bf16_t*)(c.ws + WS_PROJ);
    for (int i = c.bid * 512 + c.tid; i < NB * 3 * CONVD; i += c.G * 512) { const int b = i / (3 * CONVD), j = (i / CONVD) % 3, ch = i % CONVD; c.out[O_SCP + i] = bf1(PROJ[((size_t)b * SEQ + 2045 + j) * DINP + C_XBC + ch]); }
    for (int i = c.bid * 512 + c.tid; i < MS * 3 * CONVD; i += c.G * 512) { const int b = i / (3 * CONVD), j = (i / CONVD) % 3, ch = i % CONVD;
        c.out[O_SCS + i] = j < 2 ? IN_(I_SSC)[((size_t)b * 3 + j + 1) * CONVD + ch] : bf1(PROJ[(size_t)(MP + b) * DINP + C_XBC + ch]); }
}

DI void xattn_prompt_unit(const Ctx& c, int unit) {
    const int b = unit >> 6, head = (unit >> 4) & 3, qb = unit & 15;
    int tid_ = c.tid; asm volatile("" : "+v"(tid_)); const int tid = tid_, lane = tid & 63, w = __builtin_amdgcn_readfirstlane(tid >> 6), fr = lane & 15, fq = lane >> 4;
    constexpr int KP = 136, VP = 264;
    LAS bf16_t* Ks = (LAS bf16_t*)(c.lds); LAS bf16_t* Vt = (LAS bf16_t*)(c.lds + 69632);
    {
        const int key = tid >> 1, half = tid & 1; const float* kp = c.out + O_MKP + ((size_t)(b * 256 + key) * 4 + head) * 128 + half * 64; const float* vp = c.out + O_MVP + ((size_t)(b * 256 + key) * 4 + head) * 128 + half * 64;
#pragma unroll
        for (int i = 0; i < 8; ++i) { const f32x4 a = *(const f32x4*)(kp + 8 * i), bb = *(const f32x4*)(kp + 8 * i + 4); u32x4 q; q.x = pk2(a.x, a.y); q.y = pk2(a.z, a.w); q.z = pk2(bb.x, bb.y); q.w = pk2(bb.z, bb.w);
            *(LAS u32x4*)(Ks + key * KP + half * 64 + 8 * i) = q; }
#pragma unroll
        for (int i = 0; i < 16; ++i) { const f32x4 a = *(const f32x4*)(vp + 4 * i); const int d = half * 64 + 4 * i;
            Vt[(d + 0) * VP + key] = f2bf(a.x); Vt[(d + 1) * VP + key] = f2bf(a.y); Vt[(d + 2) * VP + key] = f2bf(a.z); Vt[(d + 3) * VP + key] = f2bf(a.w); }
    }
    __syncthreads();
    const bf16_t* QC = (const bf16_t*)(c.ws + WS_QC); bf16_t* OC = (bf16_t*)(c.ws + WS_OC);
    const size_t row = (size_t)b * SEQ + qb * 128 + 16 * w + fr;
    bf16x8 qf[4];
    { float f[32]; float sq = 0.f;
#pragma unroll
        for (int kk = 0; kk < 4; ++kk) unpack8(*(const u32x4*)(QC + row * DXA + head * 128 + kk * 32 + fq * 8), f + 8 * kk);
#pragma unroll
        for (int i = 0; i < 32; ++i) sq += f[i] * f[i];
        sq += __shfl_xor(sq, 16); sq += __shfl_xor(sq, 32); const float rs = rsqrtf(sq * (1.f / 128.f) + EPS) * 0.08838834764831845f;
#pragma unroll
        for (int kk = 0; kk < 4; ++kk) { const float* qg = IN_(I_CQG) + kk * 32 + fq * 8; u32x4 q; q.x = pk2(f[8 * kk] * rs * qg[0], f[8 * kk + 1] * rs * qg[1]); q.y = pk2(f[8 * kk + 2] * rs * qg[2], f[8 * kk + 3] * rs * qg[3]);
            q.z = pk2(f[8 * kk + 4] * rs * qg[4], f[8 * kk + 5] * rs * qg[5]); q.w = pk2(f[8 * kk + 6] * rs * qg[6], f[8 * kk + 7] * rs * qg[7]); qf[kk] = __builtin_bit_cast(bf16x8, q); } }
    f32x4 S[16];
#pragma unroll
    for (int ni = 0; ni < 16; ++ni) S[ni] = (f32x4){0.f, 0.f, 0.f, 0.f};
#pragma unroll
    for (int ni = 0; ni < 16; ++ni)
#pragma unroll
        for (int kk = 0; kk < 4; ++kk) { __builtin_amdgcn_sched_barrier(0); const bf16x8 bf = *(const LAS bf16x8*)(Ks + (16 * ni + fr) * KP + kk * 32 + fq * 8); S[ni] = MFMA16(bf, qf[kk], S[ni]); }
    float mx = -1e30f;
#pragma unroll
    for (int ni = 0; ni < 16; ++ni)
#pragma unroll
        for (int j = 0; j < 4; ++j) mx = fmaxf(mx, S[ni][j]);
    mx = fmaxf(mx, __shfl_xor(mx, 16)); mx = fmaxf(mx, __shfl_xor(mx, 32));
    float sm = 0.f;
#pragma unroll
    for (int ni = 0; ni < 16; ++ni)
#pragma unroll
        for (int j = 0; j < 4; ++j) { const float p = __expf(S[ni][j] - mx); S[ni][j] = p; sm += p; }
    sm += __shfl_xor(sm, 16); sm += __shfl_xor(sm, 32); const float inv = 1.f / sm;
    f32x4 O[8];
#pragma unroll
    for (int nd = 0; nd < 8; ++nd) O[nd] = (f32x4){0.f, 0.f, 0.f, 0.f};
#pragma unroll
    for (int k2 = 0; k2 < 8; ++k2) { __builtin_amdgcn_sched_barrier(0); u32x4 pa; pa.x = pk2(S[2 * k2][0], S[2 * k2][1]); pa.y = pk2(S[2 * k2][2], S[2 * k2][3]); pa.z = pk2(S[2 * k2 + 1][0], S[2 * k2 + 1][1]); pa.w = pk2(S[2 * k2 + 1][2], S[2 * k2 + 1][3]);
        const bf16x8 af = __builtin_bit_cast(bf16x8, pa);
#pragma unroll
        for (int nd = 0; nd < 8; ++nd) { const LAS bf16_t* vp = Vt + (16 * nd + fr) * VP + 32 * k2 + 4 * fq; const s16x4 lo = *(const LAS s16x4*)vp, hi = *(const LAS s16x4*)(vp + 16);
            O[nd] = MFMA16(__builtin_shufflevector(lo, hi, 0, 1, 2, 3, 4, 5, 6, 7), af, O[nd]); } }
#pragma unroll
    for (int nd = 0; nd < 8; ++nd) { const f32x4 o = O[nd] * inv; u32x2 wv; wv.x = pk2(o[0], o[1]); wv.y = pk2(o[2], o[3]); *(u32x2*)(OC + row * DXA + head * 128 + 16 * nd + 4 * fq) = wv; }
    __syncthreads();
}
DI void xattn_sample_wave(const Ctx& c, int wu) {
    int lane_ = c.lane; asm volatile("" : "+v"(lane_)); const int b = wu >> 2, head = wu & 3, lane = lane_;
    LAS float* qs = (LAS float*)(c.lds + c.wave * 4096); LAS float* ps = qs + 128;
    const bf16_t* QC = (const bf16_t*)(c.ws + WS_QC); bf16_t* OC = (bf16_t*)(c.ws + WS_OC);
    const unsigned qw = *(const unsigned*)(QC + (size_t)(MP + b) * DXA + head * 128 + 2 * lane); const float q0 = bflo(qw), q1 = bfhi(qw);
    const float rs = rsqrtf(wave_sum(q0 * q0 + q1 * q1) * (1.f / 128.f) + EPS) * 0.08838834764831845f; const f32x2 gg = ((const f32x2*)IN_(I_CQG))[lane];
    qs[2 * lane] = q0 * rs * gg.x; qs[2 * lane + 1] = q1 * rs * gg.y;
    LDS_FENCE();
    float lg[4];
#pragma unroll
    for (int i = 0; i < 4; ++i) { const int m = lane + 64 * i; const float* kr = IN_(I_CMK) + ((size_t)(b * 256 + m) * 4 + head) * 128; float a = 0.f;
#pragma unroll 8
        for (int d4 = 0; d4 < 32; ++d4) { const f32x4 kv = *(const f32x4*)(kr + 4 * d4), qv = *(const LAS f32x4*)(qs + 4 * d4); a += (kv.x * qv.x + kv.y * qv.y) + (kv.z * qv.z + kv.w * qv.w); }
        lg[i] = a; }
    const float mx = wave_max(fmaxf(fmaxf(lg[0], lg[1]), fmaxf(lg[2], lg[3]))); float sm = 0.f;
#pragma unroll
    for (int i = 0; i < 4; ++i) { const float p = __expf(lg[i] - mx); ps[lane + 64 * i] = p; sm += p; }
    sm = wave_sum(sm); const float inv = 1.f / sm;
    LDS_FENCE();
    float o0 = 0.f, o1 = 0.f;
#pragma unroll 8
    for (int m = 0; m < 256; ++m) { const f32x2 v = *(const f32x2*)(IN_(I_CMV) + ((size_t)(b * 256 + m) * 4 + head) * 128 + 2 * lane); const float p = ps[m]; o0 += p * v.x; o1 += p * v.y; }
    *(unsigned*)(OC + (size_t)(MP + b) * DXA + head * 128 + 2 * lane) = pk2(o0 * inv, o1 * inv);
    LDS_FENCE();
}

DI void p8_convgate(const Ctx& c) {
    const bf16_t* U = (const bf16_t*)(c.ws + WS_U); bf16_t* H = (bf16_t*)(c.ws + WS_H);
    const float* fw = IN_(I_FCW); const float* fb = IN_(I_FCB);
    const int gw = c.bid * 8 + c.wave, NGW = c.G * 8, lane = c.lane;
    for (int task = gw; task < 256 * 11; task += NGW) {
        const int seg = task / 11, j8 = (task % 11) * 64 + lane, r0 = seg * 32, tl0 = r0 & (SEQ - 1), b = r0 >> 11;
        float wg[3][8], wv[3][8], bg[8], bv[8];
#pragma unroll
        for (int i = 0; i < 3; ++i) { const f32x4 a = *(const f32x4*)(fw + (size_t)i * DFF2 + j8 * 8), a2 = *(const f32x4*)(fw + (size_t)i * DFF2 + j8 * 8 + 4), d = *(const f32x4*)(fw + (size_t)i * DFF2 + DFF + j8 * 8), d2 = *(const f32x4*)(fw + (size_t)i * DFF2 + DFF + j8 * 8 + 4);
            wg[i][0] = a.x; wg[i][1] = a.y; wg[i][2] = a.z; wg[i][3] = a.w; wg[i][4] = a2.x; wg[i][5] = a2.y; wg[i][6] = a2.z; wg[i][7] = a2.w;
            wv[i][0] = d.x; wv[i][1] = d.y; wv[i][2] = d.z; wv[i][3] = d.w; wv[i][4] = d2.x; wv[i][5] = d2.y; wv[i][6] = d2.z; wv[i][7] = d2.w; }
        { const f32x4 a = *(const f32x4*)(fb + j8 * 8), a2 = *(const f32x4*)(fb + j8 * 8 + 4), d = *(const f32x4*)(fb + DFF + j8 * 8), d2 = *(const f32x4*)(fb + DFF + j8 * 8 + 4);
            bg[0] = a.x; bg[1] = a.y; bg[2] = a.z; bg[3] = a.w; bg[4] = a2.x; bg[5] = a2.y; bg[6] = a2.z; bg[7] = a2.w; bv[0] = d.x; bv[1] = d.y; bv[2] = d.z; bv[3] = d.w; bv[4] = d2.x; bv[5] = d2.y; bv[6] = d2.z; bv[7] = d2.w; }
        float g1[8], g2[8], v1[8], v2[8];
        if (tl0 == 0) {
#pragma unroll
            for (int j = 0; j < 8; ++j) { g1[j] = 0.f; g2[j] = 0.f; v1[j] = 0.f; v2[j] = 0.f; }
        } else { const bf16_t* up = U + (size_t)(r0 - 2) * DFF2 + j8 * 8; unpack8(*(const u32x4*)up, g1); unpack8(*(const u32x4*)(up + DFF), v1); unpack8(*(const u32x4*)(up + DFF2), g2); unpack8(*(const u32x4*)(up + DFF2 + DFF), v2); }
        for (int r = 0; r < 32; ++r) { const size_t row = (size_t)r0 + r; const bf16_t* up = U + row * DFF2 + j8 * 8; float g3[8], v3[8], o[8]; unpack8(*(const u32x4*)up, g3); unpack8(*(const u32x4*)(up + DFF), v3);
#pragma unroll
            for (int j = 0; j < 8; ++j) { const float cgv = bg[j] + wg[0][j] * g1[j] + wg[1][j] * g2[j] + wg[2][j] * g3[j], cvv = bv[j] + wv[0][j] * v1[j] + wv[1][j] * v2[j] + wv[2][j] * v3[j]; o[j] = silu_f(cgv) * cvv; g1[j] = g2[j]; g2[j] = g3[j]; v1[j] = v2[j]; v2[j] = v3[j]; }
            u32x4 q; q.x = pk2(o[0], o[1]); q.y = pk2(o[2], o[3]); q.z = pk2(o[4], o[5]); q.w = pk2(o[6], o[7]); *(u32x4*)(H + row * DFF + j8 * 8) = q;
            const int tl = tl0 + r;
            if (tl >= SEQ - 2) { float* fo = c.out + O_FCP + ((size_t)b * 2 + (tl - (SEQ - 2))) * DFF2 + j8 * 8;
                *(f32x4*)fo = (f32x4){g3[0], g3[1], g3[2], g3[3]}; *(f32x4*)(fo + 4) = (f32x4){g3[4], g3[5], g3[6], g3[7]}; *(f32x4*)(fo + DFF) = (f32x4){v3[0], v3[1], v3[2], v3[3]}; *(f32x4*)(fo + DFF + 4) = (f32x4){v3[4], v3[5], v3[6], v3[7]}; } }
    }
    for (int i = c.bid * 512 + c.tid; i < MS * 704; i += c.G * 512) { const int b = i / 704, j8 = i % 704; const size_t row = MP + b; const float* st = IN_(I_SFC) + (size_t)b * 2 * DFF2; float* fo = c.out + O_FCS + (size_t)b * 2 * DFF2;
        float g3[8], v3[8], o[8]; const bf16_t* up = U + row * DFF2 + j8 * 8; unpack8(*(const u32x4*)up, g3); unpack8(*(const u32x4*)(up + DFF), v3);
#pragma unroll
        for (int j = 0; j < 8; ++j) { const int cg_ = j8 * 8 + j, cv_ = DFF + cg_; const float g1 = st[cg_], g2 = st[DFF2 + cg_], v1 = st[cv_], v2 = st[DFF2 + cv_];
            const float cgv = fb[cg_] + fw[cg_] * g1 + fw[DFF2 + cg_] * g2 + fw[2 * DFF2 + cg_] * g3[j], cvv = fb[cv_] + fw[cv_] * v1 + fw[DFF2 + cv_] * v2 + fw[2 * DFF2 + cv_] * v3[j];
            o[j] = silu_f(cgv) * cvv; fo[cg_] = g2; fo[cv_] = v2; fo[DFF2 + cg_] = g3[j]; fo[DFF2 + cv_] = v3[j]; }
        u32x4 q; q.x = pk2(o[0], o[1]); q.y = pk2(o[2], o[3]); q.z = pk2(o[4], o[5]); q.w = pk2(o[6], o[7]); *(u32x4*)(H + row * DFF + j8 * 8) = q; }
}

__global__ void __launch_bounds__(512, 2) fwd_mega(Args args) {
    extern __shared__ __attribute__((aligned(16))) unsigned char lds_raw[];
    cg::grid_group grid = cg::this_grid();
    Ctx c; c.lds = (LAS unsigned char*)lds_raw; c.tid = threadIdx.x; c.lane = c.tid & 63; c.wave = __builtin_amdgcn_readfirstlane(c.tid >> 6); c.G = gridDim.x; c.bid = blockIdx.x;
    c.in = args.in; c.out = args.out; c.ws = args.ws;
    unsigned char* ws = args.ws;
    const int lo = args.ph_lo, hi = args.ph_hi;
#ifndef PHMASK
#define PHMASK 0x3ff
#endif
#define PH(k) ((((PHMASK) >> (k)) & 1) && lo <= (k) && (k) < hi)
#define SYNC(k) do { if (PH(k) && PH((k) + 1)) grid.sync(); } while (0)
    float* SSQ = (float*)(ws + WS_SSQ);
    if (PH(0)) p0_prologue(c);
    SYNC(0);
    if (PH(1)) {
        { pg8::Gemm g{(const bf16_t*)(ws + WS_A0), (const bf16_t*)(ws + WS_WIN), MPAD, DINP, 2048}; pg8::StaticOrder S; S.init(MPAD, DINP, c.G, c.bid);
            EpiProj E{(bf16_t*)(ws + WS_PROJ), (float*)(ws + WS_DT), 0}; pg8::gemm_phase(c.lds, g, S, E); }
        { pg8::Gemm g{(const bf16_t*)(ws + WS_MEMN), (const bf16_t*)(ws + WS_WCKV), 1024, 1024, 2048}; pg8::StaticOrder S; S.init(1024, 1024, c.G, c.G - 1 - c.bid);
            EpiMem E{c.out + O_MKP, c.out + O_MVP, 0}; pg8::gemm_phase(c.lds, g, S, E); }
    }
    SYNC(1);
    if (PH(2)) p2_mixers(c);
    SYNC(2);
    if (PH(3)) { pg8::Gemm g{(const bf16_t*)(ws + WS_MIX), (const bf16_t*)(ws + WS_WOUT), MPAD, 2048, 3072}; pg8::StaticOrder S; S.init(MPAD, 2048, c.G, c.bid);
        EpiRes<true> E{IN_(I_XP), IN_(I_XS), (float*)(ws + WS_X1), (float*)(ws + WS_X1) + (size_t)MP * DM, (bf16_t*)(ws + WS_A0), SSQ + MPAD, SSQ, 32}; pg8::gemm_phase(c.lds, g, S, E); }
    SYNC(3);
    if (PH(4)) { pg8::Gemm g{(const bf16_t*)(ws + WS_A0), (const bf16_t*)(ws + WS_WCQ), MPAD, 512, 2048}; pg8::StaticOrder S; S.init(MPAD, 512, c.G, c.bid);
        EpiScale E{(bf16_t*)(ws + WS_QC), DXA, SSQ + MPAD, 0}; pg8::gemm_phase(c.lds, g, S, E); }
    SYNC(4);
    if (PH(5)) {
        for (int u = c.bid; u < 256; u += c.G) xattn_prompt_unit(c, u);
        for (int u = c.bid * 8 + c.wave; u < 512; u += c.G * 8) xattn_sample_wave(c, u);
    }
    SYNC(5);
    if (PH(6)) { pg8::Gemm g{(const bf16_t*)(ws + WS_OC), (const bf16_t*)(ws + WS_WCO), MPAD, 2048, 512}; pg8::StaticOrder S; S.init(MPAD, 2048, c.G, c.bid);
        float* X1 = (float*)(ws + WS_X1);
        EpiRes<false> E{X1, X1 + (size_t)MP * DM, X1, X1 + (size_t)MP * DM, (bf16_t*)(ws + WS_A0), SSQ + 2 * MPAD, nullptr, 0}; pg8::gemm_phase(c.lds, g, S, E); }
    SYNC(6);
    if (PH(7)) { pg8::Gemm g{(const bf16_t*)(ws + WS_A0), (const bf16_t*)(ws + WS_WUP), MPAD, DFF2, 2048}; pg8::StaticOrder S; S.init(MPAD, DFF2, c.G, c.bid);
        EpiScale E{(bf16_t*)(ws + WS_U), DFF2, SSQ + 2 * MPAD, 0}; pg8::gemm_phase(c.lds, g, S, E); }
    SYNC(7);
    if (PH(8)) p8_convgate(c);
    SYNC(8);
    if (PH(9)) { pg8::Gemm g{(const bf16_t*)(ws + WS_H), (const bf16_t*)(ws + WS_WDN), MPAD, 2048, DFF}; pg8::StaticOrder S; S.init(MPAD, 2048, c.G, c.bid);
        const float* X1 = (const float*)(ws + WS_X1);
        EpiRes<false> E{X1, X1 + (size_t)MP * DM, c.out + O_Y, c.out + O_YS, nullptr, nullptr, nullptr, 0}; pg8::gemm_phase(c.lds, g, S, E); }
}

extern "C" void kernel_launch(void* const* d_in, const int* in_sizes, int n_in, void* d_out, int out_size, void* d_ws, size_t ws_size, hipStream_t stream) {
    static int grid = 0;
    if (grid == 0) {
        if (n_in != 35 || (size_t)out_size != O_END || ws_size < WS_END) { fprintf(stderr, "kernel_launch: unexpected shapes n_in %d out %d ws %zu (need %zu)\n", n_in, out_size, ws_size, (size_t)WS_END); grid = -1; return; }
        int dev = 0, cus = 0, per_cu = 0;
        hipGetDevice(&dev);
        hipDeviceGetAttribute(&cus, hipDeviceAttributeMultiprocessorCount, dev);
        hipFuncSetAttribute((const void*)fwd_mega, hipFuncAttributeMaxDynamicSharedMemorySize, LDS_BYTES);
        hipOccupancyMaxActiveBlocksPerMultiprocessor(&per_cu, (const void*)fwd_mega, 512, LDS_BYTES);
        if (per_cu < 1) fprintf(stderr, "kernel_launch: occupancy query says %d blocks/CU\n", per_cu);
        grid = cus;
    }
    if (grid < 0) return;
    Args a{};
    for (int i = 0; i < 35; ++i) a.in[i] = (const float*)d_in[i];
    a.out = (float*)d_out; a.ws = (unsigned char*)d_ws; a.ph_lo = 0; a.ph_hi = 10;
    void* args[] = {&a};
    hipError_t e = hipLaunchCooperativeKernel((const void*)fwd_mega, dim3(grid), dim3(512), args, LDS_BYTES, stream);
    if (e != hipSuccess) fprintf(stderr, "cooperative launch failed: %s (grid %d)\n", hipGetErrorString(e), grid);
}
```

```cpp
#include <hip/hip_runtime.h>
#include <hip/hip_cooperative_groups.h>
#include <cstdio>
#include <cstdint>
namespace cg = cooperative_groups;

#define DI __device__ __forceinline__
#define LAS __attribute__((address_space(3)))
typedef unsigned short bf16_t;
typedef short bf16x8 __attribute__((ext_vector_type(8)));
typedef short s16x4 __attribute__((ext_vector_type(4)));
typedef float f32x4 __attribute__((ext_vector_type(4)));
typedef float f32x2 __attribute__((ext_vector_type(2)));
typedef unsigned u32x4 __attribute__((ext_vector_type(4)));
typedef unsigned u32x2 __attribute__((ext_vector_type(2)));
typedef __bf16 bf16x2_t __attribute__((ext_vector_type(2)));

DI unsigned pk2(float lo, float hi) { f32x2 v = {lo, hi}; bf16x2_t b = __builtin_convertvector(v, bf16x2_t); return __builtin_bit_cast(unsigned, b); }
DI float bflo(unsigned w) { return __uint_as_float(w << 16); }
DI float bfhi(unsigned w) { return __uint_as_float(w & 0xffff0000u); }
DI float bf1(bf16_t h) { return __uint_as_float(((unsigned)h) << 16); }
DI bf16_t f2bf(float f) { return (bf16_t)(pk2(f, 0.f) & 0xffffu); }
DI void unpack8(u32x4 r, float* o) { o[0] = bflo(r.x); o[1] = bfhi(r.x); o[2] = bflo(r.y); o[3] = bfhi(r.y); o[4] = bflo(r.z); o[5] = bfhi(r.z); o[6] = bflo(r.w); o[7] = bfhi(r.w); }
DI float wave_sum(float v) {
#pragma unroll
    for (int o = 1; o < 64; o <<= 1) v += __shfl_xor(v, o);
    return v;
}
DI float wave_max(float v) {
#pragma unroll
    for (int o = 1; o < 64; o <<= 1) v = fmaxf(v, __shfl_xor(v, o));
    return v;
}
DI float silu_f(float x) { return x / (1.f + __expf(-x)); }
DI float softplus_f(float x) { return x > 20.f ? x : log1pf(__expf(x)); }
#define MFMA16(a, b, c) __builtin_amdgcn_mfma_f32_16x16x32_bf16((a), (b), (c), 0, 0, 0)
#define LDS_FENCE() asm volatile("s_waitcnt lgkmcnt(0)" ::: "memory")
typedef short v4i16_t __attribute__((ext_vector_type(4)));
DI s16x4 vtr(const LAS bf16_t* p) { return __builtin_bit_cast(s16x4, __builtin_amdgcn_ds_read_tr16_b64_v4i16((LAS v4i16_t*)p)); }
DI bf16x8 cat8(s16x4 lo, s16x4 hi) { return __builtin_shufflevector(lo, hi, 0, 1, 2, 3, 4, 5, 6, 7); }

constexpr int DM = 2048, MP = 8192, MS = 128, MTOK = MP + MS, MPAD = 8448, SEQ = 2048, NB = 4;
constexpr int DIN = 6688, DINP = 6912, DMIX = 3072, DXA = 512, DFF = 5632, DFF2 = 11264, CONVD = 3072;
constexpr int C_Q = 0, C_K = 1024, C_V = 1280, C_Z = 1536, C_XBC = 3584, C_DT = 6656;
constexpr float EPS = 1e-6f;
constexpr size_t O_Y = 0, O_YS = O_Y + (size_t)MP * DM, O_SKP = O_YS + (size_t)MS * DM, O_SVP = O_SKP + 131072, O_SKS = O_SVP + 131072,
    O_SVS = O_SKS + 4194304, O_SCP = O_SVS + 4194304, O_SCS = O_SCP + 36864, O_SSP = O_SCS + 1179648, O_SSS = O_SSP + 1048576,
    O_MKP = O_SSS + 33554432, O_MVP = O_MKP + 524288, O_FCP = O_MVP + 524288, O_FCS = O_FCP + 90112, O_END = O_FCS + 2883584;
constexpr size_t MiB = 1u << 20;
constexpr size_t WS_SSQ = 0;
constexpr size_t WS_WIN = 1 * MiB;
constexpr size_t WS_WOUT = WS_WIN + 27 * MiB;
constexpr size_t WS_WCQ = WS_WOUT + 12 * MiB;
constexpr size_t WS_WCKV = WS_WCQ + 2 * MiB;
constexpr size_t WS_WCO = WS_WCKV + 4 * MiB;
constexpr size_t WS_WUP = WS_WCO + 2 * MiB;
constexpr size_t WS_WDN = WS_WUP + 44 * MiB;
constexpr size_t WS_A0 = WS_WDN + 22 * MiB;
constexpr size_t WS_MEMN = WS_A0 + 33 * MiB;
constexpr size_t WS_X1 = WS_MEMN + 4 * MiB;
constexpr size_t WS_QC = WS_X1 + 66 * MiB;
constexpr size_t WS_OC = WS_QC + 9 * MiB;
constexpr size_t WS_DT = WS_OC + 9 * MiB;
constexpr size_t WS_H = WS_DT + 2 * MiB;
constexpr size_t WS_R1 = WS_H + 91 * MiB;
constexpr size_t WS_PROJ = WS_R1, WS_MIX = WS_R1 + 112 * MiB, WS_U = WS_R1;
constexpr size_t WS_END = WS_R1 + 182 * MiB;
constexpr int LDS_BYTES = 147456;

namespace pg8 {
constexpr int BM = 256, BK = 64, HALF = 128, HTB = HALF * BK * 2, STAGE_BYTES = 8 * HTB, NXCD = 8, WGM = 8;
__host__ __device__ __forceinline__ int lds_byte(int r, int c) { const int st = (r >> 4) * 2 + (c >> 5), rr = r & 15, cc = c & 31, ob = rr * 64 + cc * 2; return st * 1024 + (ob ^ (((ob >> 9) & 1) << 5)); }
__host__ __device__ __forceinline__ void stage_rc(int b, int& R, int& C) { const int st = b / 1024, sb = b % 1024, swz = sb ^ (((sb >> 9) & 1) << 5); R = (st >> 1) * 16 + swz / 64; C = (st & 1) * 32 + (swz % 64) / 2; }
__host__ __device__ __forceinline__ int perm32(int rho) { const int n = rho >> 4, i = rho & 15; return 8 * (i >> 2) + 4 * n + (i & 3); }
struct Unit { int pm, pn; };
struct Gemm { const bf16_t* A; const bf16_t* Bt; int M, N, K; };
struct StaticOrder {
    int nM, nN, nwg, G, c;
    __host__ __device__ void init(int M, int N, int G_, int c_) { nM = M / BM; nN = N / BM; nwg = nM * nN; G = G_; c = c_; }
    __host__ __device__ bool next(int i, Unit& u) const {
        const long L = (long)i * G + c; if (L >= nwg) return false;
        int wgid = (int)L; { const int q = nwg / NXCD, r = nwg % NXCD, xcd = wgid % NXCD, off = wgid / NXCD; wgid = (xcd < r ? xcd * (q + 1) : r * (q + 1) + (xcd - r) * q) + off; }
        const int nig = WGM * nN, gid = wgid / nig, fm = gid * WGM, gsz = (nM - fm) < WGM ? (nM - fm) : WGM;
        u.pm = fm + ((wgid % nig) % gsz); u.pn = (wgid % nig) / gsz; return true;
    }
};
template <class Epi, class Sched>
__device__ __forceinline__ void gemm_phase(LAS unsigned char* lds, const Gemm g, const Sched& S, const Epi& E) {
    const int tid = threadIdx.x, wid = __builtin_amdgcn_readfirstlane(tid >> 6), lane = tid & 63, wr = wid >> 2, wc = wid & 3, fr = lane & 15, fq = lane >> 4;
    const int K = g.K, nt = K / BK;
    unsigned voffA[2], voffB[2];
#pragma unroll
    for (int i = 0; i < 2; ++i) { int R, C; stage_rc(tid * 16 + i * 8192, R, C); const int Rb = Epi::PERM ? ((R & ~31) + perm32(R & 31)) : R;
        voffA[i] = (unsigned)(R * K + C) * 2u; voffB[i] = (unsigned)(Rb * K + C) * 2u; }
    const size_t kstep = (size_t)(BK * 2);
    const size_t hstep = (size_t)HALF * K * 2;
    const size_t tstep = 2 * hstep;
    const unsigned ldsw = (unsigned)wid * 1024u;
    const int aoff = lds_byte(wr * 64 + fr, fq * 8), boff = lds_byte(wc * 32 + fr, fq * 8);
#define PG8_SA(b, h) (((b) * 2 + (h)) * HTB)
#define PG8_SB(b, h) ((4 + (b) * 2 + (h)) * HTB)
#define PG8_STAGE(bufoff, gbase, voff) do { _Pragma("unroll") for (int _i = 0; _i < 2; ++_i) \
        __builtin_amdgcn_global_load_lds((const unsigned*)((const char*)(gbase) + (voff)[_i]), (LAS unsigned*)(lds + (bufoff) + ldsw + _i * 8192), 16, 0, 0); } while (0)
#define PG8_LDA(dst, b, h) do { _Pragma("unroll") for (int m = 0; m < 4; ++m) _Pragma("unroll") for (int k = 0; k < 2; ++k) dst[m][k] = *(const LAS bf16x8*)(lds + PG8_SA(b, h) + aoff + m * 2048 + k * 1024); } while (0)
#define PG8_LDB(dst, b, h) do { _Pragma("unroll") for (int n = 0; n < 2; ++n) _Pragma("unroll") for (int k = 0; k < 2; ++k) dst[n][k] = *(const LAS bf16x8*)(lds + PG8_SB(b, h) + boff + n * 2048 + k * 1024); } while (0)
#define PG8_MMA(ai, bj, At, Bt) do { __builtin_amdgcn_s_setprio(1); _Pragma("unroll") for (int m = 0; m < 4; ++m) _Pragma("unroll") for (int n = 0; n < 2; ++n) _Pragma("unroll") for (int k = 0; k < 2; ++k) \
        acc[ai][bj][m][n] = __builtin_amdgcn_mfma_f32_16x16x32_bf16(Bt[n][k], At[m][k], acc[ai][bj][m][n], 0, 0, 0); __builtin_amdgcn_s_setprio(0); } while (0)
#define PG8_WAIT_V(n) asm volatile("s_waitcnt vmcnt(" #n ")" ::: "memory")
#define PG8_WAIT_L(n) asm volatile("s_waitcnt lgkmcnt(" #n ")" ::: "memory")
#define PG8_BAR __builtin_amdgcn_s_barrier()
#define PG8_SCHED __builtin_amdgcn_sched_barrier(0)
    Unit cur, nxt; int ui = 0;
    if (!S.next(0, cur)) return;
    f32x4 acc[2][2][4][2];
#pragma unroll
    for (int a = 0; a < 2; ++a)
#pragma unroll
        for (int b = 0; b < 2; ++b)
#pragma unroll
            for (int m = 0; m < 4; ++m)
#pragma unroll
                for (int n = 0; n < 2; ++n) acc[a][b][m][n] = (f32x4){0.f, 0.f, 0.f, 0.f};
    bf16x8 At[4][2], B0[2][2], B1[2][2];
    const char* cA = (const char*)g.A + (size_t)cur.pm * tstep; const char* cB = (const char*)g.Bt + (size_t)cur.pn * tstep;
    PG8_STAGE(PG8_SB(0, 0), cB, voffB); PG8_STAGE(PG8_SB(0, 1), cB + hstep, voffB); PG8_STAGE(PG8_SA(0, 0), cA, voffA); PG8_STAGE(PG8_SA(0, 1), cA + hstep, voffA);
    if (wr == 1) PG8_BAR;
    PG8_WAIT_V(2); PG8_BAR;
    PG8_STAGE(PG8_SB(1, 0), cB + kstep, voffB); PG8_STAGE(PG8_SA(1, 0), cA + kstep, voffA); PG8_STAGE(PG8_SB(1, 1), cB + hstep + kstep, voffB);
    PG8_WAIT_V(6); PG8_BAR;
    for (;;) {
        const bool has_next = S.next(ui + 1, nxt);
        const char* nA = has_next ? (const char*)g.A + (size_t)nxt.pm * tstep : cA; const char* nB = has_next ? (const char*)g.Bt + (size_t)nxt.pn * tstep : cB;
        for (int t = 0; t < nt; t += 2) {
            const bool last = (t == nt - 2);
            const char* a1 = cA + (size_t)(t + 1) * kstep;
            const char* a2 = last ? nA : cA + (size_t)(t + 2) * kstep; const char* b2 = last ? nB : cB + (size_t)(t + 2) * kstep;
            const char* a3 = a2 + kstep; const char* b3 = b2 + kstep;
            if constexpr (Epi::MID) { if (t == E.tsplit) E.midscale(acc, cur, wr, fr); }
            PG8_LDB(B0, 0, 0); PG8_LDB(B1, 0, 1); PG8_SCHED; PG8_LDA(At, 0, 0); PG8_STAGE(PG8_SA(1, 1), a1 + hstep, voffA);
            PG8_WAIT_V(8); PG8_WAIT_L(0); PG8_BAR; PG8_MMA(0, 0, At, B0); PG8_MMA(0, 1, At, B1); PG8_BAR; PG8_SCHED;
            PG8_LDA(At, 0, 1); PG8_STAGE(PG8_SB(0, 0), b2, voffB); PG8_STAGE(PG8_SB(0, 1), b2 + hstep, voffB); PG8_STAGE(PG8_SA(0, 0), a2, voffA);
            PG8_WAIT_V(8); PG8_WAIT_L(0); PG8_BAR; PG8_MMA(1, 0, At, B0); PG8_MMA(1, 1, At, B1); PG8_BAR; PG8_SCHED;
            PG8_LDB(B0, 1, 0); PG8_LDB(B1, 1, 1); PG8_SCHED; PG8_LDA(At, 1, 0); PG8_STAGE(PG8_SA(0, 1), a2 + hstep, voffA);
            PG8_WAIT_V(8); PG8_WAIT_L(0); PG8_BAR; PG8_MMA(0, 0, At, B0); PG8_MMA(0, 1, At, B1); PG8_BAR; PG8_SCHED;
            PG8_LDA(At, 1, 1); PG8_STAGE(PG8_SB(1, 0), b3, voffB); PG8_STAGE(PG8_SB(1, 1), b3 + hstep, voffB); PG8_STAGE(PG8_SA(1, 0), a3, voffA);
            PG8_WAIT_V(8); PG8_WAIT_L(0); PG8_BAR; PG8_MMA(1, 0, At, B0); PG8_MMA(1, 1, At, B1); PG8_BAR; PG8_SCHED;
        }
        if (wr == 0) PG8_BAR;
        E(acc, cur, wr, wc, fr, fq);
        if (!has_next) break;
#pragma unroll
        for (int a = 0; a < 2; ++a)
#pragma unroll
            for (int b = 0; b < 2; ++b)
#pragma unroll
                for (int m = 0; m < 4; ++m)
#pragma unroll
                    for (int n = 0; n < 2; ++n) acc[a][b][m][n] = (f32x4){0.f, 0.f, 0.f, 0.f};
        cur = nxt; cA = nA; cB = nB; ++ui;
        if (wr == 1) PG8_BAR;
    }
    PG8_WAIT_V(0);
    PG8_BAR;
#undef PG8_SA
#undef PG8_SB
#undef PG8_STAGE
#undef PG8_LDA
#undef PG8_LDB
#undef PG8_MMA
#undef PG8_WAIT_V
#undef PG8_WAIT_L
#undef PG8_BAR
#undef PG8_SCHED
}
}
using pg8::Unit;
typedef f32x4 Acc[2][2][4][2];

struct EpiProj {
    static constexpr bool PERM = true, MID = false; bf16_t* O; float* dt; int tsplit;
    DI void midscale(Acc&, const Unit&, int, int) const {}
    DI void operator()(const Acc& acc, const Unit& u, int wr, int wc, int fr, int fq) const {
        const int row0 = u.pm * 256 + wr * 64 + fr, col0 = u.pn * 256 + wc * 32 + 8 * fq;
#pragma unroll
        for (int ai = 0; ai < 2; ++ai)
#pragma unroll
            for (int m = 0; m < 4; ++m) { const int row = row0 + ai * 128 + m * 16; bf16_t* rowp = O + (size_t)row * DINP + col0;
#pragma unroll
                for (int bj = 0; bj < 2; ++bj) { const f32x4 v0 = acc[ai][bj][m][0], v1 = acc[ai][bj][m][1]; u32x4 w; w.x = pk2(v0[0], v0[1]); w.y = pk2(v0[2], v0[3]); w.z = pk2(v1[0], v1[1]); w.w = pk2(v1[2], v1[3]);
                    *(u32x4*)(rowp + bj * 128) = w; }
                if (u.pn == 26 && wc == 0) { float* d = dt + (size_t)row * 32 + 8 * fq; *(f32x4*)d = acc[ai][0][m][0]; *(f32x4*)(d + 4) = acc[ai][0][m][1]; } }
    }
};
struct EpiMem {
    static constexpr bool PERM = false, MID = false; float* outK; float* outV; int tsplit;
    DI void midscale(Acc&, const Unit&, int, int) const {}
    DI void operator()(const Acc& acc, const Unit& u, int wr, int wc, int fr, int fq) const {
        float* base = (u.pn < 2) ? outK : outV; const int colt = (u.pn & 1) * 256 + wc * 32 + 4 * fq;
#pragma unroll
        for (int ai = 0; ai < 2; ++ai)
#pragma unroll
            for (int m = 0; m < 4; ++m) { const int row = u.pm * 256 + ai * 128 + wr * 64 + m * 16 + fr;
#pragma unroll
                for (int bj = 0; bj < 2; ++bj)
#pragma unroll
                    for (int n = 0; n < 2; ++n) *(f32x4*)(base + (size_t)row * 512 + colt + bj * 128 + n * 16) = acc[ai][bj][m][n]; }
    }
};
template <bool MIDS> struct EpiRes {
    static constexpr bool PERM = false, MID = MIDS;
    const float* baseP; const float* baseS; float* outP; float* outS; bf16_t* abf; float* ssq; const float* ssq_in; int tsplit;
    DI void midscale(Acc& acc, const Unit& u, int wr, int fr) const {
        int rbase = u.pm * 256 + wr * 64 + fr; asm volatile("" : "+v"(rbase));
#pragma unroll
        for (int ai = 0; ai < 2; ++ai)
#pragma unroll
            for (int m = 0; m < 4; ++m) { const int row = rbase + ai * 128 + m * 16; const float s = rsqrtf(ssq_in[row] * (1.f / 2048.f) + EPS);
#pragma unroll
                for (int bj = 0; bj < 2; ++bj)
#pragma unroll
                    for (int n = 0; n < 2; ++n) acc[ai][bj][m][n] = acc[ai][bj][m][n] * s; }
    }
    DI void operator()(const Acc& acc, const Unit& u, int wr, int wc, int fr, int fq) const {
        const int col0 = u.pn * 256 + wc * 32 + 4 * fq;
#pragma unroll
        for (int ai = 0; ai < 2; ++ai)
#pragma unroll
            for (int m = 0; m < 4; ++m) { const int row = u.pm * 256 + ai * 128 + wr * 64 + m * 16 + fr;
                if (row < MTOK) {
                    const float* bp = row < MP ? baseP + (size_t)row * DM : baseS + (size_t)(row - MP) * DM;
                    float* op = row < MP ? outP + (size_t)row * DM : outS + (size_t)(row - MP) * DM;
                    float sq = 0.f;
#pragma unroll
                    for (int bj = 0; bj < 2; ++bj)
#pragma unroll
                        for (int n = 0; n < 2; ++n) { const int c = col0 + bj * 128 + n * 16; const f32x4 o = *(const f32x4*)(bp + c) + acc[ai][bj][m][n]; *(f32x4*)(op + c) = o;
                            if (abf) { u32x2 w; w.x = pk2(o[0], o[1]); w.y = pk2(o[2], o[3]); *(u32x2*)(abf + (size_t)row * DM + c) = w; sq += (o[0] * o[0] + o[1] * o[1]) + (o[2] * o[2] + o[3] * o[3]); } }
                    if (abf) { sq += __shfl_xor(sq, 16); sq += __shfl_xor(sq, 32); if (fq == 0) atomicAdd(ssq + row, sq); }
                }
                asm volatile("" ::: "memory"); }
    }
};
struct EpiScale {
    static constexpr bool PERM = true, MID = false; bf16_t* O; int ldc; const float* ssq_in; int tsplit;
    DI void midscale(Acc&, const Unit&, int, int) const {}
    DI void operator()(const Acc& acc, const Unit& u, int wr, int wc, int fr, int fq) const {
        const int row0 = u.pm * 256 + wr * 64 + fr, col0 = u.pn * 256 + wc * 32 + 8 * fq;
#pragma unroll
        for (int ai = 0; ai < 2; ++ai)
#pragma unroll
            for (int m = 0; m < 4; ++m) { const int row = row0 + ai * 128 + m * 16; bf16_t* rowp = O + (size_t)row * ldc + col0; const float s = rsqrtf(ssq_in[row] * (1.f / 2048.f) + EPS);
#pragma unroll
                for (int bj = 0; bj < 2; ++bj) { const f32x4 v0 = acc[ai][bj][m][0] * s, v1 = acc[ai][bj][m][1] * s; u32x4 w; w.x = pk2(v0[0], v0[1]); w.y = pk2(v0[2], v0[3]); w.z = pk2(v1[0], v1[1]); w.w = pk2(v1[2], v1[3]);
                    *(u32x4*)(rowp + bj * 128) = w; } }
    }
};

struct Args { const float* in[35]; float* out; unsigned char* ws; int ph_lo, ph_hi; };
struct Ctx {
    LAS unsigned char* lds; int tid, lane, wave, G, bid;
    const float* const* in; float* out; unsigned char* ws; int dry;
};
#define IN_(i) (c.in[i])
enum { I_XP = 0, I_XS, I_CSK, I_CSV, I_SSC, I_SS, I_CMK, I_CMV, I_SFC, I_MEM, I_GMIX, I_WIN, I_QG, I_KG, I_SINK, I_SCW, I_SCB, I_DTB, I_ALOG, I_DSK, I_SNG, I_WOUT, I_GCR, I_GMEM, I_WCQ, I_WCK, I_WCV, I_CQG, I_CKG, I_WCO, I_GFFN, I_WUP, I_FCW, I_FCB, I_WDN };

struct TItem { const float* W; bf16_t* WT; const float* gain; int N, ldk, ksrc0, kdst0, n0, nrow_off; };
DI bool p0_decode(const Ctx& c, int it, TItem& t) {
    constexpr int I0 = 32 * 105, I1 = 48 * 32, I2 = 32 * 8, I5 = 8 * 32, I6 = 32 * 176, I7 = 88 * 32;
    int r = it; t.nrow_off = 0;
    if (r < I0) { const int kb = r / 105, nb = r % 105; t.W = IN_(I_WIN); t.N = DIN; t.WT = (bf16_t*)(c.ws + WS_WIN); t.ldk = 2048; t.ksrc0 = kb * 64; t.kdst0 = kb * 64; t.n0 = nb * 64; t.gain = IN_(I_GMIX) + kb * 64; return true; } r -= I0;
    if (r < I1) { const int kb = r / 32, nb = r % 32, ks = kb * 64; const bool ssd = ks >= 1024; t.W = IN_(I_WOUT); t.N = 2048; t.WT = (bf16_t*)(c.ws + WS_WOUT); t.ldk = 3072; t.ksrc0 = ks; t.kdst0 = ssd ? ks - 1024 : ks + 2048; t.n0 = nb * 64;
        t.gain = ssd ? IN_(I_SNG) + (ks - 1024) : nullptr; return true; } r -= I1;
    if (r < I2) { const int kb = r / 8, nb = r % 8; t.W = IN_(I_WCQ); t.N = 512; t.WT = (bf16_t*)(c.ws + WS_WCQ); t.ldk = 2048; t.ksrc0 = kb * 64; t.kdst0 = kb * 64; t.n0 = nb * 64; t.gain = IN_(I_GCR) + kb * 64; return true; } r -= I2;
    if (r < I2) { const int kb = r / 8, nb = r % 8; t.W = IN_(I_WCK); t.N = 512; t.WT = (bf16_t*)(c.ws + WS_WCKV); t.ldk = 2048; t.ksrc0 = kb * 64; t.kdst0 = kb * 64; t.n0 = nb * 64; t.gain = IN_(I_GMEM) + kb * 64; return true; } r -= I2;
    if (r < I2) { const int kb = r / 8, nb = r % 8; t.W = IN_(I_WCV); t.N = 512; t.WT = (bf16_t*)(c.ws + WS_WCKV); t.ldk = 2048; t.ksrc0 = kb * 64; t.kdst0 = kb * 64; t.n0 = nb * 64; t.nrow_off = 512; t.gain = IN_(I_GMEM) + kb * 64; return true; } r -= I2;
    if (r < I5) { const int kb = r / 32, nb = r % 32; t.W = IN_(I_WCO); t.N = 2048; t.WT = (bf16_t*)(c.ws + WS_WCO); t.ldk = 512; t.ksrc0 = kb * 64; t.kdst0 = kb * 64; t.n0 = nb * 64; t.gain = nullptr; return true; } r -= I5;
    if (r < I6) { const int kb = r / 176, nb = r % 176; t.W = IN_(I_WUP); t.N = DFF2; t.WT = (bf16_t*)(c.ws + WS_WUP); t.ldk = 2048; t.ksrc0 = kb * 64; t.kdst0 = kb * 64; t.n0 = nb * 64; t.gain = IN_(I_GFFN) + kb * 64; return true; } r -= I6;
    if (r < I7) { const int kb = r / 32, nb = r % 32; t.W = IN_(I_WDN); t.N = 2048; t.WT = (bf16_t*)(c.ws + WS_WDN); t.ldk = DFF; t.ksrc0 = kb * 64; t.kdst0 = kb * 64; t.n0 = nb * 64; t.gain = nullptr; return true; }
    return false;
}
DI void p0_load(const TItem& t, int lane, f32x4 (&buf)[16], float (&gv)[16]) {
    const int kr = lane >> 4, n4 = (lane & 15) * 4; const bool ok = t.n0 + n4 < t.N;
    const float* p = t.W + (size_t)(t.ksrc0 + kr) * t.N + t.n0 + (ok ? n4 : 0);
#pragma unroll
    for (int i = 0; i < 16; ++i) { buf[i] = *(const f32x4*)(p + (size_t)(4 * i) * t.N); gv[i] = t.gain ? t.gain[4 * i + kr] : 1.f; if (!ok) gv[i] = 0.f; }
}
DI void p0_transposes(const Ctx& c) {
    int lane_ = c.lane; asm volatile("" : "+v"(lane_)); const int lane = lane_;
    LAS float* scr = (LAS float*)(c.lds + c.wave * 16640);
    const int gw = c.bid * 8 + c.wave, NGW = c.G * 8;
    f32x4 buf[16]; float gv[16]; TItem cur, nxt;
    int it = gw; bool have = p0_decode(c, it, cur);
    if (have) p0_load(cur, lane, buf, gv);
    const int kr = lane >> 4, n4 = (lane & 15) * 4, cc = lane & 7;
    while (have) {
        const int itn = it + NGW; const bool hn = p0_decode(c, itn, nxt);
#pragma unroll
        for (int i = 0; i < 16; ++i) { LAS float* d = scr + (4 * i + kr) * 65 + n4; const f32x4 v = buf[i] * gv[i]; d[0] = v.x; d[1] = v.y; d[2] = v.z; d[3] = v.w; }
        if (hn) p0_load(nxt, lane, buf, gv);
        LDS_FENCE();
#pragma unroll
        for (int j = 0; j < 8; ++j) { const int n = (lane >> 3) + 8 * j; const LAS float* sp = scr + (8 * cc) * 65 + n;
            u32x4 o; o.x = pk2(sp[0 * 65], sp[1 * 65]); o.y = pk2(sp[2 * 65], sp[3 * 65]); o.z = pk2(sp[4 * 65], sp[5 * 65]); o.w = pk2(sp[6 * 65], sp[7 * 65]);
            *(u32x4*)(cur.WT + (size_t)(cur.nrow_off + cur.n0 + n) * cur.ldk + cur.kdst0 + 8 * cc) = o; }
        LDS_FENCE();
        cur = nxt; it = itn; have = hn;
    }
}
DI void norm_row_to_bf16(const float* xrow, bf16_t* orow, int lane) {
    f32x4 v[8]; float s = 0.f;
    if (xrow) {
#pragma unroll
        for (int j = 0; j < 8; ++j) { v[j] = ((const f32x4*)xrow)[lane + 64 * j]; s += (v[j].x * v[j].x + v[j].y * v[j].y) + (v[j].z * v[j].z + v[j].w * v[j].w); }
    } else {
#pragma unroll
        for (int j = 0; j < 8; ++j) v[j] = (f32x4){0.f, 0.f, 0.f, 0.f};
    }
    const float rs = rsqrtf(wave_sum(s) * (1.f / 2048.f) + EPS);
#pragma unroll
    for (int j = 0; j < 8; ++j) { u32x2 w; w.x = pk2(v[j].x * rs, v[j].y * rs); w.y = pk2(v[j].z * rs, v[j].w * rs); ((u32x2*)orow)[lane + 64 * j] = w; }
}
DI void p0_prologue(const Ctx& c) {
    const int gw = c.bid * 8 + c.wave, NGW = c.G * 8, lane = c.lane;
    bf16_t* WINT = (bf16_t*)(c.ws + WS_WIN);
    p0_transposes(c);
    { u32x4* z = (u32x4*)(WINT + (size_t)6720 * 2048); const int n16 = (DINP - 6720) * 2048 * 2 / 16;
        for (int i = c.bid * 512 + c.tid; i < n16; i += c.G * 512) z[i] = (u32x4){0u, 0u, 0u, 0u}; }
    { float* z = (float*)(c.ws + WS_SSQ); for (int i = c.bid * 512 + c.tid; i < 3 * MPAD; i += c.G * 512) z[i] = 0.f; }
    bf16_t* A0 = (bf16_t*)(c.ws + WS_A0); bf16_t* MEMN = (bf16_t*)(c.ws + WS_MEMN);
    for (int m = gw; m < MPAD + 1024; m += NGW) {
        if (m < MPAD) { const float* xr = m < MP ? IN_(I_XP) + (size_t)m * DM : (m < MTOK ? IN_(I_XS) + (size_t)(m - MP) * DM : nullptr); norm_row_to_bf16(xr, A0 + (size_t)m * DM, lane); }
        else { const int r = m - MPAD; norm_row_to_bf16(IN_(I_MEM) + (size_t)r * DM, MEMN + (size_t)r * DM, lane); }
    }
}

constexpr int SP = 136;
DI void p1b_conv(const Ctx& c) {
    const bf16_t* PROJ = (const bf16_t*)(c.ws + WS_PROJ); bf16_t* XBC = (bf16_t*)(c.ws + WS_H);
    const float* cw = IN_(I_SCW); const float* cb = IN_(I_SCB);
    const int gw = c.bid * 8 + c.wave, NGW = c.G * 8, lane = c.lane;
    for (int task = gw; task < 512 * 6; task += NGW) {
        const int seg = task / 6, c8 = (task % 6) * 64 + lane, r0 = seg * 16, tl0 = r0 & (SEQ - 1), cch = c8 * 8;
        float w[4][8], bias[8];
#pragma unroll
        for (int i = 0; i < 4; ++i) { const f32x4 a = *(const f32x4*)(cw + (size_t)i * CONVD + cch), a2 = *(const f32x4*)(cw + (size_t)i * CONVD + cch + 4);
            w[i][0] = a.x; w[i][1] = a.y; w[i][2] = a.z; w[i][3] = a.w; w[i][4] = a2.x; w[i][5] = a2.y; w[i][6] = a2.z; w[i][7] = a2.w; }
        { const f32x4 a = *(const f32x4*)(cb + cch), a2 = *(const f32x4*)(cb + cch + 4); bias[0] = a.x; bias[1] = a.y; bias[2] = a.z; bias[3] = a.w; bias[4] = a2.x; bias[5] = a2.y; bias[6] = a2.z; bias[7] = a2.w; }
        float h1[8], h2[8], h3[8];
        if (tl0 == 0) {
#pragma unroll
            for (int j = 0; j < 8; ++j) { h1[j] = 0.f; h2[j] = 0.f; h3[j] = 0.f; }
        } else { const bf16_t* p = PROJ + (size_t)(r0 - 3) * DINP + C_XBC + cch; unpack8(*(const u32x4*)p, h1); unpack8(*(const u32x4*)(p + DINP), h2); unpack8(*(const u32x4*)(p + 2 * DINP), h3); }
#pragma unroll 1
        for (int rb = 0; rb < 16; rb += 4) { u32x4 lr_[4];
#pragma unroll
          for (int r4 = 0; r4 < 4; ++r4) lr_[r4] = *(const u32x4*)(PROJ + ((size_t)r0 + rb + r4) * DINP + C_XBC + cch);
#pragma unroll
          for (int r4 = 0; r4 < 4; ++r4) { const size_t row = (size_t)r0 + rb + r4; float cur[8], o[8]; unpack8(lr_[r4], cur);
#pragma unroll
            for (int j = 0; j < 8; ++j) { o[j] = silu_f(bias[j] + w[0][j] * h1[j] + w[1][j] * h2[j] + w[2][j] * h3[j] + w[3][j] * cur[j]); h1[j] = h2[j]; h2[j] = h3[j]; h3[j] = cur[j]; }
            u32x4 q; q.x = pk2(o[0], o[1]); q.y = pk2(o[2], o[3]); q.z = pk2(o[4], o[5]); q.w = pk2(o[6], o[7]); *(u32x4*)(XBC + row * CONVD + cch) = q; } }
    }
}
DI void ssd_prompt_unit(const Ctx& c, int unit) {
    const int b = unit >> 6, h = (unit >> 1) & 31, ph = unit & 1, g = h >> 3;
    int tid_ = c.tid; asm volatile("" : "+v"(tid_)); const int tid = tid_, lane = tid & 63, w = __builtin_amdgcn_readfirstlane(tid >> 6), fr = lane & 15, fq = lane >> 4;
    constexpr int XP = 40;
    LAS bf16_t* Cs = (LAS bf16_t*)(c.lds); LAS bf16_t* Bs = (LAS bf16_t*)(c.lds + 34816); LAS bf16_t* Xn = (LAS bf16_t*)(c.lds + 69632); LAS bf16_t* Hb = (LAS bf16_t*)(c.lds + 90112);
    LAS float* dts = (LAS float*)(c.lds + 98816); LAS float* las = (LAS float*)(c.lds + 99328); LAS float* scl = (LAS float*)(c.lds + 99840);
    const bf16_t* PROJ = (const bf16_t*)(c.ws + WS_PROJ); const bf16_t* XBC = (const bf16_t*)(c.ws + WS_H); const float* DTR = (const float*)(c.ws + WS_DT);
    bf16_t* MIX = (bf16_t*)(c.ws + WS_MIX); float* SSQS = (float*)(c.ws + WS_SSQ) + (c.dry ? 3 * MPAD : 0);
    const float av = -__expf(IN_(I_ALOG)[h]), dtb = IN_(I_DTB)[h], Dh = IN_(I_DSK)[h];
    f32x4 st[2] = {(f32x4){0.f, 0.f, 0.f, 0.f}, (f32x4){0.f, 0.f, 0.f, 0.f}};
    for (int i = tid; i < 32 * SP / 2; i += 512) ((LAS unsigned*)Hb)[i] = 0u;
    const int sx = tid >> 2, c8 = tid & 3, cb8 = tid & 15, s0 = tid >> 4;
    u32x4 xq, bq[4], cq[4]; float dtrA = 0.f, dtrB = 0.f;
#define SSD_LOADS(CK) do { const size_t r0_ = (size_t)b * SEQ + (CK) * 128; xq = *(const u32x4*)(XBC + (r0_ + sx) * CONVD + h * 64 + ph * 32 + c8 * 8); \
        _Pragma("unroll") for (int i = 0; i < 4; ++i) { const bf16_t* p_ = XBC + (r0_ + s0 + 32 * i) * CONVD + 2048 + g * 128 + cb8 * 8; bq[i] = *(const u32x4*)p_; cq[i] = *(const u32x4*)(p_ + 512); } \
        if (w < 2) { dtrA = DTR[(r0_ + lane) * 32 + h]; dtrB = DTR[(r0_ + 64 + lane) * 32 + h]; } } while (0)
    SSD_LOADS(0);
    for (int ck = 0; ck < 16; ++ck) {
        const size_t row0 = (size_t)b * SEQ + ck * 128;
        {
            if (w < 2) {
                const float dA = softplus_f(dtrA + dtb), dB = softplus_f(dtrB + dtb);
                float sA = dA, sB = dB;
#pragma unroll
                for (int o = 1; o < 64; o <<= 1) { const float tA = __shfl_up(sA, o), tB = __shfl_up(sB, o); if (lane >= o) { sA += tA; sB += tB; } }
                const float totA = __shfl(sA, 63), tot = totA + __shfl(sB, 63);
                if (w == 0) { dts[lane] = dA; las[lane] = av * sA; scl[lane] = dA * __expf(av * (tot - sA)); }
                else { dts[64 + lane] = dB; las[64 + lane] = av * (totA + sB); scl[64 + lane] = dB * __expf(av * (tot - totA - sB)); }
            }
            *(LAS u32x4*)(Xn + sx * XP + c8 * 8) = xq;
#pragma unroll
            for (int i = 0; i < 4; ++i) { *(LAS u32x4*)(Bs + (s0 + 32 * i) * SP + cb8 * 8) = bq[i]; *(LAS u32x4*)(Cs + (s0 + 32 * i) * SP + cb8 * 8) = cq[i]; }
        }
        __syncthreads();
        if (ck + 1 < 16) SSD_LOADS(ck + 1);
        asm volatile("" ::: "memory");
        const int l = 16 * w + fr; const float la_l = las[l];
        f32x4 cbm[8];
#pragma unroll
        for (int ni = 0; ni < 8; ++ni) cbm[ni] = (f32x4){0.f, 0.f, 0.f, 0.f};
#pragma unroll
        for (int kk = 0; kk < 4; ++kk) { __builtin_amdgcn_sched_barrier(0); const bf16x8 af = *(const LAS bf16x8*)(Cs + l * SP + kk * 32 + fq * 8);
#pragma unroll
            for (int ni = 0; ni < 8; ++ni) { const bf16x8 bf = *(const LAS bf16x8*)(Bs + (16 * ni + fr) * SP + kk * 32 + fq * 8); cbm[ni] = MFMA16(bf, af, cbm[ni]); } }
        int lim = l - 4 * fq; asm volatile("" : "+v"(lim));
#pragma unroll
        for (int ni = 0; ni < 8; ++ni) { const int s = 16 * ni + 4 * fq; const f32x4 ls = *(const LAS f32x4*)(las + s), ds = *(const LAS f32x4*)(dts + s);
#pragma unroll
            for (int j = 0; j < 4; ++j) cbm[ni][j] = (16 * ni + j <= lim) ? cbm[ni][j] * __expf(la_l - ls[j]) * ds[j] : 0.f; }
        f32x4 y[2] = {(f32x4){0.f, 0.f, 0.f, 0.f}, (f32x4){0.f, 0.f, 0.f, 0.f}}, yi[2] = {(f32x4){0.f, 0.f, 0.f, 0.f}, (f32x4){0.f, 0.f, 0.f, 0.f}};
#pragma unroll
        for (int k2 = 0; k2 < 4; ++k2) { __builtin_amdgcn_sched_barrier(0); u32x4 pa; pa.x = pk2(cbm[2 * k2][0], cbm[2 * k2][1]); pa.y = pk2(cbm[2 * k2][2], cbm[2 * k2][3]); pa.z = pk2(cbm[2 * k2 + 1][0], cbm[2 * k2 + 1][1]); pa.w = pk2(cbm[2 * k2 + 1][2], cbm[2 * k2 + 1][3]);
            const bf16x8 af = __builtin_bit_cast(bf16x8, pa);
#pragma unroll
            for (int np = 0; np < 2; ++np) { const LAS bf16_t* xp = Xn + (32 * k2 + 4 * fq + (fr >> 2)) * XP + 16 * np + 4 * (fr & 3);
                y[np] = MFMA16(cat8(vtr(xp), vtr(xp + 16 * XP)), af, y[np]); } }
#pragma unroll
        for (int kk = 0; kk < 4; ++kk) { const bf16x8 af = *(const LAS bf16x8*)(Cs + l * SP + kk * 32 + fq * 8);
#pragma unroll
            for (int np = 0; np < 2; ++np) { const bf16x8 bf = *(const LAS bf16x8*)(Hb + (16 * np + fr) * SP + kk * 32 + fq * 8); yi[np] = MFMA16(bf, af, yi[np]); } }
        {
            const float el = __expf(la_l); const size_t row = row0 + l; float sq = 0.f;
#pragma unroll
            for (int np = 0; np < 2; ++np) { const int p0 = 16 * np + 4 * fq; const u32x2 zr = *(const u32x2*)(PROJ + row * DINP + C_Z + h * 64 + ph * 32 + p0);
                const u32x2 xr = *(const LAS u32x2*)(Xn + l * XP + p0);
                const float zf[4] = {bflo(zr.x), bfhi(zr.x), bflo(zr.y), bfhi(zr.y)}, xf[4] = {bflo(xr.x), bfhi(xr.x), bflo(xr.y), bfhi(xr.y)}; float o[4];
#pragma unroll
                for (int j = 0; j < 4; ++j) { float v = y[np][j] + el * yi[np][j] + Dh * xf[j]; v *= silu_f(zf[j]); o[j] = v; sq += v * v; }
                u32x2 wv; wv.x = pk2(o[0], o[1]); wv.y = pk2(o[2], o[3]); *(u32x2*)(MIX + row * DMIX + h * 64 + ph * 32 + p0) = wv; }
            sq += __shfl_xor(sq, 16); sq += __shfl_xor(sq, 32); if (fq == 0) atomicAdd(SSQS + row, sq);
        }
        {
            f32x4 sa[2] = {(f32x4){0.f, 0.f, 0.f, 0.f}, (f32x4){0.f, 0.f, 0.f, 0.f}};
#pragma unroll
            for (int kk = 0; kk < 4; ++kk) { __builtin_amdgcn_sched_barrier(0); const int sb = 32 * kk + 8 * fq;
                const LAS bf16_t* bp = Bs + (sb + (fr >> 2)) * SP + 16 * w + 4 * (fr & 3); const bf16x8 bf = cat8(vtr(bp), vtr(bp + 4 * SP));
                const f32x4 s0 = *(const LAS f32x4*)(scl + sb), s1 = *(const LAS f32x4*)(scl + sb + 4);
#pragma unroll
                for (int mi = 0; mi < 2; ++mi) { const LAS bf16_t* xp = Xn + (sb + (fr >> 2)) * XP + 16 * mi + 4 * (fr & 3); const s16x4 x0 = vtr(xp), x1 = vtr(xp + 4 * XP);
                    const u32x2 a0 = __builtin_bit_cast(u32x2, x0), a1 = __builtin_bit_cast(u32x2, x1); u32x4 q;
                    q.x = pk2(bflo(a0.x) * s0[0], bfhi(a0.x) * s0[1]); q.y = pk2(bflo(a0.y) * s0[2], bfhi(a0.y) * s0[3]); q.z = pk2(bflo(a1.x) * s1[0], bfhi(a1.x) * s1[1]); q.w = pk2(bflo(a1.y) * s1[2], bfhi(a1.y) * s1[3]);
                    sa[mi] = MFMA16(bf, __builtin_bit_cast(bf16x8, q), sa[mi]); } }
            const float ee = __expf(las[127]);
#pragma unroll
            for (int mi = 0; mi < 2; ++mi) st[mi] = st[mi] * ee + sa[mi];
        }
        __syncthreads();
#pragma unroll
        for (int mi = 0; mi < 2; ++mi) { u32x2 wv; wv.x = pk2(st[mi][0], st[mi][1]); wv.y = pk2(st[mi][2], st[mi][3]); *(LAS u32x2*)(Hb + (16 * mi + fr) * SP + 16 * w + 4 * fq) = wv; }
    }
    float* so = c.out + O_SSP;
#pragma unroll
    for (int mi = 0; mi < 2; ++mi) *(f32x4*)(so + ((size_t)(b * 32 + h) * 64 + ph * 32 + 16 * mi + fr) * 128 + 16 * w + 4 * fq) = st[mi];
    __syncthreads();
}

DI void swa_prompt_unit(const Ctx& c, int unit) {
    const int b = unit >> 6, blk = (unit >> 2) & 15, kvh = unit & 3;
    int tid_ = c.tid; asm volatile("" : "+v"(tid_)); const int tid = tid_, lane = tid & 63, w = __builtin_amdgcn_readfirstlane(tid >> 6), fr = lane & 15, fq = lane >> 4;
    constexpr int KP = 72, VP = 72;
    LAS bf16_t* Ks = (LAS bf16_t*)(c.lds); LAS bf16_t* Vn = (LAS bf16_t*)(c.lds + 36864);
    const bf16_t* PROJ = (const bf16_t*)(c.ws + WS_PROJ); bf16_t* MIX = (bf16_t*)(c.ws + WS_MIX);
    {
        const int key = tid >> 1, half = tid & 1, tk = blk * 128 - 128 + key;
        const bf16_t* pr = PROJ + ((size_t)b * SEQ + (tk >= 0 ? tk : 0)) * DINP;
        const bool wout = (blk == 15 && key >= 128);
        unsigned ooff = (unsigned)(((b * 128 + (key & 127)) * 4 + kvh) * 64 + half * 32); asm volatile("" : "+v"(ooff));
        {
            float kf[32]; float sq = 0.f;
#pragma unroll
            for (int i = 0; i < 4; ++i) unpack8(*(const u32x4*)(pr + C_K + kvh * 64 + half * 32 + i * 8), kf + 8 * i);
#pragma unroll
            for (int i = 0; i < 32; ++i) sq += kf[i] * kf[i];
            sq += __shfl_xor(sq, 1); const float rs = (tk >= 0) ? rsqrtf(sq * (1.f / 64.f) + EPS) : 0.f; const float* kg = IN_(I_KG) + half * 32;
#pragma unroll
            for (int i = 0; i < 4; ++i) { const f32x4 g0 = *(const f32x4*)(kg + 8 * i), g1 = *(const f32x4*)(kg + 8 * i + 4);
                const f32x4 k0 = (f32x4){kf[8 * i], kf[8 * i + 1], kf[8 * i + 2], kf[8 * i + 3]} * g0 * rs, k1 = (f32x4){kf[8 * i + 4], kf[8 * i + 5], kf[8 * i + 6], kf[8 * i + 7]} * g1 * rs;
                u32x4 q; q.x = pk2(k0[0], k0[1]); q.y = pk2(k0[2], k0[3]); q.z = pk2(k1[0], k1[1]); q.w = pk2(k1[2], k1[3]);
                *(LAS u32x4*)(Ks + key * KP + half * 32 + i * 8) = q;
                if (wout) { float* ok = c.out + O_SKP + ooff; *(f32x4*)(ok + 8 * i) = k0; *(f32x4*)(ok + 8 * i + 4) = k1; } }
        }
        asm volatile("" ::: "memory");
        {
            float vf[32];
#pragma unroll
            for (int i = 0; i < 4; ++i) unpack8(*(const u32x4*)(pr + C_V + kvh * 64 + half * 32 + i * 8), vf + 8 * i);
            if (tk < 0) {
#pragma unroll
                for (int i = 0; i < 32; ++i) vf[i] = 0.f;
            }
#pragma unroll
            for (int i = 0; i < 4; ++i) { u32x4 q; q.x = pk2(vf[8 * i], vf[8 * i + 1]); q.y = pk2(vf[8 * i + 2], vf[8 * i + 3]); q.z = pk2(vf[8 * i + 4], vf[8 * i + 5]); q.w = pk2(vf[8 * i + 6], vf[8 * i + 7]);
                *(LAS u32x4*)(Vn + key * VP + half * 32 + i * 8) = q; }
            if (wout) { float* ov = c.out + O_SVP + ooff;
#pragma unroll
                for (int i = 0; i < 8; ++i) *(f32x4*)(ov + 4 * i) = (f32x4){vf[4 * i], vf[4 * i + 1], vf[4 * i + 2], vf[4 * i + 3]}; }
        }
    }
    __syncthreads();
#pragma unroll 1
    for (int it = 0; it < 4; ++it) {
        const int combo = w * 2 + (it >> 1), mi = it & 1, gq = combo & 3, rg = combo >> 2, head = kvh * 4 + gq; const float sink = IN_(I_SINK)[head];
        const int r = 16 * mi + fr; const size_t row = (size_t)b * SEQ + blk * 128 + 32 * rg + r;
        bf16x8 qf[2];
        { float f[16]; float sq = 0.f;
#pragma unroll
            for (int kk = 0; kk < 2; ++kk) unpack8(*(const u32x4*)(PROJ + row * DINP + C_Q + head * 64 + kk * 32 + fq * 8), f + 8 * kk);
#pragma unroll
            for (int i = 0; i < 16; ++i) sq += f[i] * f[i];
            sq += __shfl_xor(sq, 16); sq += __shfl_xor(sq, 32); const float rs = rsqrtf(sq * (1.f / 64.f) + EPS) * 0.125f;
#pragma unroll
            for (int kk = 0; kk < 2; ++kk) { const float* qg = IN_(I_QG) + kk * 32 + fq * 8; u32x4 q; q.x = pk2(f[8 * kk] * rs * qg[0], f[8 * kk + 1] * rs * qg[1]); q.y = pk2(f[8 * kk + 2] * rs * qg[2], f[8 * kk + 3] * rs * qg[3]);
                q.z = pk2(f[8 * kk + 4] * rs * qg[4], f[8 * kk + 5] * rs * qg[5]); q.w = pk2(f[8 * kk + 6] * rs * qg[6], f[8 * kk + 7] * rs * qg[7]); qf[kk] = __builtin_bit_cast(bf16x8, q); } }
        f32x4 S[10];
#pragma unroll
        for (int ni = 0; ni < 10; ++ni) S[ni] = (f32x4){0.f, 0.f, 0.f, 0.f};
#pragma unroll
        for (int ni = 0; ni < 10; ++ni)
#pragma unroll
            for (int kk = 0; kk < 2; ++kk) { __builtin_amdgcn_sched_barrier(0); const bf16x8 bf = *(const LAS bf16x8*)(Ks + (32 * rg + 16 * ni + fr) * KP + kk * 32 + fq * 8); S[ni] = MFMA16(bf, qf[kk], S[ni]); }
        float mx = sink;
        const int lowlim = blk > 0 ? -100000 : 128 - 32 * rg; const int lo_ = r > lowlim ? r : lowlim;
        int xoff = 4 * fq - lo_; const unsigned hi_ = (unsigned)(r + 128 - lo_); asm volatile("" : "+v"(xoff));
#pragma unroll
        for (int ni = 0; ni < 10; ++ni)
#pragma unroll
            for (int j = 0; j < 4; ++j) { const bool ok = (unsigned)(xoff + (16 * ni + j)) <= hi_;
                S[ni][j] = ok ? S[ni][j] : -1e30f; mx = fmaxf(mx, S[ni][j]); }
        mx = fmaxf(mx, __shfl_xor(mx, 16)); mx = fmaxf(mx, __shfl_xor(mx, 32));
        float sm = 0.f;
#pragma unroll
        for (int ni = 0; ni < 10; ++ni)
#pragma unroll
            for (int j = 0; j < 4; ++j) { const float p = __expf(S[ni][j] - mx); S[ni][j] = p; sm += p; }
        sm += __shfl_xor(sm, 16); sm += __shfl_xor(sm, 32); sm += __expf(sink - mx);
        const float inv = 1.f / sm;
        f32x4 O[4];
#pragma unroll
        for (int nd = 0; nd < 4; ++nd) O[nd] = (f32x4){0.f, 0.f, 0.f, 0.f};
#pragma unroll
        for (int k2 = 0; k2 < 5; ++k2) { __builtin_amdgcn_sched_barrier(0); u32x4 pa; pa.x = pk2(S[2 * k2][0], S[2 * k2][1]); pa.y = pk2(S[2 * k2][2], S[2 * k2][3]); pa.z = pk2(S[2 * k2 + 1][0], S[2 * k2 + 1][1]); pa.w = pk2(S[2 * k2 + 1][2], S[2 * k2 + 1][3]);
            const bf16x8 af = __builtin_bit_cast(bf16x8, pa);
#pragma unroll
            for (int nd = 0; nd < 4; ++nd) { const LAS bf16_t* vp = Vn + (32 * rg + 32 * k2 + 4 * fq + (fr >> 2)) * VP + 16 * nd + 4 * (fr & 3);
                O[nd] = MFMA16(cat8(vtr(vp), vtr(vp + 16 * VP)), af, O[nd]); } }
#pragma unroll
        for (int nd = 0; nd < 4; ++nd) { const f32x4 o = O[nd] * inv; u32x2 wv; wv.x = pk2(o[0], o[1]); wv.y = pk2(o[2], o[3]); *(u32x2*)(MIX + row * DMIX + 2048 + head * 64 + 16 * nd + 4 * fq) = wv; }
    }
    __syncthreads();
}

DI void swa_sample_pair(const Ctx& c, int P) {
    int tid_ = c.tid; asm volatile("" : "+v"(tid_)); const int tid = tid_, lane = tid & 63, w = __builtin_amdgcn_readfirstlane(tid >> 6);
    const int combo = 2 * P + (w >> 2), q4 = w & 3, b = combo >> 2, kvh = combo & 3;
    LAS float* qs = (LAS float*)(c.lds + w * 4096); LAS float* ps = qs + 256; LAS float* po = qs + 384; LAS float* pm = qs + 640; LAS float* psm = qs + 644;
    const bf16_t* pr = (const bf16_t*)(c.ws + WS_PROJ) + (size_t)(MP + b) * DINP; bf16_t* MIX = (bf16_t*)(c.ws + WS_MIX);
    const float* ck = IN_(I_CSK); const float* cv = IN_(I_CSV); float* ok = c.out + O_SKS; float* ov = c.out + O_SVS;
#pragma unroll
    for (int g = 0; g < 4; ++g) { const float qr = bf1(pr[C_Q + (kvh * 4 + g) * 64 + lane]); const float s2 = wave_sum(qr * qr); qs[g * 64 + lane] = qr * rsqrtf(s2 * (1.f / 64.f) + EPS) * IN_(I_QG)[lane] * 0.125f; }
    LDS_FENCE();
    const int s = 32 * q4 + (lane & 31), half = lane >> 5;
    float lg[4];
    {
        const float* kr = ck + ((size_t)(b * 128 + s) * 4 + kvh) * 64 + half * 32; f32x4 kv[8];
#pragma unroll
        for (int i = 0; i < 8; ++i) kv[i] = *(const f32x4*)(kr + 4 * i);
        if (s >= 1) { float* kw = ok + ((size_t)(b * 128 + s - 1) * 4 + kvh) * 64 + half * 32;
#pragma unroll
            for (int i = 0; i < 8; ++i) *(f32x4*)(kw + 4 * i) = kv[i]; }
#pragma unroll
        for (int g = 0; g < 4; ++g) { float a = 0.f;
#pragma unroll
            for (int i = 0; i < 8; ++i) { const f32x4 qv = *(const LAS f32x4*)(qs + g * 64 + half * 32 + 4 * i); a += (kv[i].x * qv.x + kv[i].y * qv.y) + (kv[i].z * qv.z + kv[i].w * qv.w); }
            a += __shfl_xor(a, 32); lg[g] = a; }
    }
#pragma unroll
    for (int g = 0; g < 4; ++g) { const float mx = wave_max(lg[g]); const float p = __expf(lg[g] - mx); const float sm = wave_sum(lane < 32 ? p : 0.f);
        if (lane < 32) ps[g * 32 + lane] = p; if (lane == 0) { pm[g] = mx; psm[g] = sm; } }
    LDS_FENCE();
    {
        float o[4] = {0.f, 0.f, 0.f, 0.f};
#pragma unroll 1
        for (int i0 = 0; i0 < 32; i0 += 8) { float v[8];
#pragma unroll
            for (int i = 0; i < 8; ++i) v[i] = cv[((size_t)(b * 128 + 32 * q4 + i0 + i) * 4 + kvh) * 64 + lane];
#pragma unroll
            for (int i = 0; i < 8; ++i) { const int sk = 32 * q4 + i0 + i; if (sk >= 1) ov[((size_t)(b * 128 + sk - 1) * 4 + kvh) * 64 + lane] = v[i];
#pragma unroll
                for (int g = 0; g < 4; ++g) o[g] += ps[g * 32 + i0 + i] * v[i]; } }
#pragma unroll
        for (int g = 0; g < 4; ++g) po[g * 64 + lane] = o[g];
    }
    __syncthreads();
    if (q4 == 0) {
        const float kraw = bf1(pr[C_K + kvh * 64 + lane]); const float ss = wave_sum(kraw * kraw); const float knew = kraw * rsqrtf(ss * (1.f / 64.f) + EPS) * IN_(I_KG)[lane];
        const float vnew = bf1(pr[C_V + kvh * 64 + lane]);
        ok[((size_t)(b * 128 + 127) * 4 + kvh) * 64 + lane] = knew; ov[((size_t)(b * 128 + 127) * 4 + kvh) * 64 + lane] = vnew;
#pragma unroll
        for (int g = 0; g < 4; ++g) { const float lnew = wave_sum(qs[g * 64 + lane] * knew), sink = IN_(I_SINK)[kvh * 4 + g];
            float m[4], sm[4]; float M = fmaxf(lnew, sink);
#pragma unroll
            for (int j = 0; j < 4; ++j) { const LAS float* qj = qs + j * 1024; m[j] = qj[640 + g]; sm[j] = qj[644 + g]; M = fmaxf(M, m[j]); }
            float S = __expf(lnew - M) + __expf(sink - M), o = __expf(lnew - M) * vnew;
#pragma unroll
            for (int j = 0; j < 4; ++j) { const float e = __expf(m[j] - M); S += sm[j] * e; o += (qs + j * 1024)[384 + g * 64 + lane] * e; }
            MIX[(size_t)(MP + b) * DMIX + 2048 + (kvh * 4 + g) * 64 + lane] = f2bf(o / S); }
    }
    __syncthreads();
}

DI void ssd_sample_wave(const Ctx& c, int wu) {
    int lane_ = c.lane; asm volatile("" : "+v"(lane_)); const int b = wu >> 5, h = wu & 31, g = h >> 3, lane = lane_;
    LAS float* xs = (LAS float*)(c.lds + c.wave * 4096); LAS float* Bsm = xs + 64; LAS float* Csm = xs + 192;
    const bf16_t* pr = (const bf16_t*)(c.ws + WS_PROJ) + (size_t)(MP + b) * DINP; bf16_t* MIX = (bf16_t*)(c.ws + WS_MIX);
    const float* cw = IN_(I_SCW); const float* cb = IN_(I_SCB); const float* scs = IN_(I_SSC) + (size_t)b * 3 * CONVD;
#pragma unroll
    for (int q = 0; q < 5; ++q) { const int cch = q == 0 ? h * 64 + lane : (q < 3 ? 2048 + g * 128 + (q - 1) * 64 + lane : 2560 + g * 128 + (q - 3) * 64 + lane);
        float v = cb[cch] + cw[cch] * scs[cch] + cw[CONVD + cch] * scs[CONVD + cch] + cw[2 * CONVD + cch] * scs[2 * CONVD + cch] + cw[3 * CONVD + cch] * bf1(pr[C_XBC + cch]);
        v = silu_f(v); if (q == 0) xs[lane] = v; else if (q < 3) Bsm[(q - 1) * 64 + lane] = v; else Csm[(q - 3) * 64 + lane] = v; }
    LDS_FENCE();
    const float dt = softplus_f(((const float*)(c.ws + WS_DT))[(size_t)(MP + b) * 32 + h] + IN_(I_DTB)[h]); const float dA = __expf(-dt * __expf(IN_(I_ALOG)[h])), Dh = IN_(I_DSK)[h];
    const int n4 = (lane & 31) * 4, psub = lane >> 5;
    const f32x4 Bv = *(const LAS f32x4*)(Bsm + n4), Cv = *(const LAS f32x4*)(Csm + n4);
    const float* hs = IN_(I_SS) + (size_t)(b * 32 + h) * 64 * 128; float* ho = c.out + O_SSS + (size_t)(b * 32 + h) * 64 * 128;
    float sq = 0.f;
#pragma unroll 1
    for (int it0 = 0; it0 < 32; it0 += 16) { f32x4 hv[16];
#pragma unroll
        for (int i = 0; i < 16; ++i) hv[i] = *(const f32x4*)(hs + (2 * (it0 + i) + psub) * 128 + n4);
#pragma unroll
        for (int i = 0; i < 16; ++i) { const int p = 2 * (it0 + i) + psub; const float xv = xs[p], xb = dt * xv;
            const f32x4 hn = hv[i] * dA + Bv * xb; *(f32x4*)(ho + p * 128 + n4) = hn;
            float part = (hn.x * Cv.x + hn.y * Cv.y) + (hn.z * Cv.z + hn.w * Cv.w);
#pragma unroll
            for (int o = 1; o < 32; o <<= 1) part += __shfl_xor(part, o);
            if ((lane & 31) == 0) { float yv = part + Dh * xv; yv *= silu_f(bf1(pr[C_Z + h * 64 + p])); sq += yv * yv; MIX[(size_t)(MP + b) * DMIX + h * 64 + p] = f2bf(yv); } } }
    sq = wave_sum(sq); if (lane == 0) atomicAdd((float*)(c.ws + WS_SSQ) + (c.dry ? 3 * MPAD : 0) + MP + b, sq);
    LDS_FENCE();
}

DI void p2_mixers(const Ctx& c) {
#ifndef P2SEL
#define P2SEL 15
#endif
#ifndef DRYSEL
#define DRYSEL 15
#endif
    const int sel_ = c.dry ? (DRYSEL) : (P2SEL);
    if (sel_ & 1) for (int u = c.bid; u < 256; u += c.G) ssd_prompt_unit(c, u);
    if (sel_ & 2) for (int u = c.bid; u < 256; u += c.G) swa_prompt_unit(c, u);
    const int gw = c.bid * 8 + c.wave, NGW = c.G * 8, lane = c.lane;
    if (sel_ & 4) for (int u = gw; u < 4096; u += NGW) ssd_sample_wave(c, u);
    if (sel_ & 8) for (int u = c.bid; u < 256; u += c.G) swa_sample_pair(c, u);
    if (!c.dry) for (int u = gw; u < 4096; u += NGW) { float* p = c.out + O_MKP + (size_t)u * 128; f32x2 v = ((f32x2*)p)[lane]; const float rs = rsqrtf(wave_sum(v.x * v.x + v.y * v.y) * (1.f / 128.f) + EPS);
        const f32x2 gg = ((const f32x2*)IN_(I_CKG))[lane]; v.x *= rs * gg.x; v.y *= rs * gg.y; ((f32x2*)p)[lane] = v; }
    const bf16_t* PROJ = (const bf16_t*)(c.ws + WS_PROJ);
    for (int i = c.bid * 512 + c.tid; i < NB * 3 * CONVD; i += c.G * 512) { const int b = i / (3 * CONVD), j = (i / CONVD) % 3, ch = i % CONVD; c.out[O_SCP + i] = bf1(PROJ[((size_t)b * SEQ + 2045 + j) * DINP + C_XBC + ch]); }
    for (int i = c.bid * 512 + c.tid; i < MS * 3 * CONVD; i += c.G * 512) { const int b = i / (3 * CONVD), j = (i / CONVD) % 3, ch = i % CONVD;
        c.out[O_SCS + i] = j < 2 ? IN_(I_SSC)[((size_t)b * 3 + j + 1) * CONVD + ch] : bf1(PROJ[(size_t)(MP + b) * DINP + C_XBC + ch]); }
}

DI void xattn_prompt_unit(const Ctx& c, int unit) {
    const int b = unit >> 6, head = (unit >> 4) & 3, qb = unit & 15;
    int tid_ = c.tid; asm volatile("" : "+v"(tid_)); const int tid = tid_, lane = tid & 63, w = __builtin_amdgcn_readfirstlane(tid >> 6), fr = lane & 15, fq = lane >> 4;
    constexpr int KP = 136, VP = 136;
    LAS bf16_t* Ks = (LAS bf16_t*)(c.lds); LAS bf16_t* Vn = (LAS bf16_t*)(c.lds + 69632);
    {
        const int key = tid >> 1, half = tid & 1; const float* kp = c.out + O_MKP + ((size_t)(b * 256 + key) * 4 + head) * 128 + half * 64; const float* vp = c.out + O_MVP + ((size_t)(b * 256 + key) * 4 + head) * 128 + half * 64;
#pragma unroll
        for (int i = 0; i < 8; ++i) { const f32x4 a = *(const f32x4*)(kp + 8 * i), bb = *(const f32x4*)(kp + 8 * i + 4); u32x4 q; q.x = pk2(a.x, a.y); q.y = pk2(a.z, a.w); q.z = pk2(bb.x, bb.y); q.w = pk2(bb.z, bb.w);
            *(LAS u32x4*)(Ks + key * KP + half * 64 + 8 * i) = q; }
#pragma unroll
        for (int i = 0; i < 8; ++i) { const f32x4 a = *(const f32x4*)(vp + 8 * i), bb = *(const f32x4*)(vp + 8 * i + 4); u32x4 q; q.x = pk2(a.x, a.y); q.y = pk2(a.z, a.w); q.z = pk2(bb.x, bb.y); q.w = pk2(bb.z, bb.w);
            *(LAS u32x4*)(Vn + key * VP + half * 64 + 8 * i) = q; }
    }
    __syncthreads();
    const bf16_t* QC = (const bf16_t*)(c.ws + WS_QC); bf16_t* OC = (bf16_t*)(c.ws + WS_OC);
    const size_t row = (size_t)b * SEQ + qb * 128 + 16 * w + fr;
    bf16x8 qf[4];
    { float f[32]; float sq = 0.f;
#pragma unroll
        for (int kk = 0; kk < 4; ++kk) unpack8(*(const u32x4*)(QC + row * DXA + head * 128 + kk * 32 + fq * 8), f + 8 * kk);
#pragma unroll
        for (int i = 0; i < 32; ++i) sq += f[i] * f[i];
        sq += __shfl_xor(sq, 16); sq += __shfl_xor(sq, 32); const float rs = rsqrtf(sq * (1.f / 128.f) + EPS) * 0.08838834764831845f;
#pragma unroll
        for (int kk = 0; kk < 4; ++kk) { const float* qg = IN_(I_CQG) + kk * 32 + fq * 8; u32x4 q; q.x = pk2(f[8 * kk] * rs * qg[0], f[8 * kk + 1] * rs * qg[1]); q.y = pk2(f[8 * kk + 2] * rs * qg[2], f[8 * kk + 3] * rs * qg[3]);
            q.z = pk2(f[8 * kk + 4] * rs * qg[4], f[8 * kk + 5] * rs * qg[5]); q.w = pk2(f[8 * kk + 6] * rs * qg[6], f[8 * kk + 7] * rs * qg[7]); qf[kk] = __builtin_bit_cast(bf16x8, q); } }
    f32x4 S[16];
#pragma unroll
    for (int ni = 0; ni < 16; ++ni) S[ni] = (f32x4){0.f, 0.f, 0.f, 0.f};
#pragma unroll
    for (int ni = 0; ni < 16; ++ni)
#pragma unroll
        for (int kk = 0; kk < 4; ++kk) { __builtin_amdgcn_sched_barrier(0); const bf16x8 bf = *(const LAS bf16x8*)(Ks + (16 * ni + fr) * KP + kk * 32 + fq * 8); S[ni] = MFMA16(bf, qf[kk], S[ni]); }
    float mx = -1e30f;
#pragma unroll
    for (int ni = 0; ni < 16; ++ni)
#pragma unroll
        for (int j = 0; j < 4; ++j) mx = fmaxf(mx, S[ni][j]);
    mx = fmaxf(mx, __shfl_xor(mx, 16)); mx = fmaxf(mx, __shfl_xor(mx, 32));
    float sm = 0.f;
#pragma unroll
    for (int ni = 0; ni < 16; ++ni)
#pragma unroll
        for (int j = 0; j < 4; ++j) { const float p = __expf(S[ni][j] - mx); S[ni][j] = p; sm += p; }
    sm += __shfl_xor(sm, 16); sm += __shfl_xor(sm, 32); const float inv = 1.f / sm;
    f32x4 O[8];
#pragma unroll
    for (int nd = 0; nd < 8; ++nd) O[nd] = (f32x4){0.f, 0.f, 0.f, 0.f};
#pragma unroll
    for (int k2 = 0; k2 < 8; ++k2) { __builtin_amdgcn_sched_barrier(0); u32x4 pa; pa.x = pk2(S[2 * k2][0], S[2 * k2][1]); pa.y = pk2(S[2 * k2][2], S[2 * k2][3]); pa.z = pk2(S[2 * k2 + 1][0], S[2 * k2 + 1][1]); pa.w = pk2(S[2 * k2 + 1][2], S[2 * k2 + 1][3]);
        const bf16x8 af = __builtin_bit_cast(bf16x8, pa);
#pragma unroll
        for (int nd = 0; nd < 8; ++nd) { const LAS bf16_t* vp = Vn + (32 * k2 + 4 * fq + (fr >> 2)) * VP + 16 * nd + 4 * (fr & 3);
            O[nd] = MFMA16(cat8(vtr(vp), vtr(vp + 16 * VP)), af, O[nd]); } }
#pragma unroll
    for (int nd = 0; nd < 8; ++nd) { const f32x4 o = O[nd] * inv; u32x2 wv; wv.x = pk2(o[0], o[1]); wv.y = pk2(o[2], o[3]); *(u32x2*)(OC + row * DXA + head * 128 + 16 * nd + 4 * fq) = wv; }
    __syncthreads();
}
DI void xattn_sample_pair(const Ctx& c, int P) {
    int tid_ = c.tid; asm volatile("" : "+v"(tid_)); const int tid = tid_, lane = tid & 63, w = __builtin_amdgcn_readfirstlane(tid >> 6);
    const int combo = 2 * P + (w >> 2), q4 = w & 3, b = combo >> 2, head = combo & 3;
    LAS float* qs = (LAS float*)(c.lds + w * 4096); LAS float* ps = qs + 128; LAS float* po = qs + 192; LAS float* pm = qs + 320;
    const bf16_t* QC = (const bf16_t*)(c.ws + WS_QC); bf16_t* OC = (bf16_t*)(c.ws + WS_OC);
    const unsigned qw = *(const unsigned*)(QC + (size_t)(MP + b) * DXA + head * 128 + 2 * lane); const float q0 = bflo(qw), q1 = bfhi(qw);
    const float rs = rsqrtf(wave_sum(q0 * q0 + q1 * q1) * (1.f / 128.f) + EPS) * 0.08838834764831845f; const f32x2 gg = ((const f32x2*)IN_(I_CQG))[lane];
    qs[2 * lane] = q0 * rs * gg.x; qs[2 * lane + 1] = q1 * rs * gg.y;
    LDS_FENCE();
    const int m0 = 64 * q4;
    float lg;
    { const float* kr = IN_(I_CMK) + ((size_t)(b * 256 + m0 + lane) * 4 + head) * 128; float a = 0.f;
#pragma unroll 1
        for (int d0 = 0; d0 < 32; d0 += 8) { f32x4 kv[8];
#pragma unroll
            for (int i = 0; i < 8; ++i) kv[i] = *(const f32x4*)(kr + 4 * (d0 + i));
#pragma unroll
            for (int i = 0; i < 8; ++i) { const f32x4 qv = *(const LAS f32x4*)(qs + 4 * (d0 + i)); a += (kv[i].x * qv.x + kv[i].y * qv.y) + (kv[i].z * qv.z + kv[i].w * qv.w); } }
        lg = a; }
    const float mx = wave_max(lg); const float p = __expf(lg - mx); const float sm = wave_sum(p);
    ps[lane] = p; if (lane == 0) { pm[0] = mx; pm[1] = sm; }
    LDS_FENCE();
    { float o0 = 0.f, o1 = 0.f; const float* vr = IN_(I_CMV) + ((size_t)(b * 256 + m0) * 4 + head) * 128 + 2 * lane;
#pragma unroll 1
        for (int i0 = 0; i0 < 64; i0 += 16) { f32x2 v[16];
#pragma unroll
            for (int i = 0; i < 16; ++i) v[i] = *(const f32x2*)(vr + (size_t)(i0 + i) * 512);
#pragma unroll
            for (int i = 0; i < 16; ++i) { const float pp = ps[i0 + i]; o0 += pp * v[i].x; o1 += pp * v[i].y; } }
        po[2 * lane] = o0; po[2 * lane + 1] = o1; }
    __syncthreads();
    if (q4 == 0) {
        float m[4], sm4[4]; float M = -1e30f;
#pragma unroll
        for (int j = 0; j < 4; ++j) { const LAS float* qj = qs + j * 1024; m[j] = qj[320]; sm4[j] = qj[321]; M = fmaxf(M, m[j]); }
        float S = 0.f, o0 = 0.f, o1 = 0.f;
#pragma unroll
        for (int j = 0; j < 4; ++j) { const float e = __expf(m[j] - M); S += sm4[j] * e; o0 += (qs + j * 1024)[192 + 2 * lane] * e; o1 += (qs + j * 1024)[192 + 2 * lane + 1] * e; }
        const float inv = 1.f / S;
        *(unsigned*)(OC + (size_t)(MP + b) * DXA + head * 128 + 2 * lane) = pk2(o0 * inv, o1 * inv);
    }
    __syncthreads();
}

DI void p8_convgate(const Ctx& c) {
    const bf16_t* U = (const bf16_t*)(c.ws + WS_U); bf16_t* H = (bf16_t*)(c.ws + WS_H);
    const float* fw = IN_(I_FCW); const float* fb = IN_(I_FCB);
    const int gw = c.bid * 8 + c.wave, NGW = c.G * 8, lane = c.lane;
    for (int task = gw; task < 512 * 11; task += NGW) {
        const int seg = task / 11, j8 = (task % 11) * 64 + lane, r0 = seg * 16, tl0 = r0 & (SEQ - 1), b = r0 >> 11;
        float wg[3][8], wv[3][8], bg[8], bv[8];
#pragma unroll
        for (int i = 0; i < 3; ++i) { const f32x4 a = *(const f32x4*)(fw + (size_t)i * DFF2 + j8 * 8), a2 = *(const f32x4*)(fw + (size_t)i * DFF2 + j8 * 8 + 4), d = *(const f32x4*)(fw + (size_t)i * DFF2 + DFF + j8 * 8), d2 = *(const f32x4*)(fw + (size_t)i * DFF2 + DFF + j8 * 8 + 4);
            wg[i][0] = a.x; wg[i][1] = a.y; wg[i][2] = a.z; wg[i][3] = a.w; wg[i][4] = a2.x; wg[i][5] = a2.y; wg[i][6] = a2.z; wg[i][7] = a2.w;
            wv[i][0] = d.x; wv[i][1] = d.y; wv[i][2] = d.z; wv[i][3] = d.w; wv[i][4] = d2.x; wv[i][5] = d2.y; wv[i][6] = d2.z; wv[i][7] = d2.w; }
        { const f32x4 a = *(const f32x4*)(fb + j8 * 8), a2 = *(const f32x4*)(fb + j8 * 8 + 4), d = *(const f32x4*)(fb + DFF + j8 * 8), d2 = *(const f32x4*)(fb + DFF + j8 * 8 + 4);
            bg[0] = a.x; bg[1] = a.y; bg[2] = a.z; bg[3] = a.w; bg[4] = a2.x; bg[5] = a2.y; bg[6] = a2.z; bg[7] = a2.w; bv[0] = d.x; bv[1] = d.y; bv[2] = d.z; bv[3] = d.w; bv[4] = d2.x; bv[5] = d2.y; bv[6] = d2.z; bv[7] = d2.w; }
        float g1[8], g2[8], v1[8], v2[8];
        if (tl0 == 0) {
#pragma unroll
            for (int j = 0; j < 8; ++j) { g1[j] = 0.f; g2[j] = 0.f; v1[j] = 0.f; v2[j] = 0.f; }
        } else { const bf16_t* up = U + (size_t)(r0 - 2) * DFF2 + j8 * 8; unpack8(*(const u32x4*)up, g1); unpack8(*(const u32x4*)(up + DFF), v1); unpack8(*(const u32x4*)(up + DFF2), g2); unpack8(*(const u32x4*)(up + DFF2 + DFF), v2); }
#pragma unroll 1
        for (int rb = 0; rb < 16; rb += 4) { u32x4 lg_[4], lv_[4];
#pragma unroll
          for (int r4 = 0; r4 < 4; ++r4) { const bf16_t* up = U + ((size_t)r0 + rb + r4) * DFF2 + j8 * 8; lg_[r4] = *(const u32x4*)up; lv_[r4] = *(const u32x4*)(up + DFF); }
#pragma unroll
          for (int r4 = 0; r4 < 4; ++r4) { const int r = rb + r4; const size_t row = (size_t)r0 + r; float g3[8], v3[8], o[8]; unpack8(lg_[r4], g3); unpack8(lv_[r4], v3);
#pragma unroll
            for (int j = 0; j < 8; ++j) { const float cgv = bg[j] + wg[0][j] * g1[j] + wg[1][j] * g2[j] + wg[2][j] * g3[j], cvv = bv[j] + wv[0][j] * v1[j] + wv[1][j] * v2[j] + wv[2][j] * v3[j]; o[j] = silu_f(cgv) * cvv; g1[j] = g2[j]; g2[j] = g3[j]; v1[j] = v2[j]; v2[j] = v3[j]; }
            u32x4 q; q.x = pk2(o[0], o[1]); q.y = pk2(o[2], o[3]); q.z = pk2(o[4], o[5]); q.w = pk2(o[6], o[7]); *(u32x4*)(H + row * DFF + j8 * 8) = q;
            const int tl = tl0 + r;
            if (tl >= SEQ - 2) { float* fo = c.out + O_FCP + ((size_t)b * 2 + (tl - (SEQ - 2))) * DFF2 + j8 * 8;
                *(f32x4*)fo = (f32x4){g3[0], g3[1], g3[2], g3[3]}; *(f32x4*)(fo + 4) = (f32x4){g3[4], g3[5], g3[6], g3[7]}; *(f32x4*)(fo + DFF) = (f32x4){v3[0], v3[1], v3[2], v3[3]}; *(f32x4*)(fo + DFF + 4) = (f32x4){v3[4], v3[5], v3[6], v3[7]}; } } }
    }
    for (int i = c.bid * 512 + c.tid; i < MS * 704; i += c.G * 512) { const int b = i / 704, j8 = i % 704; const size_t row = MP + b; const float* st = IN_(I_SFC) + (size_t)b * 2 * DFF2; float* fo = c.out + O_FCS + (size_t)b * 2 * DFF2;
        float g3[8], v3[8], o[8]; const bf16_t* up = U + row * DFF2 + j8 * 8; unpack8(*(const u32x4*)up, g3); unpack8(*(const u32x4*)(up + DFF), v3);
#pragma unroll
        for (int j = 0; j < 8; ++j) { const int cg_ = j8 * 8 + j, cv_ = DFF + cg_; const float g1 = st[cg_], g2 = st[DFF2 + cg_], v1 = st[cv_], v2 = st[DFF2 + cv_];
            const float cgv = fb[cg_] + fw[cg_] * g1 + fw[DFF2 + cg_] * g2 + fw[2 * DFF2 + cg_] * g3[j], cvv = fb[cv_] + fw[cv_] * v1 + fw[DFF2 + cv_] * v2 + fw[2 * DFF2 + cv_] * v3[j];
            o[j] = silu_f(cgv) * cvv; fo[cg_] = g2; fo[cv_] = v2; fo[DFF2 + cg_] = g3[j]; fo[DFF2 + cv_] = v3[j]; }
        u32x4 q; q.x = pk2(o[0], o[1]); q.y = pk2(o[2], o[3]); q.z = pk2(o[4], o[5]); q.w = pk2(o[6], o[7]); *(u32x4*)(H + row * DFF + j8 * 8) = q; }
}

struct Skinny { const bf16_t* A; const bf16_t* Bt; int K; int ksplit; const float* ssq_in; const float* base; float* out; bf16_t* abf; float* ssq; };
DI void skinny_tile(const Ctx& c, const Skinny& g, int ct) {
    int tid_ = c.tid; asm volatile("" : "+v"(tid_)); const int tid = tid_, lane = tid & 63, w = __builtin_amdgcn_readfirstlane(tid >> 6), fr = lane & 15, fq = lane >> 4;
    const int K = g.K, kw = K >> 3, k0 = w * kw;
    f32x4 acc[8];
#pragma unroll
    for (int mi = 0; mi < 8; ++mi) acc[mi] = (f32x4){0.f, 0.f, 0.f, 0.f};
    const bf16_t* ap = g.A + (size_t)fr * K + k0 + fq * 8; const bf16_t* bp = g.Bt + (size_t)(16 * ct + fr) * K + k0 + fq * 8;
#pragma unroll 2
    for (int ks = 0; ks < kw; ks += 32) {
        if (k0 + ks == g.ksplit && ks != 0) {
#pragma unroll
            for (int mi = 0; mi < 8; ++mi) acc[mi] = acc[mi] * rsqrtf(g.ssq_in[16 * mi + fr] * (1.f / 2048.f) + EPS);
        }
        const bf16x8 bf = *(const bf16x8*)(bp + ks);
#pragma unroll
        for (int mi = 0; mi < 8; ++mi) { const bf16x8 af = *(const bf16x8*)(ap + (size_t)mi * 16 * K + ks); acc[mi] = MFMA16(bf, af, acc[mi]); }
    }
    if (k0 + kw <= g.ksplit) {
#pragma unroll
        for (int mi = 0; mi < 8; ++mi) acc[mi] = acc[mi] * rsqrtf(g.ssq_in[16 * mi + fr] * (1.f / 2048.f) + EPS);
    }
    LAS f32x4* red = (LAS f32x4*)c.lds;
#pragma unroll
    for (int mi = 0; mi < 8; ++mi) red[(w * 8 + mi) * 64 + lane] = acc[mi];
    __syncthreads();
    f32x4 sum = (f32x4){0.f, 0.f, 0.f, 0.f};
#pragma unroll
    for (int ww = 0; ww < 8; ++ww) sum = sum + red[(ww * 8 + w) * 64 + lane];
    const int row = 16 * w + fr, col = 16 * ct + 4 * fq;
    const f32x4 o = *(const f32x4*)(g.base + (size_t)row * DM + col) + sum;
    *(f32x4*)(g.out + (size_t)row * DM + col) = o;
    if (g.abf) { u32x2 wv; wv.x = pk2(o[0], o[1]); wv.y = pk2(o[2], o[3]); *(u32x2*)(g.abf + (size_t)row * DM + col) = wv;
        float sq = (o[0] * o[0] + o[1] * o[1]) + (o[2] * o[2] + o[3] * o[3]); sq += __shfl_xor(sq, 16); sq += __shfl_xor(sq, 32); if (fq == 0) atomicAdd(g.ssq + row, sq); }
    __syncthreads();
}

__global__ void __launch_bounds__(512, 2) fwd_mega(Args args) {
    extern __shared__ __attribute__((aligned(16))) unsigned char lds_raw[];
    cg::grid_group grid = cg::this_grid();
    Ctx c; c.lds = (LAS unsigned char*)lds_raw; c.tid = threadIdx.x; c.lane = c.tid & 63; c.wave = __builtin_amdgcn_readfirstlane(c.tid >> 6); c.G = gridDim.x; c.bid = blockIdx.x;
    c.in = args.in; c.out = args.out; c.ws = args.ws; c.dry = 0;
    unsigned char* ws = args.ws;
    const int lo = args.ph_lo, hi = args.ph_hi;
#ifndef PHMASK
#define PHMASK 0x3ff
#endif
#define PH(k) ((((PHMASK) >> (k)) & 1) && lo <= (k) && (k) < hi)
#define SYNC(k) do { if (PH(k) && PH((k) + 1)) grid.sync(); } while (0)
#ifndef REPEAT_MASK
#define REPEAT_MASK 0
#endif
#define REP(k) (((REPEAT_MASK) >> (k)) & 1)
    float* SSQ = (float*)(ws + WS_SSQ);
    if (PH(0)) p0_prologue(c);
    if (REP(0)) { grid.sync(); p0_prologue(c); }
    SYNC(0);
    if (PH(1)) {
        { pg8::Gemm g{(const bf16_t*)(ws + WS_A0), (const bf16_t*)(ws + WS_WIN), MPAD, DINP, 2048}; pg8::StaticOrder S; S.init(MPAD, DINP, c.G, c.bid);
            EpiProj E{(bf16_t*)(ws + WS_PROJ), (float*)(ws + WS_DT), 0}; pg8::gemm_phase(c.lds, g, S, E); }
        { pg8::Gemm g{(const bf16_t*)(ws + WS_MEMN), (const bf16_t*)(ws + WS_WCKV), 1024, 1024, 2048}; pg8::StaticOrder S; S.init(1024, 1024, c.G, c.G - 1 - c.bid);
            EpiMem E{c.out + O_MKP, c.out + O_MVP, 0}; pg8::gemm_phase(c.lds, g, S, E); }
    }
    SYNC(1);
    if (PH(2)) { p1b_conv(c); grid.sync(); }
    if (PH(2)) p2_mixers(c);
    if (REP(2)) { grid.sync(); c.dry = 1; p2_mixers(c); c.dry = 0; }
    SYNC(2);
    if (PH(3)) { pg8::Gemm g{(const bf16_t*)(ws + WS_MIX), (const bf16_t*)(ws + WS_WOUT), MP, 2048, 3072}; pg8::StaticOrder S; S.init(MP, 2048, c.G, c.bid);
        EpiRes<true> E{IN_(I_XP), IN_(I_XS), (float*)(ws + WS_X1), (float*)(ws + WS_X1) + (size_t)MP * DM, (bf16_t*)(ws + WS_A0), SSQ + MPAD, SSQ, 32}; pg8::gemm_phase(c.lds, g, S, E);
        const Skinny sk{(const bf16_t*)(ws + WS_MIX) + (size_t)MP * DMIX, (const bf16_t*)(ws + WS_WOUT), 3072, 2048, SSQ + MP, IN_(I_XS), (float*)(ws + WS_X1) + (size_t)MP * DM, (bf16_t*)(ws + WS_A0) + (size_t)MP * DM, SSQ + MPAD + MP};
        for (int t = c.bid; t < 256; t += c.G) if ((t & 1) == 0) skinny_tile(c, sk, t >> 1); }
    SYNC(3);
    if (PH(4)) { pg8::Gemm g{(const bf16_t*)(ws + WS_A0), (const bf16_t*)(ws + WS_WCQ), MPAD, 512, 2048}; pg8::StaticOrder S; S.init(MPAD, 512, c.G, c.bid);
        EpiScale E{(bf16_t*)(ws + WS_QC), DXA, SSQ + MPAD, 0}; pg8::gemm_phase(c.lds, g, S, E); }
    SYNC(4);
    for (int rep = 0; rep < 1 + REP(5); ++rep) if (PH(5)) {
        if (rep) grid.sync();
        for (int u = c.bid; u < 256; u += c.G) xattn_prompt_unit(c, u);
        for (int u = c.bid; u < 256; u += c.G) xattn_sample_pair(c, u);
    }
    SYNC(5);
    if (PH(6)) { pg8::Gemm g{(const bf16_t*)(ws + WS_OC), (const bf16_t*)(ws + WS_WCO), MP, 2048, 512}; pg8::StaticOrder S; S.init(MP, 2048, c.G, c.bid);
        float* X1 = (float*)(ws + WS_X1);
        EpiRes<false> E{X1, X1 + (size_t)MP * DM, X1, X1 + (size_t)MP * DM, (bf16_t*)(ws + WS_A0), SSQ + 2 * MPAD, nullptr, 0}; pg8::gemm_phase(c.lds, g, S, E);
        const Skinny sk{(const bf16_t*)(ws + WS_OC) + (size_t)MP * DXA, (const bf16_t*)(ws + WS_WCO), 512, -1, nullptr, X1 + (size_t)MP * DM, X1 + (size_t)MP * DM, (bf16_t*)(ws + WS_A0) + (size_t)MP * DM, SSQ + 2 * MPAD + MP};
        for (int t = c.bid; t < 256; t += c.G) if ((t & 1) == 0) skinny_tile(c, sk, t >> 1); }
    SYNC(6);
    if (PH(7)) { pg8::Gemm g{(const bf16_t*)(ws + WS_A0), (const bf16_t*)(ws + WS_WUP), MPAD, DFF2, 2048}; pg8::StaticOrder S; S.init(MPAD, DFF2, c.G, c.bid);
        EpiScale E{(bf16_t*)(ws + WS_U), DFF2, SSQ + 2 * MPAD, 0}; pg8::gemm_phase(c.lds, g, S, E); }
    SYNC(7);
    if (PH(8)) p8_convgate(c);
    if (REP(8)) { grid.sync(); p8_convgate(c); }
    SYNC(8);
    if (PH(9)) { pg8::Gemm g{(const bf16_t*)(ws + WS_H), (const bf16_t*)(ws + WS_WDN), MP, 2048, DFF}; pg8::StaticOrder S; S.init(MP, 2048, c.G, c.bid);
        const float* X1 = (const float*)(ws + WS_X1);
        EpiRes<false> E{X1, X1 + (size_t)MP * DM, c.out + O_Y, c.out + O_YS, nullptr, nullptr, nullptr, 0}; pg8::gemm_phase(c.lds, g, S, E);
        const Skinny sk{(const bf16_t*)(ws + WS_H) + (size_t)MP * DFF, (const bf16_t*)(ws + WS_WDN), DFF, -1, nullptr, X1 + (size_t)MP * DM, c.out + O_YS, nullptr, nullptr};
        for (int t = c.bid; t < 256; t += c.G) if ((t & 1) == 0) skinny_tile(c, sk, t >> 1); }
}

extern "C" void kernel_launch(void* const* d_in, const int* in_sizes, int n_in, void* d_out, int out_size, void* d_ws, size_t ws_size, hipStream_t stream) {
    static int grid = 0;
    if (grid == 0) {
        if (n_in != 35 || (size_t)out_size != O_END || ws_size < WS_END) { fprintf(stderr, "kernel_launch: unexpected shapes n_in %d out %d ws %zu (need %zu)\n", n_in, out_size, ws_size, (size_t)WS_END); grid = -1; return; }
        int dev = 0, cus = 0, per_cu = 0;
        hipGetDevice(&dev);
        hipDeviceGetAttribute(&cus, hipDeviceAttributeMultiprocessorCount, dev);
        hipFuncSetAttribute((const void*)fwd_mega, hipFuncAttributeMaxDynamicSharedMemorySize, LDS_BYTES);
        hipOccupancyMaxActiveBlocksPerMultiprocessor(&per_cu, (const void*)fwd_mega, 512, LDS_BYTES);
        if (per_cu < 1) fprintf(stderr, "kernel_launch: occupancy query says %d blocks/CU\n", per_cu);
        grid = cus;
    }
    if (grid < 0) return;
    Args a{};
    for (int i = 0; i < 35; ++i) a.in[i] = (const float*)d_in[i];
    a.out = (float*)d_out; a.ws = (unsigned char*)d_ws; a.ph_lo = 0; a.ph_hi = 10;
    void* args[] = {&a};
    hipError_t e = hipLaunchCooperativeKernel((const void*)fwd_mega, dim3(grid), dim3(512), args, LDS_BYTES, stream);
    if (e != hipSuccess) fprintf(stderr, "cooperative launch failed: %s (grid %d)\n", hipGetErrorString(e), grid);
}
```

```cpp
#include <hip/hip_runtime.h>
#include <hip/hip_cooperative_groups.h>
#include <cstdio>
#include <cstdint>
namespace cg = cooperative_groups;

#define DI __device__ __forceinline__
#define LAS __attribute__((address_space(3)))
typedef unsigned short bf16_t;
typedef short bf16x8 __attribute__((ext_vector_type(8)));
typedef short s16x4 __attribute__((ext_vector_type(4)));
typedef float f32x4 __attribute__((ext_vector_type(4)));
typedef float f32x2 __attribute__((ext_vector_type(2)));
typedef unsigned u32x4 __attribute__((ext_vector_type(4)));
typedef unsigned u32x2 __attribute__((ext_vector_type(2)));
typedef __bf16 bf16x2_t __attribute__((ext_vector_type(2)));

DI unsigned pk2(float lo, float hi) { f32x2 v = {lo, hi}; bf16x2_t b = __builtin_convertvector(v, bf16x2_t); return __builtin_bit_cast(unsigned, b); }
DI float bflo(unsigned w) { return __uint_as_float(w << 16); }
DI float bfhi(unsigned w) { return __uint_as_float(w & 0xffff0000u); }
DI float bf1(bf16_t h) { return __uint_as_float(((unsigned)h) << 16); }
DI bf16_t f2bf(float f) { return (bf16_t)(pk2(f, 0.f) & 0xffffu); }
DI void unpack8(u32x4 r, float* o) { o[0] = bflo(r.x); o[1] = bfhi(r.x); o[2] = bflo(r.y); o[3] = bfhi(r.y); o[4] = bflo(r.z); o[5] = bfhi(r.z); o[6] = bflo(r.w); o[7] = bfhi(r.w); }
DI float wave_sum(float v) {
#pragma unroll
    for (int o = 1; o < 64; o <<= 1) v += __shfl_xor(v, o);
    return v;
}
DI float wave_max(float v) {
#pragma unroll
    for (int o = 1; o < 64; o <<= 1) v = fmaxf(v, __shfl_xor(v, o));
    return v;
}
DI float silu_f(float x) { return x / (1.f + __expf(-x)); }
DI float softplus_f(float x) { return x > 20.f ? x : log1pf(__expf(x)); }
#define MFMA16(a, b, c) __builtin_amdgcn_mfma_f32_16x16x32_bf16((a), (b), (c), 0, 0, 0)
#define LDS_FENCE() asm volatile("s_waitcnt lgkmcnt(0)" ::: "memory")
typedef short v4i16_t __attribute__((ext_vector_type(4)));
DI s16x4 vtr(const LAS bf16_t* p) { return __builtin_bit_cast(s16x4, __builtin_amdgcn_ds_read_tr16_b64_v4i16((LAS v4i16_t*)p)); }
DI bf16x8 cat8(s16x4 lo, s16x4 hi) { return __builtin_shufflevector(lo, hi, 0, 1, 2, 3, 4, 5, 6, 7); }

constexpr int DM = 2048, MP = 8192, MS = 128, MTOK = MP + MS, MPAD = 8448, SEQ = 2048, NB = 4;
constexpr int DIN = 6688, DINP = 6912, DMIX = 3072, DXA = 512, DFF = 5632, DFF2 = 11264, CONVD = 3072;
constexpr int C_Q = 0, C_K = 1024, C_V = 1280, C_Z = 1536, C_XBC = 3584, C_DT = 6656;
constexpr float EPS = 1e-6f;
constexpr size_t O_Y = 0, O_YS = O_Y + (size_t)MP * DM, O_SKP = O_YS + (size_t)MS * DM, O_SVP = O_SKP + 131072, O_SKS = O_SVP + 131072,
    O_SVS = O_SKS + 4194304, O_SCP = O_SVS + 4194304, O_SCS = O_SCP + 36864, O_SSP = O_SCS + 1179648, O_SSS = O_SSP + 1048576,
    O_MKP = O_SSS + 33554432, O_MVP = O_MKP + 524288, O_FCP = O_MVP + 524288, O_FCS = O_FCP + 90112, O_END = O_FCS + 2883584;
constexpr size_t MiB = 1u << 20;
constexpr size_t WS_SSQ = 0;
constexpr size_t WS_BAR = 512 * 1024, WS_BAR_BYTES = 16384;
constexpr size_t WS_WIN = 1 * MiB;
constexpr size_t WS_WOUT = WS_WIN + 27 * MiB;
constexpr size_t WS_WCQ = WS_WOUT + 12 * MiB;
constexpr size_t WS_WCKV = WS_WCQ + 2 * MiB;
constexpr size_t WS_WCO = WS_WCKV + 4 * MiB;
constexpr size_t WS_WUP = WS_WCO + 2 * MiB;
constexpr size_t WS_WDN = WS_WUP + 44 * MiB;
constexpr size_t WS_A0 = WS_WDN + 22 * MiB;
constexpr size_t WS_MEMN = WS_A0 + 33 * MiB;
constexpr size_t WS_X1 = WS_MEMN + 4 * MiB;
constexpr size_t WS_QC = WS_X1 + 66 * MiB;
constexpr size_t WS_OC = WS_QC + 9 * MiB;
constexpr size_t WS_DT = WS_OC + 9 * MiB;
constexpr size_t WS_H = WS_DT + 2 * MiB;
constexpr size_t WS_R1 = WS_H + 91 * MiB;
constexpr size_t WS_PROJ = WS_R1, WS_MIX = WS_R1 + 112 * MiB, WS_U = WS_R1;
constexpr size_t WS_END = WS_R1 + 182 * MiB;
constexpr int LDS_BYTES = 147456;

namespace pg8 {
constexpr int BM = 256, BK = 64, HALF = 128, HTB = HALF * BK * 2, STAGE_BYTES = 8 * HTB, NXCD = 8, WGM = 8;
__host__ __device__ __forceinline__ int lds_byte(int r, int c) { const int st = (r >> 4) * 2 + (c >> 5), rr = r & 15, cc = c & 31, ob = rr * 64 + cc * 2; return st * 1024 + (ob ^ (((ob >> 9) & 1) << 5)); }
__host__ __device__ __forceinline__ void stage_rc(int b, int& R, int& C) { const int st = b / 1024, sb = b % 1024, swz = sb ^ (((sb >> 9) & 1) << 5); R = (st >> 1) * 16 + swz / 64; C = (st & 1) * 32 + (swz % 64) / 2; }
__host__ __device__ __forceinline__ int perm32(int rho) { const int n = rho >> 4, i = rho & 15; return 8 * (i >> 2) + 4 * n + (i & 3); }
struct Unit { int pm, pn; };
struct Gemm { const bf16_t* A; const bf16_t* Bt; int M, N, K; };
struct StaticOrder {
    int nM, nN, nwg, G, c;
    __host__ __device__ void init(int M, int N, int G_, int c_) { nM = M / BM; nN = N / BM; nwg = nM * nN; G = G_; c = c_; }
    __host__ __device__ bool next(int i, Unit& u) const {
        const long L = (long)i * G + c; if (L >= nwg) return false;
        int wgid = (int)L; { const int q = nwg / NXCD, r = nwg % NXCD, xcd = wgid % NXCD, off = wgid / NXCD; wgid = (xcd < r ? xcd * (q + 1) : r * (q + 1) + (xcd - r) * q) + off; }
        const int nig = WGM * nN, gid = wgid / nig, fm = gid * WGM, gsz = (nM - fm) < WGM ? (nM - fm) : WGM;
        u.pm = fm + ((wgid % nig) % gsz); u.pn = (wgid % nig) / gsz; return true;
    }
};
template <class Epi, class Sched>
__device__ __forceinline__ void gemm_phase(LAS unsigned char* lds, const Gemm g, const Sched& S, const Epi& E) {
    const int tid = threadIdx.x, wid = __builtin_amdgcn_readfirstlane(tid >> 6), lane = tid & 63, wr = wid >> 2, wc = wid & 3, fr = lane & 15, fq = lane >> 4;
    const int K = g.K, nt = K / BK;
    unsigned voffA[2], voffB[2];
#pragma unroll
    for (int i = 0; i < 2; ++i) { int R, C; stage_rc(tid * 16 + i * 8192, R, C); const int Rb = Epi::PERM ? ((R & ~31) + perm32(R & 31)) : R;
        voffA[i] = (unsigned)(R * K + C) * 2u; voffB[i] = (unsigned)(Rb * K + C) * 2u; }
    const size_t kstep = (size_t)(BK * 2);
    const size_t hstep = (size_t)HALF * K * 2;
    const size_t tstep = 2 * hstep;
    const unsigned ldsw = (unsigned)wid * 1024u;
    const int aoff = lds_byte(wr * 64 + fr, fq * 8), boff = lds_byte(wc * 32 + fr, fq * 8);
#define PG8_SA(b, h) (((b) * 2 + (h)) * HTB)
#define PG8_SB(b, h) ((4 + (b) * 2 + (h)) * HTB)
#define PG8_STAGE(bufoff, gbase, voff) do { _Pragma("unroll") for (int _i = 0; _i < 2; ++_i) \
        __builtin_amdgcn_global_load_lds((const unsigned*)((const char*)(gbase) + (voff)[_i]), (LAS unsigned*)(lds + (bufoff) + ldsw + _i * 8192), 16, 0, 0); } while (0)
#define PG8_LDA(dst, b, h) do { _Pragma("unroll") for (int m = 0; m < 4; ++m) _Pragma("unroll") for (int k = 0; k < 2; ++k) dst[m][k] = *(const LAS bf16x8*)(lds + PG8_SA(b, h) + aoff + m * 2048 + k * 1024); } while (0)
#define PG8_LDB(dst, b, h) do { _Pragma("unroll") for (int n = 0; n < 2; ++n) _Pragma("unroll") for (int k = 0; k < 2; ++k) dst[n][k] = *(const LAS bf16x8*)(lds + PG8_SB(b, h) + boff + n * 2048 + k * 1024); } while (0)
#define PG8_MMA(ai, bj, At, Bt) do { __builtin_amdgcn_s_setprio(1); _Pragma("unroll") for (int m = 0; m < 4; ++m) _Pragma("unroll") for (int n = 0; n < 2; ++n) _Pragma("unroll") for (int k = 0; k < 2; ++k) \
        acc[ai][bj][m][n] = __builtin_amdgcn_mfma_f32_16x16x32_bf16(Bt[n][k], At[m][k], acc[ai][bj][m][n], 0, 0, 0); __builtin_amdgcn_s_setprio(0); } while (0)
#define PG8_WAIT_V(n) asm volatile("s_waitcnt vmcnt(" #n ")" ::: "memory")
#define PG8_WAIT_L(n) asm volatile("s_waitcnt lgkmcnt(" #n ")" ::: "memory")
#define PG8_BAR __builtin_amdgcn_s_barrier()
#define PG8_SCHED __builtin_amdgcn_sched_barrier(0)
    Unit cur, nxt; int ui = 0;
    if (!S.next(0, cur)) return;
    f32x4 acc[2][2][4][2];
#pragma unroll
    for (int a = 0; a < 2; ++a)
#pragma unroll
        for (int b = 0; b < 2; ++b)
#pragma unroll
            for (int m = 0; m < 4; ++m)
#pragma unroll
                for (int n = 0; n < 2; ++n) acc[a][b][m][n] = (f32x4){0.f, 0.f, 0.f, 0.f};
    bf16x8 At[4][2], B0[2][2], B1[2][2];
    const char* cA = (const char*)g.A + (size_t)cur.pm * tstep; const char* cB = (const char*)g.Bt + (size_t)cur.pn * tstep;
    PG8_STAGE(PG8_SB(0, 0), cB, voffB); PG8_STAGE(PG8_SB(0, 1), cB + hstep, voffB); PG8_STAGE(PG8_SA(0, 0), cA, voffA); PG8_STAGE(PG8_SA(0, 1), cA + hstep, voffA);
    if (wr == 1) PG8_BAR;
    PG8_WAIT_V(2); PG8_BAR;
    PG8_STAGE(PG8_SB(1, 0), cB + kstep, voffB); PG8_STAGE(PG8_SA(1, 0), cA + kstep, voffA); PG8_STAGE(PG8_SB(1, 1), cB + hstep + kstep, voffB);
    PG8_WAIT_V(6); PG8_BAR;
    for (;;) {
        const bool has_next = S.next(ui + 1, nxt);
        const char* nA = has_next ? (const char*)g.A + (size_t)nxt.pm * tstep : cA; const char* nB = has_next ? (const char*)g.Bt + (size_t)nxt.pn * tstep : cB;
        for (int t = 0; t < nt; t += 2) {
            const bool last = (t == nt - 2);
            const char* a1 = cA + (size_t)(t + 1) * kstep;
            const char* a2 = last ? nA : cA + (size_t)(t + 2) * kstep; const char* b2 = last ? nB : cB + (size_t)(t + 2) * kstep;
            const char* a3 = a2 + kstep; const char* b3 = b2 + kstep;
            if constexpr (Epi::MID) { if (t == E.tsplit) E.midscale(acc, cur, wr, fr); }
            PG8_LDB(B0, 0, 0); PG8_LDB(B1, 0, 1); PG8_SCHED; PG8_LDA(At, 0, 0); PG8_STAGE(PG8_SA(1, 1), a1 + hstep, voffA);
            PG8_WAIT_V(8); PG8_WAIT_L(0); PG8_BAR; PG8_MMA(0, 0, At, B0); PG8_MMA(0, 1, At, B1); PG8_BAR; PG8_SCHED;
            PG8_LDA(At, 0, 1); PG8_STAGE(PG8_SB(0, 0), b2, voffB); PG8_STAGE(PG8_SB(0, 1), b2 + hstep, voffB); PG8_STAGE(PG8_SA(0, 0), a2, voffA);
            PG8_WAIT_V(8); PG8_WAIT_L(0); PG8_BAR; PG8_MMA(1, 0, At, B0); PG8_MMA(1, 1, At, B1); PG8_BAR; PG8_SCHED;
            PG8_LDB(B0, 1, 0); PG8_LDB(B1, 1, 1); PG8_SCHED; PG8_LDA(At, 1, 0); PG8_STAGE(PG8_SA(0, 1), a2 + hstep, voffA);
            PG8_WAIT_V(8); PG8_WAIT_L(0); PG8_BAR; PG8_MMA(0, 0, At, B0); PG8_MMA(0, 1, At, B1); PG8_BAR; PG8_SCHED;
            PG8_LDA(At, 1, 1); PG8_STAGE(PG8_SB(1, 0), b3, voffB); PG8_STAGE(PG8_SB(1, 1), b3 + hstep, voffB); PG8_STAGE(PG8_SA(1, 0), a3, voffA);
            PG8_WAIT_V(8); PG8_WAIT_L(0); PG8_BAR; PG8_MMA(1, 0, At, B0); PG8_MMA(1, 1, At, B1); PG8_BAR; PG8_SCHED;
        }
        if (wr == 0) PG8_BAR;
        E(acc, cur, wr, wc, fr, fq);
        if (!has_next) break;
#pragma unroll
        for (int a = 0; a < 2; ++a)
#pragma unroll
            for (int b = 0; b < 2; ++b)
#pragma unroll
                for (int m = 0; m < 4; ++m)
#pragma unroll
                    for (int n = 0; n < 2; ++n) acc[a][b][m][n] = (f32x4){0.f, 0.f, 0.f, 0.f};
        cur = nxt; cA = nA; cB = nB; ++ui;
        if (wr == 1) PG8_BAR;
    }
    PG8_WAIT_V(0);
    PG8_BAR;
#undef PG8_SA
#undef PG8_SB
#undef PG8_STAGE
#undef PG8_LDA
#undef PG8_LDB
#undef PG8_MMA
#undef PG8_WAIT_V
#undef PG8_WAIT_L
#undef PG8_BAR
#undef PG8_SCHED
}
}
using pg8::Unit;
typedef f32x4 Acc[2][2][4][2];

struct EpiProj {
    static constexpr bool PERM = true, MID = false; bf16_t* O; float* dt; int tsplit;
    DI void midscale(Acc&, const Unit&, int, int) const {}
    DI void operator()(const Acc& acc, const Unit& u, int wr, int wc, int fr, int fq) const {
        const int row0 = u.pm * 256 + wr * 64 + fr, col0 = u.pn * 256 + wc * 32 + 8 * fq;
#pragma unroll
        for (int ai = 0; ai < 2; ++ai)
#pragma unroll
            for (int m = 0; m < 4; ++m) { const int row = row0 + ai * 128 + m * 16; bf16_t* rowp = O + (size_t)row * DINP + col0;
#pragma unroll
                for (int bj = 0; bj < 2; ++bj) { const f32x4 v0 = acc[ai][bj][m][0], v1 = acc[ai][bj][m][1]; u32x4 w; w.x = pk2(v0[0], v0[1]); w.y = pk2(v0[2], v0[3]); w.z = pk2(v1[0], v1[1]); w.w = pk2(v1[2], v1[3]);
                    *(u32x4*)(rowp + bj * 128) = w; }
                if (u.pn == 26 && wc == 0) { float* d = dt + (size_t)row * 32 + 8 * fq; *(f32x4*)d = acc[ai][0][m][0]; *(f32x4*)(d + 4) = acc[ai][0][m][1]; } }
    }
};
struct EpiMem {
    static constexpr bool PERM = false, MID = false; float* outK; float* outV; int tsplit;
    DI void midscale(Acc&, const Unit&, int, int) const {}
    DI void operator()(const Acc& acc, const Unit& u, int wr, int wc, int fr, int fq) const {
        float* base = (u.pn < 2) ? outK : outV; const int colt = (u.pn & 1) * 256 + wc * 32 + 4 * fq;
#pragma unroll
        for (int ai = 0; ai < 2; ++ai)
#pragma unroll
            for (int m = 0; m < 4; ++m) { const int row = u.pm * 256 + ai * 128 + wr * 64 + m * 16 + fr;
#pragma unroll
                for (int bj = 0; bj < 2; ++bj)
#pragma unroll
                    for (int n = 0; n < 2; ++n) *(f32x4*)(base + (size_t)row * 512 + colt + bj * 128 + n * 16) = acc[ai][bj][m][n]; }
    }
};
template <bool MIDS> struct EpiRes {
    static constexpr bool PERM = false, MID = MIDS;
    const float* baseP; const float* baseS; float* outP; float* outS; bf16_t* abf; float* ssq; const float* ssq_in; int tsplit;
    DI void midscale(Acc& acc, const Unit& u, int wr, int fr) const {
        int rbase = u.pm * 256 + wr * 64 + fr; asm volatile("" : "+v"(rbase));
#pragma unroll
        for (int ai = 0; ai < 2; ++ai)
#pragma unroll
            for (int m = 0; m < 4; ++m) { const int row = rbase + ai * 128 + m * 16; const float s = rsqrtf(ssq_in[row] * (1.f / 2048.f) + EPS);
#pragma unroll
                for (int bj = 0; bj < 2; ++bj)
#pragma unroll
                    for (int n = 0; n < 2; ++n) acc[ai][bj][m][n] = acc[ai][bj][m][n] * s; }
    }
    DI void operator()(const Acc& acc, const Unit& u, int wr, int wc, int fr, int fq) const {
        const int col0 = u.pn * 256 + wc * 32 + 4 * fq;
#pragma unroll
        for (int ai = 0; ai < 2; ++ai)
#pragma unroll
            for (int m = 0; m < 4; ++m) { const int row = u.pm * 256 + ai * 128 + wr * 64 + m * 16 + fr;
                if (row < MTOK) {
                    const float* bp = row < MP ? baseP + (size_t)row * DM : baseS + (size_t)(row - MP) * DM;
                    float* op = row < MP ? outP + (size_t)row * DM : outS + (size_t)(row - MP) * DM;
                    float sq = 0.f;
#pragma unroll
                    for (int bj = 0; bj < 2; ++bj)
#pragma unroll
                        for (int n = 0; n < 2; ++n) { const int c = col0 + bj * 128 + n * 16; const f32x4 o = *(const f32x4*)(bp + c) + acc[ai][bj][m][n]; *(f32x4*)(op + c) = o;
                            if (abf) { u32x2 w; w.x = pk2(o[0], o[1]); w.y = pk2(o[2], o[3]); *(u32x2*)(abf + (size_t)row * DM + c) = w; sq += (o[0] * o[0] + o[1] * o[1]) + (o[2] * o[2] + o[3] * o[3]); } }
                    if (abf) { sq += __shfl_xor(sq, 16); sq += __shfl_xor(sq, 32); if (fq == 0) atomicAdd(ssq + row, sq); }
                }
                asm volatile("" ::: "memory"); }
    }
};
struct EpiScale {
    static constexpr bool PERM = true, MID = false; bf16_t* O; int ldc; const float* ssq_in; int tsplit;
    DI void midscale(Acc&, const Unit&, int, int) const {}
    DI void operator()(const Acc& acc, const Unit& u, int wr, int wc, int fr, int fq) const {
        const int row0 = u.pm * 256 + wr * 64 + fr, col0 = u.pn * 256 + wc * 32 + 8 * fq;
#pragma unroll
        for (int ai = 0; ai < 2; ++ai)
#pragma unroll
            for (int m = 0; m < 4; ++m) { const int row = row0 + ai * 128 + m * 16; bf16_t* rowp = O + (size_t)row * ldc + col0; const float s = rsqrtf(ssq_in[row] * (1.f / 2048.f) + EPS);
#pragma unroll
                for (int bj = 0; bj < 2; ++bj) { const f32x4 v0 = acc[ai][bj][m][0] * s, v1 = acc[ai][bj][m][1] * s; u32x4 w; w.x = pk2(v0[0], v0[1]); w.y = pk2(v0[2], v0[3]); w.z = pk2(v1[0], v1[1]); w.w = pk2(v1[2], v1[3]);
                    *(u32x4*)(rowp + bj * 128) = w; } }
    }
};

#define XB_TMO      128
#define XB_XCNT(j)  (256  + 64 * (j))
#define XB_XSUB(j)  (1280 + 64 * (j))
#define XB_XGEN(j)  (2304 + 64 * (j))
#define XB_TOP      3328
#define XB_TOPGEN   3392
#define XCD_BAR_WORDS 3456
#define XB_SPIN_CAP (1u << 18)

__device__ __forceinline__ unsigned xb_ld(unsigned* p)              { return __hip_atomic_load(p, __ATOMIC_RELAXED, __HIP_MEMORY_SCOPE_AGENT); }
__device__ __forceinline__ unsigned xb_add(unsigned* p, unsigned v) { return __hip_atomic_fetch_add(p, v, __ATOMIC_RELAXED, __HIP_MEMORY_SCOPE_AGENT); }
__device__ __forceinline__ unsigned xb_xcc_id() { return (unsigned)__builtin_amdgcn_s_getreg((3 << 11) | 20) & 0xFu; }
#define XB_SPIN(cond, bar) do { unsigned _sp = 0; while (cond) { __builtin_amdgcn_s_sleep(1); \
    if ((++_sp & 255u) == 0u) { if (xb_ld(&(bar)[XB_TMO])) break; if (_sp > XB_SPIN_CAP) { atomicAdd(&(bar)[XB_TMO], 1u); break; } } } } while (0)

struct XcdBarrier {
    unsigned* bar; unsigned x;
    volatile LAS unsigned* st;
};

__device__ __forceinline__ XcdBarrier xcd_barrier_post(unsigned* bar, volatile LAS unsigned* st) {
    XcdBarrier b; b.bar = bar; b.x = xb_xcc_id(); b.st = st;
    if (threadIdx.x == 0) (void)xb_add(&bar[XB_XCNT(b.x)], 1u);
    return b;
}
__device__ __forceinline__ void xcd_barrier_complete(unsigned* bar, unsigned x, unsigned& nloc, unsigned& nx) {
    const unsigned G = gridDim.x * gridDim.y * gridDim.z;
    unsigned sum, cnt, mine, sp = 0u;
    for (;;) {
        sum = 0u; cnt = 0u; mine = 0u;
#pragma unroll
        for (unsigned j = 0; j < 16; ++j) { const unsigned c = xb_ld(&bar[XB_XCNT(j)]); sum += c; cnt += (c > 0u) ? 1u : 0u; mine = (j == x) ? c : mine; }
        if (sum == G) break;
        __builtin_amdgcn_s_sleep(1);
        if ((++sp & 255u) == 0u) { if (xb_ld(&bar[XB_TMO])) break; if (sp > XB_SPIN_CAP) { atomicAdd(&bar[XB_TMO], 1u); break; } }
    }
    nloc = mine > 0u ? mine : 1u; nx = cnt > 0u ? cnt : 1u;
}

__device__ __forceinline__ void xcd_barrier(const XcdBarrier& b) {
    asm volatile("s_waitcnt vmcnt(0)" ::: "memory");
    __syncthreads();
    if (threadIdx.x == 0) {
        unsigned* bar = b.bar;
        __builtin_amdgcn_s_waitcnt(0);
        unsigned nloc = b.st[0], nx = b.st[1];
        if (nloc == 0u) { xcd_barrier_complete(bar, b.x, nloc, nx); b.st[0] = nloc; b.st[1] = nx; }
        const unsigned old = xb_add(&bar[XB_XSUB(b.x)], 1u);
        const unsigned gen = old / nloc;
        if (old + 1u == (gen + 1u) * nloc) {
            __builtin_amdgcn_fence(__ATOMIC_RELEASE, "agent");
            asm volatile("s_waitcnt vmcnt(0)" ::: "memory");
            const unsigned og = xb_add(&bar[XB_TOP], 1u);
            const unsigned tg = og / nx;
            if (og + 1u == (tg + 1u) * nx) xb_add(&bar[XB_TOPGEN], 1u);
            else XB_SPIN(xb_ld(&bar[XB_TOPGEN]) == tg, bar);
            __builtin_amdgcn_fence(__ATOMIC_ACQUIRE, "agent");
            xb_add(&bar[XB_XGEN(b.x)], 1u);
            asm volatile("s_waitcnt vmcnt(0)" ::: "memory");
        } else {
            XB_SPIN(xb_ld(&bar[XB_XGEN(b.x)]) == gen, bar);
            __builtin_amdgcn_fence(__ATOMIC_ACQUIRE, "agent");
            asm volatile("s_waitcnt vmcnt(0)" ::: "memory");
        }
    }
    __syncthreads();
}

struct Args { const float* in[35]; float* out; unsigned char* ws; int ph_lo, ph_hi; };
struct Ctx {
    LAS unsigned char* lds; int tid, lane, wave, G, bid;
    const float* const* in; float* out; unsigned char* ws; int dry;
};
#define IN_(i) (c.in[i])
enum { I_XP = 0, I_XS, I_CSK, I_CSV, I_SSC, I_SS, I_CMK, I_CMV, I_SFC, I_MEM, I_GMIX, I_WIN, I_QG, I_KG, I_SINK, I_SCW, I_SCB, I_DTB, I_ALOG, I_DSK, I_SNG, I_WOUT, I_GCR, I_GMEM, I_WCQ, I_WCK, I_WCV, I_CQG, I_CKG, I_WCO, I_GFFN, I_WUP, I_FCW, I_FCB, I_WDN };

struct TItem { const float* W; bf16_t* WT; const float* gain; int N, ldk, ksrc0, kdst0, n0, nrow_off; };
DI bool p0_decode(const Ctx& c, int it, TItem& t) {
    constexpr int I0 = 32 * 105, I1 = 48 * 32, I2 = 32 * 8, I5 = 8 * 32, I6 = 32 * 176, I7 = 88 * 32;
    int r = it; t.nrow_off = 0;
    if (r < I0) { const int kb = r / 105, nb = r % 105; t.W = IN_(I_WIN); t.N = DIN; t.WT = (bf16_t*)(c.ws + WS_WIN); t.ldk = 2048; t.ksrc0 = kb * 64; t.kdst0 = kb * 64; t.n0 = nb * 64; t.gain = IN_(I_GMIX) + kb * 64; return true; } r -= I0;
    if (r < I1) { const int kb = r / 32, nb = r % 32, ks = kb * 64; const bool ssd = ks >= 1024; t.W = IN_(I_WOUT); t.N = 2048; t.WT = (bf16_t*)(c.ws + WS_WOUT); t.ldk = 3072; t.ksrc0 = ks; t.kdst0 = ssd ? ks - 1024 : ks + 2048; t.n0 = nb * 64;
        t.gain = ssd ? IN_(I_SNG) + (ks - 1024) : nullptr; return true; } r -= I1;
    if (r < I2) { const int kb = r / 8, nb = r % 8; t.W = IN_(I_WCQ); t.N = 512; t.WT = (bf16_t*)(c.ws + WS_WCQ); t.ldk = 2048; t.ksrc0 = kb * 64; t.kdst0 = kb * 64; t.n0 = nb * 64; t.gain = IN_(I_GCR) + kb * 64; return true; } r -= I2;
    if (r < I2) { const int kb = r / 8, nb = r % 8; t.W = IN_(I_WCK); t.N = 512; t.WT = (bf16_t*)(c.ws + WS_WCKV); t.ldk = 2048; t.ksrc0 = kb * 64; t.kdst0 = kb * 64; t.n0 = nb * 64; t.gain = IN_(I_GMEM) + kb * 64; return true; } r -= I2;
    if (r < I2) { const int kb = r / 8, nb = r % 8; t.W = IN_(I_WCV); t.N = 512; t.WT = (bf16_t*)(c.ws + WS_WCKV); t.ldk = 2048; t.ksrc0 = kb * 64; t.kdst0 = kb * 64; t.n0 = nb * 64; t.nrow_off = 512; t.gain = IN_(I_GMEM) + kb * 64; return true; } r -= I2;
    if (r < I5) { const int kb = r / 32, nb = r % 32; t.W = IN_(I_WCO); t.N = 2048; t.WT = (bf16_t*)(c.ws + WS_WCO); t.ldk = 512; t.ksrc0 = kb * 64; t.kdst0 = kb * 64; t.n0 = nb * 64; t.gain = nullptr; return true; } r -= I5;
    if (r < I6) { const int kb = r / 176, nb = r % 176; t.W = IN_(I_WUP); t.N = DFF2; t.WT = (bf16_t*)(c.ws + WS_WUP); t.ldk = 2048; t.ksrc0 = kb * 64; t.kdst0 = kb * 64; t.n0 = nb * 64; t.gain = IN_(I_GFFN) + kb * 64; return true; } r -= I6;
    if (r < I7) { const int kb = r / 32, nb = r % 32; t.W = IN_(I_WDN); t.N = 2048; t.WT = (bf16_t*)(c.ws + WS_WDN); t.ldk = DFF; t.ksrc0 = kb * 64; t.kdst0 = kb * 64; t.n0 = nb * 64; t.gain = nullptr; return true; }
    return false;
}
DI void p0_load(const TItem& t, int lane, f32x4 (&buf)[16], float (&gv)[16]) {
    const int kr = lane >> 4, n4 = (lane & 15) * 4; const bool ok = t.n0 + n4 < t.N;
    const float* p = t.W + (size_t)(t.ksrc0 + kr) * t.N + t.n0 + (ok ? n4 : 0);
#pragma unroll
    for (int i = 0; i < 16; ++i) { buf[i] = *(const f32x4*)(p + (size_t)(4 * i) * t.N); gv[i] = t.gain ? t.gain[4 * i + kr] : 1.f; if (!ok) gv[i] = 0.f; }
}
constexpr int P0_EARLY_ITEMS = 32 * 105 + 48 * 32 + 3 * 32 * 8 + 8 * 32;
constexpr int P0_ALL_ITEMS = P0_EARLY_ITEMS + 32 * 176 + 88 * 32;
constexpr int P0_SPLIT_ITEMS = P0_ALL_ITEMS - 5600;
DI void p0_transposes(const Ctx& c, int it_lo, int it_hi, int gw, int NGW) {
    int lane_ = c.lane; asm volatile("" : "+v"(lane_)); const int lane = lane_;
    LAS float* scr = (LAS float*)(c.lds + c.wave * 16640);
    f32x4 buf[16]; float gv[16]; TItem cur, nxt;
    int it = it_lo + gw; bool have = (it < it_hi) && p0_decode(c, it, cur);
    if (have) p0_load(cur, lane, buf, gv);
    const int kr = lane >> 4, n4 = (lane & 15) * 4, cc = lane & 7;
    while (have) {
        const int itn = it + NGW; const bool hn = (itn < it_hi) && p0_decode(c, itn, nxt);
#pragma unroll
        for (int i = 0; i < 16; ++i) { LAS float* d = scr + (4 * i + kr) * 65 + n4; const f32x4 v = buf[i] * gv[i]; d[0] = v.x; d[1] = v.y; d[2] = v.z; d[3] = v.w; }
        if (hn) p0_load(nxt, lane, buf, gv);
        LDS_FENCE();
#pragma unroll
        for (int j = 0; j < 8; ++j) { const int n = (lane >> 3) + 8 * j; const LAS float* sp = scr + (8 * cc) * 65 + n;
            u32x4 o; o.x = pk2(sp[0 * 65], sp[1 * 65]); o.y = pk2(sp[2 * 65], sp[3 * 65]); o.z = pk2(sp[4 * 65], sp[5 * 65]); o.w = pk2(sp[6 * 65], sp[7 * 65]);
            *(u32x4*)(cur.WT + (size_t)(cur.nrow_off + cur.n0 + n) * cur.ldk + cur.kdst0 + 8 * cc) = o; }
        LDS_FENCE();
        cur = nxt; it = itn; have = hn;
    }
}
DI void norm_row_to_bf16(const float* xrow, bf16_t* orow, int lane) {
    f32x4 v[8]; float s = 0.f;
    if (xrow) {
#pragma unroll
        for (int j = 0; j < 8; ++j) { v[j] = ((const f32x4*)xrow)[lane + 64 * j]; s += (v[j].x * v[j].x + v[j].y * v[j].y) + (v[j].z * v[j].z + v[j].w * v[j].w); }
    } else {
#pragma unroll
        for (int j = 0; j < 8; ++j) v[j] = (f32x4){0.f, 0.f, 0.f, 0.f};
    }
    const float rs = rsqrtf(wave_sum(s) * (1.f / 2048.f) + EPS);
#pragma unroll
    for (int j = 0; j < 8; ++j) { u32x2 w; w.x = pk2(v[j].x * rs, v[j].y * rs); w.y = pk2(v[j].z * rs, v[j].w * rs); ((u32x2*)orow)[lane + 64 * j] = w; }
}
DI void p0_prologue(const Ctx& c) {
    const int gw = c.bid * 8 + c.wave, NGW = c.G * 8, lane = c.lane;
    bf16_t* WINT = (bf16_t*)(c.ws + WS_WIN);
    p0_transposes(c, 0, P0_SPLIT_ITEMS, gw, NGW);
    { u32x4* z = (u32x4*)(WINT + (size_t)6720 * 2048); const int n16 = (DINP - 6720) * 2048 * 2 / 16;
        for (int i = c.bid * 512 + c.tid; i < n16; i += c.G * 512) z[i] = (u32x4){0u, 0u, 0u, 0u}; }
    { float* z = (float*)(c.ws + WS_SSQ); for (int i = c.bid * 512 + c.tid; i < 3 * MPAD; i += c.G * 512) z[i] = 0.f; }
    bf16_t* A0 = (bf16_t*)(c.ws + WS_A0); bf16_t* MEMN = (bf16_t*)(c.ws + WS_MEMN);
    for (int m = gw; m < MPAD + 1024; m += NGW) {
        if (m < MPAD) { const float* xr = m < MP ? IN_(I_XP) + (size_t)m * DM : (m < MTOK ? IN_(I_XS) + (size_t)(m - MP) * DM : nullptr); norm_row_to_bf16(xr, A0 + (size_t)m * DM, lane); }
        else { const int r = m - MPAD; norm_row_to_bf16(IN_(I_MEM) + (size_t)r * DM, MEMN + (size_t)r * DM, lane); }
    }
}

constexpr int SP = 136;
DI void p1b_conv(const Ctx& c) {
    const bf16_t* PROJ = (const bf16_t*)(c.ws + WS_PROJ); bf16_t* XBC = (bf16_t*)(c.ws + WS_H);
    const float* cw = IN_(I_SCW); const float* cb = IN_(I_SCB);
    const int gw = c.bid * 8 + c.wave, NGW = c.G * 8, lane = c.lane;
    for (int task = gw; task < 512 * 6; task += NGW) {
        const int seg = task / 6, c8 = (task % 6) * 64 + lane, r0 = seg * 16, tl0 = r0 & (SEQ - 1), cch = c8 * 8;
        float w[4][8], bias[8];
#pragma unroll
        for (int i = 0; i < 4; ++i) { const f32x4 a = *(const f32x4*)(cw + (size_t)i * CONVD + cch), a2 = *(const f32x4*)(cw + (size_t)i * CONVD + cch + 4);
            w[i][0] = a.x; w[i][1] = a.y; w[i][2] = a.z; w[i][3] = a.w; w[i][4] = a2.x; w[i][5] = a2.y; w[i][6] = a2.z; w[i][7] = a2.w; }
        { const f32x4 a = *(const f32x4*)(cb + cch), a2 = *(const f32x4*)(cb + cch + 4); bias[0] = a.x; bias[1] = a.y; bias[2] = a.z; bias[3] = a.w; bias[4] = a2.x; bias[5] = a2.y; bias[6] = a2.z; bias[7] = a2.w; }
        float h1[8], h2[8], h3[8];
        if (tl0 == 0) {
#pragma unroll
            for (int j = 0; j < 8; ++j) { h1[j] = 0.f; h2[j] = 0.f; h3[j] = 0.f; }
        } else { const bf16_t* p = PROJ + (size_t)(r0 - 3) * DINP + C_XBC + cch; unpack8(*(const u32x4*)p, h1); unpack8(*(const u32x4*)(p + DINP), h2); unpack8(*(const u32x4*)(p + 2 * DINP), h3); }
#pragma unroll 1
        for (int rb = 0; rb < 16; rb += 4) { u32x4 lr_[4];
#pragma unroll
          for (int r4 = 0; r4 < 4; ++r4) lr_[r4] = *(const u32x4*)(PROJ + ((size_t)r0 + rb + r4) * DINP + C_XBC + cch);
#pragma unroll
          for (int r4 = 0; r4 < 4; ++r4) { const size_t row = (size_t)r0 + rb + r4; float cur[8], o[8]; unpack8(lr_[r4], cur);
#pragma unroll
            for (int j = 0; j < 8; ++j) { o[j] = silu_f(bias[j] + w[0][j] * h1[j] + w[1][j] * h2[j] + w[2][j] * h3[j] + w[3][j] * cur[j]); h1[j] = h2[j]; h2[j] = h3[j]; h3[j] = cur[j]; }
            u32x4 q; q.x = pk2(o[0], o[1]); q.y = pk2(o[2], o[3]); q.z = pk2(o[4], o[5]); q.w = pk2(o[6], o[7]); *(u32x4*)(XBC + row * CONVD + cch) = q; } }
    }
}
DI void ssd_prompt_unit(const Ctx& c, int unit) {
    const int b = unit >> 6, h = (unit >> 1) & 31, ph = unit & 1, g = h >> 3;
    int tid_ = c.tid; asm volatile("" : "+v"(tid_)); const int tid = tid_, lane = tid & 63, w = __builtin_amdgcn_readfirstlane(tid >> 6), fr = lane & 15, fq = lane >> 4;
    constexpr int XP = 40;
    LAS bf16_t* Cs = (LAS bf16_t*)(c.lds); LAS bf16_t* Bs = (LAS bf16_t*)(c.lds + 34816); LAS bf16_t* Xn = (LAS bf16_t*)(c.lds + 69632); LAS bf16_t* Hb = (LAS bf16_t*)(c.lds + 90112);
    LAS float* dts = (LAS float*)(c.lds + 98816); LAS float* las = (LAS float*)(c.lds + 99328); LAS float* scl = (LAS float*)(c.lds + 99840);
    const bf16_t* PROJ = (const bf16_t*)(c.ws + WS_PROJ); const bf16_t* XBC = (const bf16_t*)(c.ws + WS_H); const float* DTR = (const float*)(c.ws + WS_DT);
    bf16_t* MIX = (bf16_t*)(c.ws + WS_MIX); float* SSQS = (float*)(c.ws + WS_SSQ) + (c.dry ? 3 * MPAD : 0);
    const float av = -__expf(IN_(I_ALOG)[h]), dtb = IN_(I_DTB)[h], Dh = IN_(I_DSK)[h];
    f32x4 st[2] = {(f32x4){0.f, 0.f, 0.f, 0.f}, (f32x4){0.f, 0.f, 0.f, 0.f}};
    for (int i = tid; i < 32 * SP / 2; i += 512) ((LAS unsigned*)Hb)[i] = 0u;
    const int sx = tid >> 2, c8 = tid & 3, cb8 = tid & 15, s0 = tid >> 4;
    u32x4 xq, bq[4], cq[4]; float dtrA = 0.f, dtrB = 0.f; u32x2 zn[2], zc[2];
#define SSD_LOADS(CK) do { const size_t r0_ = (size_t)b * SEQ + (CK) * 128; xq = *(const u32x4*)(XBC + (r0_ + sx) * CONVD + h * 64 + ph * 32 + c8 * 8); \
        _Pragma("unroll") for (int i = 0; i < 4; ++i) { const bf16_t* p_ = XBC + (r0_ + s0 + 32 * i) * CONVD + 2048 + g * 128 + cb8 * 8; bq[i] = *(const u32x4*)p_; cq[i] = *(const u32x4*)(p_ + 512); } \
        if (w < 2) { dtrA = DTR[(r0_ + lane) * 32 + h]; dtrB = DTR[(r0_ + 64 + lane) * 32 + h]; } \
        _Pragma("unroll") for (int np = 0; np < 2; ++np) zn[np] = *(const u32x2*)(PROJ + (r0_ + 16 * w + fr) * DINP + C_Z + h * 64 + ph * 32 + 16 * np + 4 * fq); } while (0)
    SSD_LOADS(0);
    for (int ck = 0; ck < 16; ++ck) {
        const size_t row0 = (size_t)b * SEQ + ck * 128;
        {
            if (w < 2) {
                const float dA = softplus_f(dtrA + dtb), dB = softplus_f(dtrB + dtb);
                float sA = dA, sB = dB;
#pragma unroll
                for (int o = 1; o < 64; o <<= 1) { const float tA = __shfl_up(sA, o), tB = __shfl_up(sB, o); if (lane >= o) { sA += tA; sB += tB; } }
                const float totA = __shfl(sA, 63), tot = totA + __shfl(sB, 63);
                if (w == 0) { dts[lane] = dA; las[lane] = av * sA; scl[lane] = dA * __expf(av * (tot - sA)); }
                else { dts[64 + lane] = dB; las[64 + lane] = av * (totA + sB); scl[64 + lane] = dB * __expf(av * (tot - totA - sB)); }
            }
            *(LAS u32x4*)(Xn + sx * XP + c8 * 8) = xq;
#pragma unroll
            for (int i = 0; i < 4; ++i) { *(LAS u32x4*)(Bs + (s0 + 32 * i) * SP + cb8 * 8) = bq[i]; *(LAS u32x4*)(Cs + (s0 + 32 * i) * SP + cb8 * 8) = cq[i]; }
        }
        zc[0] = zn[0]; zc[1] = zn[1];
        __syncthreads();
        if (ck + 1 < 16) SSD_LOADS(ck + 1);
        asm volatile("" ::: "memory");
        const int l = 16 * w + fr; const float la_l = las[l];
        f32x4 cbm[8];
#pragma unroll
        for (int ni = 0; ni < 8; ++ni) cbm[ni] = (f32x4){0.f, 0.f, 0.f, 0.f};
#pragma unroll
        for (int kk = 0; kk < 4; ++kk) { __builtin_amdgcn_sched_barrier(0); const bf16x8 af = *(const LAS bf16x8*)(Cs + l * SP + kk * 32 + fq * 8);
#pragma unroll
            for (int ni = 0; ni < 8; ++ni) { const bf16x8 bf = *(const LAS bf16x8*)(Bs + (16 * ni + fr) * SP + kk * 32 + fq * 8); cbm[ni] = MFMA16(bf, af, cbm[ni]); } }
        int lim = l - 4 * fq; asm volatile("" : "+v"(lim));
#pragma unroll
        for (int ni = 0; ni < 8; ++ni) { const int s = 16 * ni + 4 * fq; const f32x4 ls = *(const LAS f32x4*)(las + s), ds = *(const LAS f32x4*)(dts + s);
#pragma unroll
            for (int j = 0; j < 4; ++j) cbm[ni][j] = (16 * ni + j <= lim) ? cbm[ni][j] * __expf(la_l - ls[j]) * ds[j] : 0.f; }
        f32x4 y[2] = {(f32x4){0.f, 0.f, 0.f, 0.f}, (f32x4){0.f, 0.f, 0.f, 0.f}}, yi[2] = {(f32x4){0.f, 0.f, 0.f, 0.f}, (f32x4){0.f, 0.f, 0.f, 0.f}};
#pragma unroll
        for (int k2 = 0; k2 < 4; ++k2) { __builtin_amdgcn_sched_barrier(0); u32x4 pa; pa.x = pk2(cbm[2 * k2][0], cbm[2 * k2][1]); pa.y = pk2(cbm[2 * k2][2], cbm[2 * k2][3]); pa.z = pk2(cbm[2 * k2 + 1][0], cbm[2 * k2 + 1][1]); pa.w = pk2(cbm[2 * k2 + 1][2], cbm[2 * k2 + 1][3]);
            const bf16x8 af = __builtin_bit_cast(bf16x8, pa);
#pragma unroll
            for (int np = 0; np < 2; ++np) { const LAS bf16_t* xp = Xn + (32 * k2 + 4 * fq + (fr >> 2)) * XP + 16 * np + 4 * (fr & 3);
                y[np] = MFMA16(cat8(vtr(xp), vtr(xp + 16 * XP)), af, y[np]); } }
#pragma unroll
        for (int kk = 0; kk < 4; ++kk) { const bf16x8 af = *(const LAS bf16x8*)(Cs + l * SP + kk * 32 + fq * 8);
#pragma unroll
            for (int np = 0; np < 2; ++np) { const bf16x8 bf = *(const LAS bf16x8*)(Hb + (16 * np + fr) * SP + kk * 32 + fq * 8); yi[np] = MFMA16(bf, af, yi[np]); } }
        {
            const float el = __expf(la_l); const size_t row = row0 + l; float sq = 0.f;
#pragma unroll
            for (int np = 0; np < 2; ++np) { const int p0 = 16 * np + 4 * fq; const u32x2 zr = zc[np];
                const u32x2 xr = *(const LAS u32x2*)(Xn + l * XP + p0);
                const float zf[4] = {bflo(zr.x), bfhi(zr.x), bflo(zr.y), bfhi(zr.y)}, xf[4] = {bflo(xr.x), bfhi(xr.x), bflo(xr.y), bfhi(xr.y)}; float o[4];
#pragma unroll
                for (int j = 0; j < 4; ++j) { float v = y[np][j] + el * yi[np][j] + Dh * xf[j]; v *= silu_f(zf[j]); o[j] = v; sq += v * v; }
                u32x2 wv; wv.x = pk2(o[0], o[1]); wv.y = pk2(o[2], o[3]); *(u32x2*)(MIX + row * DMIX + h * 64 + ph * 32 + p0) = wv; }
            sq += __shfl_xor(sq, 16); sq += __shfl_xor(sq, 32); if (fq == 0) atomicAdd(SSQS + row, sq);
        }
        {
            f32x4 sa[2] = {(f32x4){0.f, 0.f, 0.f, 0.f}, (f32x4){0.f, 0.f, 0.f, 0.f}};
#pragma unroll
            for (int kk = 0; kk < 4; ++kk) { __builtin_amdgcn_sched_barrier(0); const int sb = 32 * kk + 8 * fq;
                const LAS bf16_t* bp = Bs + (sb + (fr >> 2)) * SP + 16 * w + 4 * (fr & 3); const bf16x8 bf = cat8(vtr(bp), vtr(bp + 4 * SP));
                const f32x4 s0 = *(const LAS f32x4*)(scl + sb), s1 = *(const LAS f32x4*)(scl + sb + 4);
#pragma unroll
                for (int mi = 0; mi < 2; ++mi) { const LAS bf16_t* xp = Xn + (sb + (fr >> 2)) * XP + 16 * mi + 4 * (fr & 3); const s16x4 x0 = vtr(xp), x1 = vtr(xp + 4 * XP);
                    const u32x2 a0 = __builtin_bit_cast(u32x2, x0), a1 = __builtin_bit_cast(u32x2, x1); u32x4 q;
                    q.x = pk2(bflo(a0.x) * s0[0], bfhi(a0.x) * s0[1]); q.y = pk2(bflo(a0.y) * s0[2], bfhi(a0.y) * s0[3]); q.z = pk2(bflo(a1.x) * s1[0], bfhi(a1.x) * s1[1]); q.w = pk2(bflo(a1.y) * s1[2], bfhi(a1.y) * s1[3]);
                    sa[mi] = MFMA16(bf, __builtin_bit_cast(bf16x8, q), sa[mi]); } }
            const float ee = __expf(las[127]);
#pragma unroll
            for (int mi = 0; mi < 2; ++mi) st[mi] = st[mi] * ee + sa[mi];
        }
        __syncthreads();
#pragma unroll
        for (int mi = 0; mi < 2; ++mi) { u32x2 wv; wv.x = pk2(st[mi][0], st[mi][1]); wv.y = pk2(st[mi][2], st[mi][3]); *(LAS u32x2*)(Hb + (16 * mi + fr) * SP + 16 * w + 4 * fq) = wv; }
    }
    float* so = c.out + O_SSP;
#pragma unroll
    for (int mi = 0; mi < 2; ++mi) *(f32x4*)(so + ((size_t)(b * 32 + h) * 64 + ph * 32 + 16 * mi + fr) * 128 + 16 * w + 4 * fq) = st[mi];
    __syncthreads();
}

DI void swa_prompt_unit(const Ctx& c, int unit) {
    const int b = unit >> 6, blk = (unit >> 2) & 15, kvh = unit & 3;
    int tid_ = c.tid; asm volatile("" : "+v"(tid_)); const int tid = tid_, lane = tid & 63, w = __builtin_amdgcn_readfirstlane(tid >> 6), fr = lane & 15, fq = lane >> 4;
    constexpr int KP = 72, VP = 72;
    LAS bf16_t* Ks = (LAS bf16_t*)(c.lds); LAS bf16_t* Vn = (LAS bf16_t*)(c.lds + 36864);
    const bf16_t* PROJ = (const bf16_t*)(c.ws + WS_PROJ); bf16_t* MIX = (bf16_t*)(c.ws + WS_MIX);
    u32x4 qraw[4][2];
#pragma unroll
    for (int it = 0; it < 4; ++it) { const int combo = w * 2 + (it >> 1), mi = it & 1, gq = combo & 3, rg = combo >> 2; const size_t row = (size_t)b * SEQ + blk * 128 + 32 * rg + 16 * mi + fr;
#pragma unroll
        for (int kk = 0; kk < 2; ++kk) qraw[it][kk] = *(const u32x4*)(PROJ + row * DINP + C_Q + (kvh * 4 + gq) * 64 + kk * 32 + fq * 8); }
    {
        const int key = tid >> 1, half = tid & 1, tk = blk * 128 - 128 + key;
        const bf16_t* pr = PROJ + ((size_t)b * SEQ + (tk >= 0 ? tk : 0)) * DINP;
        const bool wout = (blk == 15 && key >= 128);
        unsigned ooff = (unsigned)(((b * 128 + (key & 127)) * 4 + kvh) * 64 + half * 32); asm volatile("" : "+v"(ooff));
        {
            float kf[32]; float sq = 0.f;
#pragma unroll
            for (int i = 0; i < 4; ++i) unpack8(*(const u32x4*)(pr + C_K + kvh * 64 + half * 32 + i * 8), kf + 8 * i);
#pragma unroll
            for (int i = 0; i < 32; ++i) sq += kf[i] * kf[i];
            sq += __shfl_xor(sq, 1); const float rs = (tk >= 0) ? rsqrtf(sq * (1.f / 64.f) + EPS) : 0.f; const float* kg = IN_(I_KG) + half * 32;
#pragma unroll
            for (int i = 0; i < 4; ++i) { const f32x4 g0 = *(const f32x4*)(kg + 8 * i), g1 = *(const f32x4*)(kg + 8 * i + 4);
                const f32x4 k0 = (f32x4){kf[8 * i], kf[8 * i + 1], kf[8 * i + 2], kf[8 * i + 3]} * g0 * rs, k1 = (f32x4){kf[8 * i + 4], kf[8 * i + 5], kf[8 * i + 6], kf[8 * i + 7]} * g1 * rs;
                u32x4 q; q.x = pk2(k0[0], k0[1]); q.y = pk2(k0[2], k0[3]); q.z = pk2(k1[0], k1[1]); q.w = pk2(k1[2], k1[3]);
                *(LAS u32x4*)(Ks + key * KP + half * 32 + i * 8) = q;
                if (wout) { float* ok = c.out + O_SKP + ooff; *(f32x4*)(ok + 8 * i) = k0; *(f32x4*)(ok + 8 * i + 4) = k1; } }
        }
        asm volatile("" ::: "memory");
        {
            float vf[32];
#pragma unroll
            for (int i = 0; i < 4; ++i) unpack8(*(const u32x4*)(pr + C_V + kvh * 64 + half * 32 + i * 8), vf + 8 * i);
            if (tk < 0) {
#pragma unroll
                for (int i = 0; i < 32; ++i) vf[i] = 0.f;
            }
#pragma unroll
            for (int i = 0; i < 4; ++i) { u32x4 q; q.x = pk2(vf[8 * i], vf[8 * i + 1]); q.y = pk2(vf[8 * i + 2], vf[8 * i + 3]); q.z = pk2(vf[8 * i + 4], vf[8 * i + 5]); q.w = pk2(vf[8 * i + 6], vf[8 * i + 7]);
                *(LAS u32x4*)(Vn + key * VP + half * 32 + i * 8) = q; }
            if (wout) { float* ov = c.out + O_SVP + ooff;
#pragma unroll
                for (int i = 0; i < 8; ++i) *(f32x4*)(ov + 4 * i) = (f32x4){vf[4 * i], vf[4 * i + 1], vf[4 * i + 2], vf[4 * i + 3]}; }
        }
    }
    __syncthreads();
#pragma unroll
    for (int it = 0; it < 4; ++it) {
        asm volatile("" ::: "memory");
        const int combo = w * 2 + (it >> 1), mi = it & 1, gq = combo & 3, rg = combo >> 2, head = kvh * 4 + gq; const float sink = IN_(I_SINK)[head];
        const int r = 16 * mi + fr; const size_t row = (size_t)b * SEQ + blk * 128 + 32 * rg + r;
        bf16x8 qf[2];
        { float f[16]; float sq = 0.f;
#pragma unroll
            for (int kk = 0; kk < 2; ++kk) unpack8(qraw[it][kk], f + 8 * kk);
#pragma unroll
            for (int i = 0; i < 16; ++i) sq += f[i] * f[i];
            sq += __shfl_xor(sq, 16); sq += __shfl_xor(sq, 32); const float rs = rsqrtf(sq * (1.f / 64.f) + EPS) * 0.125f;
#pragma unroll
            for (int kk = 0; kk < 2; ++kk) { const float* qg = IN_(I_QG) + kk * 32 + fq * 8; u32x4 q; q.x = pk2(f[8 * kk] * rs * qg[0], f[8 * kk + 1] * rs * qg[1]); q.y = pk2(f[8 * kk + 2] * rs * qg[2], f[8 * kk + 3] * rs * qg[3]);
                q.z = pk2(f[8 * kk + 4] * rs * qg[4], f[8 * kk + 5] * rs * qg[5]); q.w = pk2(f[8 * kk + 6] * rs * qg[6], f[8 * kk + 7] * rs * qg[7]); qf[kk] = __builtin_bit_cast(bf16x8, q); } }
        f32x4 S[10];
#pragma unroll
        for (int ni = 0; ni < 10; ++ni) S[ni] = (f32x4){0.f, 0.f, 0.f, 0.f};
#pragma unroll
        for (int ni = 0; ni < 10; ++ni)
#pragma unroll
            for (int kk = 0; kk < 2; ++kk) { __builtin_amdgcn_sched_barrier(0); const bf16x8 bf = *(const LAS bf16x8*)(Ks + (32 * rg + 16 * ni + fr) * KP + kk * 32 + fq * 8); S[ni] = MFMA16(bf, qf[kk], S[ni]); }
        float mx = sink;
        const int lowlim = blk > 0 ? -100000 : 128 - 32 * rg; const int lo_ = r > lowlim ? r : lowlim;
        int xoff = 4 * fq - lo_; const unsigned hi_ = (unsigned)(r + 128 - lo_); asm volatile("" : "+v"(xoff));
#pragma unroll
        for (int ni = 0; ni < 10; ++ni)
#pragma unroll
            for (int j = 0; j < 4; ++j) { const bool ok = (unsigned)(xoff + (16 * ni + j)) <= hi_;
                S[ni][j] = ok ? S[ni][j] : -1e30f; mx = fmaxf(mx, S[ni][j]); }
        mx = fmaxf(mx, __shfl_xor(mx, 16)); mx = fmaxf(mx, __shfl_xor(mx, 32));
        float sm = 0.f;
#pragma unroll
        for (int ni = 0; ni < 10; ++ni)
#pragma unroll
            for (int j = 0; j < 4; ++j) { const float p = __expf(S[ni][j] - mx); S[ni][j] = p; sm += p; }
        sm += __shfl_xor(sm, 16); sm += __shfl_xor(sm, 32); sm += __expf(sink - mx);
        const float inv = 1.f / sm;
        f32x4 O[4];
#pragma unroll
        for (int nd = 0; nd < 4; ++nd) O[nd] = (f32x4){0.f, 0.f, 0.f, 0.f};
#pragma unroll
        for (int k2 = 0; k2 < 5; ++k2) { __builtin_amdgcn_sched_barrier(0); u32x4 pa; pa.x = pk2(S[2 * k2][0], S[2 * k2][1]); pa.y = pk2(S[2 * k2][2], S[2 * k2][3]); pa.z = pk2(S[2 * k2 + 1][0], S[2 * k2 + 1][1]); pa.w = pk2(S[2 * k2 + 1][2], S[2 * k2 + 1][3]);
            const bf16x8 af = __builtin_bit_cast(bf16x8, pa);
#pragma unroll
            for (int nd = 0; nd < 4; ++nd) { const LAS bf16_t* vp = Vn + (32 * rg + 32 * k2 + 4 * fq + (fr >> 2)) * VP + 16 * nd + 4 * (fr & 3);
                O[nd] = MFMA16(cat8(vtr(vp), vtr(vp + 16 * VP)), af, O[nd]); } }
#pragma unroll
        for (int nd = 0; nd < 4; ++nd) { const f32x4 o = O[nd] * inv; u32x2 wv; wv.x = pk2(o[0], o[1]); wv.y = pk2(o[2], o[3]); *(u32x2*)(MIX + row * DMIX + 2048 + head * 64 + 16 * nd + 4 * fq) = wv; }
    }
    __syncthreads();
}

DI void swa_sample_pair(const Ctx& c, int P) {
    int tid_ = c.tid; asm volatile("" : "+v"(tid_)); const int tid = tid_, lane = tid & 63, w = __builtin_amdgcn_readfirstlane(tid >> 6);
    const int combo = 2 * P + (w >> 2), q4 = w & 3, b = combo >> 2, kvh = combo & 3;
    LAS float* qs = (LAS float*)(c.lds + w * 4096); LAS float* ps = qs + 256; LAS float* po = qs + 384; LAS float* pm = qs + 640; LAS float* psm = qs + 644;
    const bf16_t* pr = (const bf16_t*)(c.ws + WS_PROJ) + (size_t)(MP + b) * DINP; bf16_t* MIX = (bf16_t*)(c.ws + WS_MIX);
    const float* ck = IN_(I_CSK); const float* cv = IN_(I_CSV); float* ok = c.out + O_SKS; float* ov = c.out + O_SVS;
#pragma unroll
    for (int g = 0; g < 4; ++g) { const float qr = bf1(pr[C_Q + (kvh * 4 + g) * 64 + lane]); const float s2 = wave_sum(qr * qr); qs[g * 64 + lane] = qr * rsqrtf(s2 * (1.f / 64.f) + EPS) * IN_(I_QG)[lane] * 0.125f; }
    LDS_FENCE();
    const int s = 32 * q4 + (lane & 31), half = lane >> 5;
    float lg[4];
    {
        const float* kr = ck + ((size_t)(b * 128 + s) * 4 + kvh) * 64 + half * 32; f32x4 kv[8];
#pragma unroll
        for (int i = 0; i < 8; ++i) kv[i] = *(const f32x4*)(kr + 4 * i);
        if (s >= 1) { float* kw = ok + ((size_t)(b * 128 + s - 1) * 4 + kvh) * 64 + half * 32;
#pragma unroll
            for (int i = 0; i < 8; ++i) *(f32x4*)(kw + 4 * i) = kv[i]; }
#pragma unroll
        for (int g = 0; g < 4; ++g) { float a = 0.f;
#pragma unroll
            for (int i = 0; i < 8; ++i) { const f32x4 qv = *(const LAS f32x4*)(qs + g * 64 + half * 32 + 4 * i); a += (kv[i].x * qv.x + kv[i].y * qv.y) + (kv[i].z * qv.z + kv[i].w * qv.w); }
            a += __shfl_xor(a, 32); lg[g] = a; }
    }
#pragma unroll
    for (int g = 0; g < 4; ++g) { const float mx = wave_max(lg[g]); const float p = __expf(lg[g] - mx); const float sm = wave_sum(lane < 32 ? p : 0.f);
        if (lane < 32) ps[g * 32 + lane] = p; if (lane == 0) { pm[g] = mx; psm[g] = sm; } }
    LDS_FENCE();
    {
        float o[4] = {0.f, 0.f, 0.f, 0.f};
#pragma unroll 1
        for (int i0 = 0; i0 < 32; i0 += 8) { float v[8];
#pragma unroll
            for (int i = 0; i < 8; ++i) v[i] = cv[((size_t)(b * 128 + 32 * q4 + i0 + i) * 4 + kvh) * 64 + lane];
#pragma unroll
            for (int i = 0; i < 8; ++i) { const int sk = 32 * q4 + i0 + i; if (sk >= 1) ov[((size_t)(b * 128 + sk - 1) * 4 + kvh) * 64 + lane] = v[i];
#pragma unroll
                for (int g = 0; g < 4; ++g) o[g] += ps[g * 32 + i0 + i] * v[i]; } }
#pragma unroll
        for (int g = 0; g < 4; ++g) po[g * 64 + lane] = o[g];
    }
    __syncthreads();
    if (q4 == 0) {
        const float kraw = bf1(pr[C_K + kvh * 64 + lane]); const float ss = wave_sum(kraw * kraw); const float knew = kraw * rsqrtf(ss * (1.f / 64.f) + EPS) * IN_(I_KG)[lane];
        const float vnew = bf1(pr[C_V + kvh * 64 + lane]);
        ok[((size_t)(b * 128 + 127) * 4 + kvh) * 64 + lane] = knew; ov[((size_t)(b * 128 + 127) * 4 + kvh) * 64 + lane] = vnew;
#pragma unroll
        for (int g = 0; g < 4; ++g) { const float lnew = wave_sum(qs[g * 64 + lane] * knew), sink = IN_(I_SINK)[kvh * 4 + g];
            float m[4], sm[4]; float M = fmaxf(lnew, sink);
#pragma unroll
            for (int j = 0; j < 4; ++j) { const LAS float* qj = qs + j * 1024; m[j] = qj[640 + g]; sm[j] = qj[644 + g]; M = fmaxf(M, m[j]); }
            float S = __expf(lnew - M) + __expf(sink - M), o = __expf(lnew - M) * vnew;
#pragma unroll
            for (int j = 0; j < 4; ++j) { const float e = __expf(m[j] - M); S += sm[j] * e; o += (qs + j * 1024)[384 + g * 64 + lane] * e; }
            MIX[(size_t)(MP + b) * DMIX + 2048 + (kvh * 4 + g) * 64 + lane] = f2bf(o / S); }
    }
    __syncthreads();
}

DI void ssd_sample_wave(const Ctx& c, int wu) {
    int lane_ = c.lane; asm volatile("" : "+v"(lane_)); const int b = wu >> 5, h = wu & 31, g = h >> 3, lane = lane_;
    LAS float* xs = (LAS float*)(c.lds + c.wave * 4096); LAS float* Bsm = xs + 64; LAS float* Csm = xs + 192;
    const bf16_t* pr = (const bf16_t*)(c.ws + WS_PROJ) + (size_t)(MP + b) * DINP; bf16_t* MIX = (bf16_t*)(c.ws + WS_MIX);
    const float* cw = IN_(I_SCW); const float* cb = IN_(I_SCB); const float* scs = IN_(I_SSC) + (size_t)b * 3 * CONVD;
#pragma unroll
    for (int q = 0; q < 5; ++q) { const int cch = q == 0 ? h * 64 + lane : (q < 3 ? 2048 + g * 128 + (q - 1) * 64 + lane : 2560 + g * 128 + (q - 3) * 64 + lane);
        float v = cb[cch] + cw[cch] * scs[cch] + cw[CONVD + cch] * scs[CONVD + cch] + cw[2 * CONVD + cch] * scs[2 * CONVD + cch] + cw[3 * CONVD + cch] * bf1(pr[C_XBC + cch]);
        v = silu_f(v); if (q == 0) xs[lane] = v; else if (q < 3) Bsm[(q - 1) * 64 + lane] = v; else Csm[(q - 3) * 64 + lane] = v; }
    LDS_FENCE();
    const float dt = softplus_f(((const float*)(c.ws + WS_DT))[(size_t)(MP + b) * 32 + h] + IN_(I_DTB)[h]); const float dA = __expf(-dt * __expf(IN_(I_ALOG)[h])), Dh = IN_(I_DSK)[h];
    const int n4 = (lane & 31) * 4, psub = lane >> 5;
    const f32x4 Bv = *(const LAS f32x4*)(Bsm + n4), Cv = *(const LAS f32x4*)(Csm + n4);
    const float* hs = IN_(I_SS) + (size_t)(b * 32 + h) * 64 * 128; float* ho = c.out + O_SSS + (size_t)(b * 32 + h) * 64 * 128;
    float sq = 0.f;
#pragma unroll 1
    for (int it0 = 0; it0 < 32; it0 += 16) { f32x4 hv[16];
#pragma unroll
        for (int i = 0; i < 16; ++i) hv[i] = *(const f32x4*)(hs + (2 * (it0 + i) + psub) * 128 + n4);
#pragma unroll
        for (int i = 0; i < 16; ++i) { const int p = 2 * (it0 + i) + psub; const float xv = xs[p], xb = dt * xv;
            const f32x4 hn = hv[i] * dA + Bv * xb; *(f32x4*)(ho + p * 128 + n4) = hn;
            float part = (hn.x * Cv.x + hn.y * Cv.y) + (hn.z * Cv.z + hn.w * Cv.w);
#pragma unroll
            for (int o = 1; o < 32; o <<= 1) part += __shfl_xor(part, o);
            if ((lane & 31) == 0) { float yv = part + Dh * xv; yv *= silu_f(bf1(pr[C_Z + h * 64 + p])); sq += yv * yv; MIX[(size_t)(MP + b) * DMIX + h * 64 + p] = f2bf(yv); } } }
    sq = wave_sum(sq); if (lane == 0) atomicAdd((float*)(c.ws + WS_SSQ) + (c.dry ? 3 * MPAD : 0) + MP + b, sq);
    LDS_FENCE();
}

DI void p2_mixers(const Ctx& c) {
#ifndef P2SEL
#define P2SEL 15
#endif
#ifndef DRYSEL
#define DRYSEL 15
#endif
    const int sel_ = c.dry ? (DRYSEL) : (P2SEL);
    if (sel_ & 1) for (int u = c.bid; u < 256; u += c.G) ssd_prompt_unit(c, u);
    if (sel_ & 2) for (int u = c.bid; u < 256; u += c.G) swa_prompt_unit(c, u);
    const int gw = c.bid * 8 + c.wave, NGW = c.G * 8, lane = c.lane;
    if (sel_ & 4) for (int u = gw; u < 4096; u += NGW) ssd_sample_wave(c, u);
    if (sel_ & 8) for (int u = c.bid; u < 256; u += c.G) swa_sample_pair(c, u);
    if (!c.dry) for (int u = gw; u < 4096; u += NGW) { float* p = c.out + O_MKP + (size_t)u * 128; f32x2 v = ((f32x2*)p)[lane]; const float rs = rsqrtf(wave_sum(v.x * v.x + v.y * v.y) * (1.f / 128.f) + EPS);
        const f32x2 gg = ((const f32x2*)IN_(I_CKG))[lane]; v.x *= rs * gg.x; v.y *= rs * gg.y; ((f32x2*)p)[lane] = v; }
    const bf16_t* PROJ = (const bf16_t*)(c.ws + WS_PROJ);
    for (int i = c.bid * 512 + c.tid; i < NB * 3 * CONVD; i += c.G * 512) { const int b = i / (3 * CONVD), j = (i / CONVD) % 3, ch = i % CONVD; c.out[O_SCP + i] = bf1(PROJ[((size_t)b * SEQ + 2045 + j) * DINP + C_XBC + ch]); }
    for (int i = c.bid * 512 + c.tid; i < MS * 3 * CONVD; i += c.G * 512) { const int b = i / (3 * CONVD), j = (i / CONVD) % 3, ch = i % CONVD;
        c.out[O_SCS + i] = j < 2 ? IN_(I_SSC)[((size_t)b * 3 + j + 1) * CONVD + ch] : bf1(PROJ[(size_t)(MP + b) * DINP + C_XBC + ch]); }
}

DI void xattn_prompt_unit(const Ctx& c, int unit) {
    const int b = unit >> 6, head = (unit >> 4) & 3, qb = unit & 15;
    int tid_ = c.tid; asm volatile("" : "+v"(tid_)); const int tid = tid_, lane = tid & 63, w = __builtin_amdgcn_readfirstlane(tid >> 6), fr = lane & 15, fq = lane >> 4;
    constexpr int KP = 136, VP = 136;
    LAS bf16_t* Ks = (LAS bf16_t*)(c.lds); LAS bf16_t* Vn = (LAS bf16_t*)(c.lds + 69632);
    {
        const int key = tid >> 1, half = tid & 1; const float* kp = c.out + O_MKP + ((size_t)(b * 256 + key) * 4 + head) * 128 + half * 64; const float* vp = c.out + O_MVP + ((size_t)(b * 256 + key) * 4 + head) * 128 + half * 64;
#pragma unroll
        for (int i = 0; i < 8; ++i) { const f32x4 a = *(const f32x4*)(kp + 8 * i), bb = *(const f32x4*)(kp + 8 * i + 4); u32x4 q; q.x = pk2(a.x, a.y); q.y = pk2(a.z, a.w); q.z = pk2(bb.x, bb.y); q.w = pk2(bb.z, bb.w);
            *(LAS u32x4*)(Ks + key * KP + half * 64 + 8 * i) = q; }
#pragma unroll
        for (int i = 0; i < 8; ++i) { const f32x4 a = *(const f32x4*)(vp + 8 * i), bb = *(const f32x4*)(vp + 8 * i + 4); u32x4 q; q.x = pk2(a.x, a.y); q.y = pk2(a.z, a.w); q.z = pk2(bb.x, bb.y); q.w = pk2(bb.z, bb.w);
            *(LAS u32x4*)(Vn + key * VP + half * 64 + 8 * i) = q; }
    }
    __syncthreads();
    const bf16_t* QC = (const bf16_t*)(c.ws + WS_QC); bf16_t* OC = (bf16_t*)(c.ws + WS_OC);
    const size_t row = (size_t)b * SEQ + qb * 128 + 16 * w + fr;
    bf16x8 qf[4];
    { float f[32]; float sq = 0.f;
#pragma unroll
        for (int kk = 0; kk < 4; ++kk) unpack8(*(const u32x4*)(QC + row * DXA + head * 128 + kk * 32 + fq * 8), f + 8 * kk);
#pragma unroll
        for (int i = 0; i < 32; ++i) sq += f[i] * f[i];
        sq += __shfl_xor(sq, 16); sq += __shfl_xor(sq, 32); const float rs = rsqrtf(sq * (1.f / 128.f) + EPS) * 0.08838834764831845f;
#pragma unroll
        for (int kk = 0; kk < 4; ++kk) { const float* qg = IN_(I_CQG) + kk * 32 + fq * 8; u32x4 q; q.x = pk2(f[8 * kk] * rs * qg[0], f[8 * kk + 1] * rs * qg[1]); q.y = pk2(f[8 * kk + 2] * rs * qg[2], f[8 * kk + 3] * rs * qg[3]);
            q.z = pk2(f[8 * kk + 4] * rs * qg[4], f[8 * kk + 5] * rs * qg[5]); q.w = pk2(f[8 * kk + 6] * rs * qg[6], f[8 * kk + 7] * rs * qg[7]); qf[kk] = __builtin_bit_cast(bf16x8, q); } }
    f32x4 S[16];
#pragma unroll
    for (int ni = 0; ni < 16; ++ni) S[ni] = (f32x4){0.f, 0.f, 0.f, 0.f};
#pragma unroll
    for (int ni = 0; ni < 16; ++ni)
#pragma unroll
        for (int kk = 0; kk < 4; ++kk) { __builtin_amdgcn_sched_barrier(0); const bf16x8 bf = *(const LAS bf16x8*)(Ks + (16 * ni + fr) * KP + kk * 32 + fq * 8); S[ni] = MFMA16(bf, qf[kk], S[ni]); }
    float mx = -1e30f;
#pragma unroll
    for (int ni = 0; ni < 16; ++ni)
#pragma unroll
        for (int j = 0; j < 4; ++j) mx = fmaxf(mx, S[ni][j]);
    mx = fmaxf(mx, __shfl_xor(mx, 16)); mx = fmaxf(mx, __shfl_xor(mx, 32));
    float sm = 0.f;
#pragma unroll
    for (int ni = 0; ni < 16; ++ni)
#pragma unroll
        for (int j = 0; j < 4; ++j) { const float p = __expf(S[ni][j] - mx); S[ni][j] = p; sm += p; }
    sm += __shfl_xor(sm, 16); sm += __shfl_xor(sm, 32); const float inv = 1.f / sm;
    f32x4 O[8];
#pragma unroll
    for (int nd = 0; nd < 8; ++nd) O[nd] = (f32x4){0.f, 0.f, 0.f, 0.f};
#pragma unroll
    for (int k2 = 0; k2 < 8; ++k2) { __builtin_amdgcn_sched_barrier(0); u32x4 pa; pa.x = pk2(S[2 * k2][0], S[2 * k2][1]); pa.y = pk2(S[2 * k2][2], S[2 * k2][3]); pa.z = pk2(S[2 * k2 + 1][0], S[2 * k2 + 1][1]); pa.w = pk2(S[2 * k2 + 1][2], S[2 * k2 + 1][3]);
        const bf16x8 af = __builtin_bit_cast(bf16x8, pa);
#pragma unroll
        for (int nd = 0; nd < 8; ++nd) { const LAS bf16_t* vp = Vn + (32 * k2 + 4 * fq + (fr >> 2)) * VP + 16 * nd + 4 * (fr & 3);
            O[nd] = MFMA16(cat8(vtr(vp), vtr(vp + 16 * VP)), af, O[nd]); } }
#pragma unroll
    for (int nd = 0; nd < 8; ++nd) { const f32x4 o = O[nd] * inv; u32x2 wv; wv.x = pk2(o[0], o[1]); wv.y = pk2(o[2], o[3]); *(u32x2*)(OC + row * DXA + head * 128 + 16 * nd + 4 * fq) = wv; }
    __syncthreads();
}
DI void xattn_sample_pair(const Ctx& c, int P) {
    int tid_ = c.tid; asm volatile("" : "+v"(tid_)); const int tid = tid_, lane = tid & 63, w = __builtin_amdgcn_readfirstlane(tid >> 6);
    const int combo = 2 * P + (w >> 2), q4 = w & 3, b = combo >> 2, head = combo & 3;
    LAS float* qs = (LAS float*)(c.lds + w * 4096); LAS float* ps = qs + 128; LAS float* po = qs + 192; LAS float* pm = qs + 320;
    const bf16_t* QC = (const bf16_t*)(c.ws + WS_QC); bf16_t* OC = (bf16_t*)(c.ws + WS_OC);
    const unsigned qw = *(const unsigned*)(QC + (size_t)(MP + b) * DXA + head * 128 + 2 * lane); const float q0 = bflo(qw), q1 = bfhi(qw);
    const float rs = rsqrtf(wave_sum(q0 * q0 + q1 * q1) * (1.f / 128.f) + EPS) * 0.08838834764831845f; const f32x2 gg = ((const f32x2*)IN_(I_CQG))[lane];
    qs[2 * lane] = q0 * rs * gg.x; qs[2 * lane + 1] = q1 * rs * gg.y;
    LDS_FENCE();
    const int m0 = 64 * q4;
    float lg;
    { const float* kr = IN_(I_CMK) + ((size_t)(b * 256 + m0 + lane) * 4 + head) * 128; float a = 0.f;
#pragma unroll 1
        for (int d0 = 0; d0 < 32; d0 += 8) { f32x4 kv[8];
#pragma unroll
            for (int i = 0; i < 8; ++i) kv[i] = *(const f32x4*)(kr + 4 * (d0 + i));
#pragma unroll
            for (int i = 0; i < 8; ++i) { const f32x4 qv = *(const LAS f32x4*)(qs + 4 * (d0 + i)); a += (kv[i].x * qv.x + kv[i].y * qv.y) + (kv[i].z * qv.z + kv[i].w * qv.w); } }
        lg = a; }
    const float mx = wave_max(lg); const float p = __expf(lg - mx); const float sm = wave_sum(p);
    ps[lane] = p; if (lane == 0) { pm[0] = mx; pm[1] = sm; }
    LDS_FENCE();
    { float o0 = 0.f, o1 = 0.f; const float* vr = IN_(I_CMV) + ((size_t)(b * 256 + m0) * 4 + head) * 128 + 2 * lane;
#pragma unroll 1
        for (int i0 = 0; i0 < 64; i0 += 16) { f32x2 v[16];
#pragma unroll
            for (int i = 0; i < 16; ++i) v[i] = *(const f32x2*)(vr + (size_t)(i0 + i) * 512);
#pragma unroll
            for (int i = 0; i < 16; ++i) { const float pp = ps[i0 + i]; o0 += pp * v[i].x; o1 += pp * v[i].y; } }
        po[2 * lane] = o0; po[2 * lane + 1] = o1; }
    __syncthreads();
    if (q4 == 0) {
        float m[4], sm4[4]; float M = -1e30f;
#pragma unroll
        for (int j = 0; j < 4; ++j) { const LAS float* qj = qs + j * 1024; m[j] = qj[320]; sm4[j] = qj[321]; M = fmaxf(M, m[j]); }
        float S = 0.f, o0 = 0.f, o1 = 0.f;
#pragma unroll
        for (int j = 0; j < 4; ++j) { const float e = __expf(m[j] - M); S += sm4[j] * e; o0 += (qs + j * 1024)[192 + 2 * lane] * e; o1 += (qs + j * 1024)[192 + 2 * lane + 1] * e; }
        const float inv = 1.f / S;
        *(unsigned*)(OC + (size_t)(MP + b) * DXA + head * 128 + 2 * lane) = pk2(o0 * inv, o1 * inv);
    }
    __syncthreads();
}

DI void p8_convgate(const Ctx& c) {
    const bf16_t* U = (const bf16_t*)(c.ws + WS_U); bf16_t* H = (bf16_t*)(c.ws + WS_H);
    const float* fw = IN_(I_FCW); const float* fb = IN_(I_FCB);
    const int gw = c.bid * 8 + c.wave, NGW = c.G * 8, lane = c.lane;
    for (int task = gw; task < 512 * 11; task += NGW) {
        const int seg = task / 11, j8 = (task % 11) * 64 + lane, r0 = seg * 16, tl0 = r0 & (SEQ - 1), b = r0 >> 11;
        float wg[3][8], wv[3][8], bg[8], bv[8];
#pragma unroll
        for (int i = 0; i < 3; ++i) { const f32x4 a = *(const f32x4*)(fw + (size_t)i * DFF2 + j8 * 8), a2 = *(const f32x4*)(fw + (size_t)i * DFF2 + j8 * 8 + 4), d = *(const f32x4*)(fw + (size_t)i * DFF2 + DFF + j8 * 8), d2 = *(const f32x4*)(fw + (size_t)i * DFF2 + DFF + j8 * 8 + 4);
            wg[i][0] = a.x; wg[i][1] = a.y; wg[i][2] = a.z; wg[i][3] = a.w; wg[i][4] = a2.x; wg[i][5] = a2.y; wg[i][6] = a2.z; wg[i][7] = a2.w;
            wv[i][0] = d.x; wv[i][1] = d.y; wv[i][2] = d.z; wv[i][3] = d.w; wv[i][4] = d2.x; wv[i][5] = d2.y; wv[i][6] = d2.z; wv[i][7] = d2.w; }
        { const f32x4 a = *(const f32x4*)(fb + j8 * 8), a2 = *(const f32x4*)(fb + j8 * 8 + 4), d = *(const f32x4*)(fb + DFF + j8 * 8), d2 = *(const f32x4*)(fb + DFF + j8 * 8 + 4);
            bg[0] = a.x; bg[1] = a.y; bg[2] = a.z; bg[3] = a.w; bg[4] = a2.x; bg[5] = a2.y; bg[6] = a2.z; bg[7] = a2.w; bv[0] = d.x; bv[1] = d.y; bv[2] = d.z; bv[3] = d.w; bv[4] = d2.x; bv[5] = d2.y; bv[6] = d2.z; bv[7] = d2.w; }
        float g1[8], g2[8], v1[8], v2[8];
        if (tl0 == 0) {
#pragma unroll
            for (int j = 0; j < 8; ++j) { g1[j] = 0.f; g2[j] = 0.f; v1[j] = 0.f; v2[j] = 0.f; }
        } else { const bf16_t* up = U + (size_t)(r0 - 2) * DFF2 + j8 * 8; unpack8(*(const u32x4*)up, g1); unpack8(*(const u32x4*)(up + DFF), v1); unpack8(*(const u32x4*)(up + DFF2), g2); unpack8(*(const u32x4*)(up + DFF2 + DFF), v2); }
#pragma unroll 1
        for (int rb = 0; rb < 16; rb += 4) { u32x4 lg_[4], lv_[4];
#pragma unroll
          for (int r4 = 0; r4 < 4; ++r4) { const bf16_t* up = U + ((size_t)r0 + rb + r4) * DFF2 + j8 * 8; lg_[r4] = *(const u32x4*)up; lv_[r4] = *(const u32x4*)(up + DFF); }
#pragma unroll
          for (int r4 = 0; r4 < 4; ++r4) { const int r = rb + r4; const size_t row = (size_t)r0 + r; float g3[8], v3[8], o[8]; unpack8(lg_[r4], g3); unpack8(lv_[r4], v3);
#pragma unroll
            for (int j = 0; j < 8; ++j) { const float cgv = bg[j] + wg[0][j] * g1[j] + wg[1][j] * g2[j] + wg[2][j] * g3[j], cvv = bv[j] + wv[0][j] * v1[j] + wv[1][j] * v2[j] + wv[2][j] * v3[j]; o[j] = silu_f(cgv) * cvv; g1[j] = g2[j]; g2[j] = g3[j]; v1[j] = v2[j]; v2[j] = v3[j]; }
            u32x4 q; q.x = pk2(o[0], o[1]); q.y = pk2(o[2], o[3]); q.z = pk2(o[4], o[5]); q.w = pk2(o[6], o[7]); *(u32x4*)(H + row * DFF + j8 * 8) = q;
            const int tl = tl0 + r;
            if (tl >= SEQ - 2) { float* fo = c.out + O_FCP + ((size_t)b * 2 + (tl - (SEQ - 2))) * DFF2 + j8 * 8;
                *(f32x4*)fo = (f32x4){g3[0], g3[1], g3[2], g3[3]}; *(f32x4*)(fo + 4) = (f32x4){g3[4], g3[5], g3[6], g3[7]}; *(f32x4*)(fo + DFF) = (f32x4){v3[0], v3[1], v3[2], v3[3]}; *(f32x4*)(fo + DFF + 4) = (f32x4){v3[4], v3[5], v3[6], v3[7]}; } } }
    }
    for (int i = c.bid * 512 + c.tid; i < MS * 704; i += c.G * 512) { const int b = i / 704, j8 = i % 704; const size_t row = MP + b; const float* st = IN_(I_SFC) + (size_t)b * 2 * DFF2; float* fo = c.out + O_FCS + (size_t)b * 2 * DFF2;
        float g3[8], v3[8], o[8]; const bf16_t* up = U + row * DFF2 + j8 * 8; unpack8(*(const u32x4*)up, g3); unpack8(*(const u32x4*)(up + DFF), v3);
#pragma unroll
        for (int j = 0; j < 8; ++j) { const int cg_ = j8 * 8 + j, cv_ = DFF + cg_; const float g1 = st[cg_], g2 = st[DFF2 + cg_], v1 = st[cv_], v2 = st[DFF2 + cv_];
            const float cgv = fb[cg_] + fw[cg_] * g1 + fw[DFF2 + cg_] * g2 + fw[2 * DFF2 + cg_] * g3[j], cvv = fb[cv_] + fw[cv_] * v1 + fw[DFF2 + cv_] * v2 + fw[2 * DFF2 + cv_] * v3[j];
            o[j] = silu_f(cgv) * cvv; fo[cg_] = g2; fo[cv_] = v2; fo[DFF2 + cg_] = g3[j]; fo[DFF2 + cv_] = v3[j]; }
        u32x4 q; q.x = pk2(o[0], o[1]); q.y = pk2(o[2], o[3]); q.z = pk2(o[4], o[5]); q.w = pk2(o[6], o[7]); *(u32x4*)(H + row * DFF + j8 * 8) = q; }
}

struct Skinny { const bf16_t* A; const bf16_t* Bt; int K; int ksplit; const float* ssq_in; const float* base; float* out; bf16_t* abf; float* ssq; };
DI void skinny_tile(const Ctx& c, const Skinny& g, int ct) {
    int tid_ = c.tid; asm volatile("" : "+v"(tid_)); const int tid = tid_, lane = tid & 63, w = __builtin_amdgcn_readfirstlane(tid >> 6), fr = lane & 15, fq = lane >> 4;
    const int K = g.K, kw = K >> 3, k0 = w * kw;
    f32x4 acc[8];
#pragma unroll
    for (int mi = 0; mi < 8; ++mi) acc[mi] = (f32x4){0.f, 0.f, 0.f, 0.f};
    const bf16_t* ap = g.A + (size_t)fr * K + k0 + fq * 8; const bf16_t* bp = g.Bt + (size_t)(16 * ct + fr) * K + k0 + fq * 8;
#pragma unroll 2
    for (int ks = 0; ks < kw; ks += 32) {
        if (k0 + ks == g.ksplit && ks != 0) {
#pragma unroll
            for (int mi = 0; mi < 8; ++mi) acc[mi] = acc[mi] * rsqrtf(g.ssq_in[16 * mi + fr] * (1.f / 2048.f) + EPS);
        }
        const bf16x8 bf = *(const bf16x8*)(bp + ks);
#pragma unroll
        for (int mi = 0; mi < 8; ++mi) { const bf16x8 af = *(const bf16x8*)(ap + (size_t)mi * 16 * K + ks); acc[mi] = MFMA16(bf, af, acc[mi]); }
    }
    if (k0 + kw <= g.ksplit) {
#pragma unroll
        for (int mi = 0; mi < 8; ++mi) acc[mi] = acc[mi] * rsqrtf(g.ssq_in[16 * mi + fr] * (1.f / 2048.f) + EPS);
    }
    LAS f32x4* red = (LAS f32x4*)c.lds;
#pragma unroll
    for (int mi = 0; mi < 8; ++mi) red[(w * 8 + mi) * 64 + lane] = acc[mi];
    __syncthreads();
    f32x4 sum = (f32x4){0.f, 0.f, 0.f, 0.f};
#pragma unroll
    for (int ww = 0; ww < 8; ++ww) sum = sum + red[(ww * 8 + w) * 64 + lane];
    const int row = 16 * w + fr, col = 16 * ct + 4 * fq;
    const f32x4 o = *(const f32x4*)(g.base + (size_t)row * DM + col) + sum;
    *(f32x4*)(g.out + (size_t)row * DM + col) = o;
    if (g.abf) { u32x2 wv; wv.x = pk2(o[0], o[1]); wv.y = pk2(o[2], o[3]); *(u32x2*)(g.abf + (size_t)row * DM + col) = wv;
        float sq = (o[0] * o[0] + o[1] * o[1]) + (o[2] * o[2] + o[3] * o[3]); sq += __shfl_xor(sq, 16); sq += __shfl_xor(sq, 32); if (fq == 0) atomicAdd(g.ssq + row, sq); }
    __syncthreads();
}

__global__ void __launch_bounds__(512, 2) fwd_mega(Args args) {
    extern __shared__ __attribute__((aligned(16))) unsigned char lds_raw[];
    cg::grid_group grid = cg::this_grid();
    Ctx c; c.lds = (LAS unsigned char*)lds_raw; c.tid = threadIdx.x; c.lane = c.tid & 63; c.wave = __builtin_amdgcn_readfirstlane(c.tid >> 6); c.G = gridDim.x; c.bid = blockIdx.x;
    c.in = args.in; c.out = args.out; c.ws = args.ws; c.dry = 0;
    unsigned char* ws = args.ws;
    const int lo = args.ph_lo, hi = args.ph_hi;
#ifndef PHMASK
#define PHMASK 0x3ff
#endif
#define PH(k) ((((PHMASK) >> (k)) & 1) && lo <= (k) && (k) < hi)
    volatile LAS unsigned* bst = (volatile LAS unsigned*)(c.lds + LDS_BYTES - 64);
    if (c.tid < 2) bst[c.tid] = 0u;
    __syncthreads();
    XcdBarrier xbar = xcd_barrier_post((unsigned*)(ws + WS_BAR), bst);
    if (lo > 1000) grid.sync();
#define GSYNC() xcd_barrier(xbar)
#define SYNC(k) do { if (PH(k) && PH((k) + 1)) GSYNC(); } while (0)
#ifndef REPEAT_MASK
#define REPEAT_MASK 0
#endif
#define REP(k) (((REPEAT_MASK) >> (k)) & 1)
    float* SSQ = (float*)(ws + WS_SSQ);
    if (PH(0)) p0_prologue(c);
    if (REP(0)) { GSYNC(); p0_prologue(c); }
    SYNC(0);
    if (PH(1)) {
        { pg8::Gemm g{(const bf16_t*)(ws + WS_A0), (const bf16_t*)(ws + WS_WIN), MPAD, DINP, 2048}; pg8::StaticOrder S; S.init(MPAD, DINP, c.G, c.bid);
            EpiProj E{(bf16_t*)(ws + WS_PROJ), (float*)(ws + WS_DT), 0}; pg8::gemm_phase(c.lds, g, S, E); }
        { pg8::Gemm g{(const bf16_t*)(ws + WS_MEMN), (const bf16_t*)(ws + WS_WCKV), 1024, 1024, 2048}; pg8::StaticOrder S; S.init(1024, 1024, c.G, c.G - 1 - c.bid);
            EpiMem E{c.out + O_MKP, c.out + O_MVP, 0}; pg8::gemm_phase(c.lds, g, S, E); }
    }
    SYNC(1);
    if (PH(2)) { p1b_conv(c); GSYNC(); }
    if (PH(2)) p2_mixers(c);
    if (REP(2)) { GSYNC(); c.dry = 1; p2_mixers(c); c.dry = 0; }
    SYNC(2);
    if (PH(3)) { pg8::Gemm g{(const bf16_t*)(ws + WS_MIX), (const bf16_t*)(ws + WS_WOUT), MP, 2048, 3072}; pg8::StaticOrder S; S.init(MP, 2048, c.G, c.bid);
        EpiRes<true> E{IN_(I_XP), IN_(I_XS), (float*)(ws + WS_X1), (float*)(ws + WS_X1) + (size_t)MP * DM, (bf16_t*)(ws + WS_A0), SSQ + MPAD, SSQ, 32}; pg8::gemm_phase(c.lds, g, S, E);
        const Skinny sk{(const bf16_t*)(ws + WS_MIX) + (size_t)MP * DMIX, (const bf16_t*)(ws + WS_WOUT), 3072, 2048, SSQ + MP, IN_(I_XS), (float*)(ws + WS_X1) + (size_t)MP * DM, (bf16_t*)(ws + WS_A0) + (size_t)MP * DM, SSQ + MPAD + MP};
        for (int t = c.bid; t < 256; t += c.G) if ((t & 1) == 0) skinny_tile(c, sk, t >> 1); }
    SYNC(3);
    if (PH(4)) { pg8::Gemm g{(const bf16_t*)(ws + WS_A0), (const bf16_t*)(ws + WS_WCQ), MPAD, 512, 2048}; pg8::StaticOrder S; S.init(MPAD, 512, c.G, c.bid);
        EpiScale E{(bf16_t*)(ws + WS_QC), DXA, SSQ + MPAD, 0}; pg8::gemm_phase(c.lds, g, S, E);
        constexpr int NT3 = (MPAD / 256) * 2;
        if (c.G > NT3) { if (c.bid >= NT3) p0_transposes(c, P0_SPLIT_ITEMS, P0_ALL_ITEMS, (c.bid - NT3) * 8 + c.wave, (c.G - NT3) * 8); }
        else p0_transposes(c, P0_SPLIT_ITEMS, P0_ALL_ITEMS, c.bid * 8 + c.wave, c.G * 8); }
    SYNC(4);
    for (int rep = 0; rep < 1 + REP(5); ++rep) if (PH(5)) {
        if (rep) GSYNC();
        for (int u = c.bid; u < 256; u += c.G) xattn_prompt_unit(c, u);
        for (int u = c.bid; u < 256; u += c.G) xattn_sample_pair(c, u);
    }
    SYNC(5);
    if (PH(6)) { pg8::Gemm g{(const bf16_t*)(ws + WS_OC), (const bf16_t*)(ws + WS_WCO), MP, 2048, 512}; pg8::StaticOrder S; S.init(MP, 2048, c.G, c.bid);
        float* X1 = (float*)(ws + WS_X1);
        EpiRes<false> E{X1, X1 + (size_t)MP * DM, X1, X1 + (size_t)MP * DM, (bf16_t*)(ws + WS_A0), SSQ + 2 * MPAD, nullptr, 0}; pg8::gemm_phase(c.lds, g, S, E);
        const Skinny sk{(const bf16_t*)(ws + WS_OC) + (size_t)MP * DXA, (const bf16_t*)(ws + WS_WCO), 512, -1, nullptr, X1 + (size_t)MP * DM, X1 + (size_t)MP * DM, (bf16_t*)(ws + WS_A0) + (size_t)MP * DM, SSQ + 2 * MPAD + MP};
        for (int t = c.bid; t < 256; t += c.G) if ((t & 1) == 0) skinny_tile(c, sk, t >> 1); }
    SYNC(6);
    if (PH(7)) { pg8::Gemm g{(const bf16_t*)(ws + WS_A0), (const bf16_t*)(ws + WS_WUP), MPAD, DFF2, 2048}; pg8::StaticOrder S; S.init(MPAD, DFF2, c.G, c.bid);
        EpiScale E{(bf16_t*)(ws + WS_U), DFF2, SSQ + 2 * MPAD, 0}; pg8::gemm_phase(c.lds, g, S, E); }
    SYNC(7);
    if (PH(8)) p8_convgate(c);
    if (REP(8)) { GSYNC(); p8_convgate(c); }
    SYNC(8);
#ifdef EXTRA_SYNCS
    for (int i = 0; i < EXTRA_SYNCS; ++i) GSYNC();
#endif
    if (PH(9)) { pg8::Gemm g{(const bf16_t*)(ws + WS_H), (const bf16_t*)(ws + WS_WDN), MP, 2048, DFF}; pg8::StaticOrder S; S.init(MP, 2048, c.G, c.bid);
        const float* X1 = (const float*)(ws + WS_X1);
        EpiRes<false> E{X1, X1 + (size_t)MP * DM, c.out + O_Y, c.out + O_YS, nullptr, nullptr, nullptr, 0}; pg8::gemm_phase(c.lds, g, S, E);
        const Skinny sk{(const bf16_t*)(ws + WS_H) + (size_t)MP * DFF, (const bf16_t*)(ws + WS_WDN), DFF, -1, nullptr, X1 + (size_t)MP * DM, c.out + O_YS, nullptr, nullptr};
        for (int t = c.bid; t < 256; t += c.G) if ((t & 1) == 0) skinny_tile(c, sk, t >> 1); }
}

extern "C" void kernel_launch(void* const* d_in, const int* in_sizes, int n_in, void* d_out, int out_size, void* d_ws, size_t ws_size, hipStream_t stream) {
    static int grid = 0;
    if (grid == 0) {
        if (n_in != 35 || (size_t)out_size != O_END || ws_size < WS_END) { fprintf(stderr, "kernel_launch: unexpected shapes n_in %d out %d ws %zu (need %zu)\n", n_in, out_size, ws_size, (size_t)WS_END); grid = -1; return; }
        int dev = 0, cus = 0, per_cu = 0;
        hipGetDevice(&dev);
        hipDeviceGetAttribute(&cus, hipDeviceAttributeMultiprocessorCount, dev);
        hipFuncSetAttribute((const void*)fwd_mega, hipFuncAttributeMaxDynamicSharedMemorySize, LDS_BYTES);
        hipOccupancyMaxActiveBlocksPerMultiprocessor(&per_cu, (const void*)fwd_mega, 512, LDS_BYTES);
        if (per_cu < 1) fprintf(stderr, "kernel_launch: occupancy query says %d blocks/CU\n", per_cu);
        grid = cus;
    }
    if (grid < 0) return;
    if (hipMemsetAsync((char*)d_ws + WS_BAR, 0, WS_BAR_BYTES, stream) != hipSuccess) { fprintf(stderr, "kernel_launch: hipMemsetAsync failed\n"); return; }
    Args a{};
    for (int i = 0; i < 35; ++i) a.in[i] = (const float*)d_in[i];
    a.out = (float*)d_out; a.ws = (unsigned char*)d_ws; a.ph_lo = 0; a.ph_hi = 10;
    void* args[] = {&a};
    hipError_t e = hipLaunchCooperativeKernel((const void*)fwd_mega, dim3(grid), dim3(512), args, LDS_BYTES, stream);
    if (e != hipSuccess) fprintf(stderr, "cooperative launch failed: %s (grid %d)\n", hipGetErrorString(e), grid);
}
```

```cpp
#include <hip/hip_runtime.h>
#include <hip/hip_cooperative_groups.h>
#include <cstdio>
#include <cstdint>
namespace cg = cooperative_groups;

#define DI __device__ __forceinline__
#define LAS __attribute__((address_space(3)))
typedef unsigned short bf16_t;
typedef short bf16x8 __attribute__((ext_vector_type(8)));
typedef short s16x4 __attribute__((ext_vector_type(4)));
typedef float f32x4 __attribute__((ext_vector_type(4)));
typedef float f32x2 __attribute__((ext_vector_type(2)));
typedef unsigned u32x4 __attribute__((ext_vector_type(4)));
typedef unsigned u32x2 __attribute__((ext_vector_type(2)));
typedef __bf16 bf16x2_t __attribute__((ext_vector_type(2)));

DI unsigned pk2(float lo, float hi) { f32x2 v = {lo, hi}; bf16x2_t b = __builtin_convertvector(v, bf16x2_t); return __builtin_bit_cast(unsigned, b); }
DI float bflo(unsigned w) { return __uint_as_float(w << 16); }
DI float bfhi(unsigned w) { return __uint_as_float(w & 0xffff0000u); }
DI float bf1(bf16_t h) { return __uint_as_float(((unsigned)h) << 16); }
DI bf16_t f2bf(float f) { return (bf16_t)(pk2(f, 0.f) & 0xffffu); }
DI void unpack8(u32x4 r, float* o) { o[0] = bflo(r.x); o[1] = bfhi(r.x); o[2] = bflo(r.y); o[3] = bfhi(r.y); o[4] = bflo(r.z); o[5] = bfhi(r.z); o[6] = bflo(r.w); o[7] = bfhi(r.w); }
DI float wave_sum(float v) {
#pragma unroll
    for (int o = 1; o < 64; o <<= 1) v += __shfl_xor(v, o);
    return v;
}
DI float wave_max(float v) {
#pragma unroll
    for (int o = 1; o < 64; o <<= 1) v = fmaxf(v, __shfl_xor(v, o));
    return v;
}
DI float silu_f(float x) { return x / (1.f + __expf(-x)); }
DI float softplus_f(float x) { return x > 20.f ? x : log1pf(__expf(x)); }
#define MFMA16(a, b, c) __builtin_amdgcn_mfma_f32_16x16x32_bf16((a), (b), (c), 0, 0, 0)
#define LDS_FENCE() asm volatile("s_waitcnt lgkmcnt(0)" ::: "memory")
typedef short v4i16_t __attribute__((ext_vector_type(4)));
DI s16x4 vtr(const LAS bf16_t* p) { return __builtin_bit_cast(s16x4, __builtin_amdgcn_ds_read_tr16_b64_v4i16((LAS v4i16_t*)p)); }
DI bf16x8 cat8(s16x4 lo, s16x4 hi) { return __builtin_shufflevector(lo, hi, 0, 1, 2, 3, 4, 5, 6, 7); }

constexpr int DM = 2048, MP = 8192, MS = 128, MTOK = MP + MS, MPAD = 8448, SEQ = 2048, NB = 4;
constexpr int DIN = 6688, DINP = 6912, DMIX = 3072, DXA = 512, DFF = 5632, DFF2 = 11264, CONVD = 3072;
constexpr int C_Q = 0, C_K = 1024, C_V = 1280, C_Z = 1536, C_XBC = 3584, C_DT = 6656;
constexpr float EPS = 1e-6f;
constexpr size_t O_Y = 0, O_YS = O_Y + (size_t)MP * DM, O_SKP = O_YS + (size_t)MS * DM, O_SVP = O_SKP + 131072, O_SKS = O_SVP + 131072,
    O_SVS = O_SKS + 4194304, O_SCP = O_SVS + 4194304, O_SCS = O_SCP + 36864, O_SSP = O_SCS + 1179648, O_SSS = O_SSP + 1048576,
    O_MKP = O_SSS + 33554432, O_MVP = O_MKP + 524288, O_FCP = O_MVP + 524288, O_FCS = O_FCP + 90112, O_END = O_FCS + 2883584;
constexpr size_t MiB = 1u << 20;
constexpr size_t WS_SSQ = 0;
constexpr size_t WS_BAR = 512 * 1024, WS_BAR_BYTES = 16384;
constexpr size_t WS_WIN = 1 * MiB;
constexpr size_t WS_WOUT = WS_WIN + 27 * MiB;
constexpr size_t WS_WCQ = WS_WOUT + 12 * MiB;
constexpr size_t WS_WCKV = WS_WCQ + 2 * MiB;
constexpr size_t WS_WCO = WS_WCKV + 4 * MiB;
constexpr size_t WS_WUP = WS_WCO + 2 * MiB;
constexpr size_t WS_WDN = WS_WUP + 44 * MiB;
constexpr size_t WS_A0 = WS_WDN + 22 * MiB;
constexpr size_t WS_MEMN = WS_A0 + 33 * MiB;
constexpr size_t WS_X1 = WS_MEMN + 4 * MiB;
constexpr size_t WS_QC = WS_X1 + 66 * MiB;
constexpr size_t WS_OC = WS_QC + 9 * MiB;
constexpr size_t WS_DT = WS_OC + 9 * MiB;
constexpr size_t WS_H = WS_DT + 2 * MiB;
constexpr size_t WS_R1 = WS_H + 91 * MiB;
constexpr size_t WS_PROJ = WS_R1, WS_MIX = WS_R1 + 112 * MiB, WS_U = WS_R1;
constexpr size_t WS_UF = WS_R1, WS_UL = WS_R1 + 4 * MiB, WS_USMP = WS_R1 + 8 * MiB;
constexpr size_t WS_END = WS_R1 + 182 * MiB;
constexpr int LDS_BYTES = 147456;

namespace pg8 {
constexpr int BM = 256, BK = 64, HALF = 128, HTB = HALF * BK * 2, STAGE_BYTES = 8 * HTB, NXCD = 8, WGM = 8;
__host__ __device__ __forceinline__ int lds_byte(int r, int c) { const int st = (r >> 4) * 2 + (c >> 5), rr = r & 15, cc = c & 31, ob = rr * 64 + cc * 2; return st * 1024 + (ob ^ (((ob >> 9) & 1) << 5)); }
__host__ __device__ __forceinline__ void stage_rc(int b, int& R, int& C) { const int st = b / 1024, sb = b % 1024, swz = sb ^ (((sb >> 9) & 1) << 5); R = (st >> 1) * 16 + swz / 64; C = (st & 1) * 32 + (swz % 64) / 2; }
__host__ __device__ __forceinline__ int perm32(int rho) { const int n = rho >> 4, i = rho & 15; return 8 * (i >> 2) + 4 * n + (i & 3); }
struct Unit { int pm, pn; };
struct Gemm { const bf16_t* A; const bf16_t* Bt; int M, N, K; };
struct StaticOrder {
    int nM, nN, nwg, G, c;
    __host__ __device__ void init(int M, int N, int G_, int c_) { nM = M / BM; nN = N / BM; nwg = nM * nN; G = G_; c = c_; }
    __host__ __device__ bool next(int i, Unit& u) const {
        const long L = (long)i * G + c; if (L >= nwg) return false;
        int wgid = (int)L; { const int q = nwg / NXCD, r = nwg % NXCD, xcd = wgid % NXCD, off = wgid / NXCD; wgid = (xcd < r ? xcd * (q + 1) : r * (q + 1) + (xcd - r) * q) + off; }
        const int nig = WGM * nN, gid = wgid / nig, fm = gid * WGM, gsz = (nM - fm) < WGM ? (nM - fm) : WGM;
        u.pm = fm + ((wgid % nig) % gsz); u.pn = (wgid % nig) / gsz; return true;
    }
};
template <class Epi, class Sched>
__device__ __forceinline__ void gemm_phase(LAS unsigned char* lds, const Gemm g, const Sched& S, const Epi& E) {
    const int tid = threadIdx.x, wid = __builtin_amdgcn_readfirstlane(tid >> 6), lane = tid & 63, wr = wid >> 2, wc = wid & 3, fr = lane & 15, fq = lane >> 4;
    const int K = g.K, nt = K / BK;
    unsigned voffA[2], voffB[2];
#pragma unroll
    for (int i = 0; i < 2; ++i) { int R, C; stage_rc(tid * 16 + i * 8192, R, C); const int Rb = Epi::PERM ? ((R & ~31) + perm32(R & 31)) : R;
        voffA[i] = (unsigned)(R * K + C) * 2u; voffB[i] = (unsigned)(Rb * K + C) * 2u; }
    const size_t kstep = (size_t)(BK * 2);
    const size_t hstep = (size_t)HALF * K * 2;
    const size_t tstep = 2 * hstep;
    const unsigned ldsw = (unsigned)wid * 1024u;
    const int aoff = lds_byte(wr * 64 + fr, fq * 8), boff = lds_byte(wc * 32 + fr, fq * 8);
#define PG8_SA(b, h) (((b) * 2 + (h)) * HTB)
#define PG8_SB(b, h) ((4 + (b) * 2 + (h)) * HTB)
#define PG8_STAGE(bufoff, gbase, voff) do { _Pragma("unroll") for (int _i = 0; _i < 2; ++_i) \
        __builtin_amdgcn_global_load_lds((const unsigned*)((const char*)(gbase) + (voff)[_i]), (LAS unsigned*)(lds + (bufoff) + ldsw + _i * 8192), 16, 0, 0); } while (0)
#define PG8_LDA(dst, b, h) do { _Pragma("unroll") for (int m = 0; m < 4; ++m) _Pragma("unroll") for (int k = 0; k < 2; ++k) dst[m][k] = *(const LAS bf16x8*)(lds + PG8_SA(b, h) + aoff + m * 2048 + k * 1024); } while (0)
#define PG8_LDB(dst, b, h) do { _Pragma("unroll") for (int n = 0; n < 2; ++n) _Pragma("unroll") for (int k = 0; k < 2; ++k) dst[n][k] = *(const LAS bf16x8*)(lds + PG8_SB(b, h) + boff + n * 2048 + k * 1024); } while (0)
#define PG8_MMA(ai, bj, At, Bt) do { __builtin_amdgcn_s_setprio(1); _Pragma("unroll") for (int m = 0; m < 4; ++m) _Pragma("unroll") for (int n = 0; n < 2; ++n) _Pragma("unroll") for (int k = 0; k < 2; ++k) \
        acc[ai][bj][m][n] = Epi::SWAP ? __builtin_amdgcn_mfma_f32_16x16x32_bf16(At[m][k], Bt[n][k], acc[ai][bj][m][n], 0, 0, 0) : __builtin_amdgcn_mfma_f32_16x16x32_bf16(Bt[n][k], At[m][k], acc[ai][bj][m][n], 0, 0, 0); __builtin_amdgcn_s_setprio(0); } while (0)
#define PG8_WAIT_V(n) asm volatile("s_waitcnt vmcnt(" #n ")" ::: "memory")
#define PG8_WAIT_L(n) asm volatile("s_waitcnt lgkmcnt(" #n ")" ::: "memory")
#define PG8_BAR __builtin_amdgcn_s_barrier()
#define PG8_SCHED __builtin_amdgcn_sched_barrier(0)
    Unit cur, nxt; int ui = 0;
    if (!S.next(0, cur)) return;
    f32x4 acc[2][2][4][2];
#pragma unroll
    for (int a = 0; a < 2; ++a)
#pragma unroll
        for (int b = 0; b < 2; ++b)
#pragma unroll
            for (int m = 0; m < 4; ++m)
#pragma unroll
                for (int n = 0; n < 2; ++n) acc[a][b][m][n] = (f32x4){0.f, 0.f, 0.f, 0.f};
    bf16x8 At[4][2], B0[2][2], B1[2][2];
    const char* cA = (const char*)g.A + (size_t)cur.pm * tstep; const char* cB = (const char*)g.Bt + (size_t)cur.pn * tstep;
    PG8_STAGE(PG8_SB(0, 0), cB, voffB); PG8_STAGE(PG8_SB(0, 1), cB + hstep, voffB); PG8_STAGE(PG8_SA(0, 0), cA, voffA); PG8_STAGE(PG8_SA(0, 1), cA + hstep, voffA);
    if (wr == 1) PG8_BAR;
    PG8_WAIT_V(2); PG8_BAR;
    PG8_STAGE(PG8_SB(1, 0), cB + kstep, voffB); PG8_STAGE(PG8_SA(1, 0), cA + kstep, voffA); PG8_STAGE(PG8_SB(1, 1), cB + hstep + kstep, voffB);
    PG8_WAIT_V(6); PG8_BAR;
    for (;;) {
        const bool has_next = S.next(ui + 1, nxt);
        const char* nA = has_next ? (const char*)g.A + (size_t)nxt.pm * tstep : cA; const char* nB = has_next ? (const char*)g.Bt + (size_t)nxt.pn * tstep : cB;
        for (int t = 0; t < nt; t += 2) {
            const bool last = (t == nt - 2);
            const char* a1 = cA + (size_t)(t + 1) * kstep;
            const char* a2 = last ? nA : cA + (size_t)(t + 2) * kstep; const char* b2 = last ? nB : cB + (size_t)(t + 2) * kstep;
            const char* a3 = a2 + kstep; const char* b3 = b2 + kstep;
            if constexpr (Epi::MID) { if (t == E.tsplit) E.midscale(acc, cur, wr, fr); }
            PG8_LDB(B0, 0, 0); PG8_LDB(B1, 0, 1); PG8_SCHED; PG8_LDA(At, 0, 0); PG8_STAGE(PG8_SA(1, 1), a1 + hstep, voffA);
            PG8_WAIT_V(8); PG8_WAIT_L(0); PG8_BAR; PG8_MMA(0, 0, At, B0); PG8_MMA(0, 1, At, B1); PG8_BAR; PG8_SCHED;
            PG8_LDA(At, 0, 1); PG8_STAGE(PG8_SB(0, 0), b2, voffB); PG8_STAGE(PG8_SB(0, 1), b2 + hstep, voffB); PG8_STAGE(PG8_SA(0, 0), a2, voffA);
            PG8_WAIT_V(8); PG8_WAIT_L(0); PG8_BAR; PG8_MMA(1, 0, At, B0); PG8_MMA(1, 1, At, B1); PG8_BAR; PG8_SCHED;
            PG8_LDB(B0, 1, 0); PG8_LDB(B1, 1, 1); PG8_SCHED; PG8_LDA(At, 1, 0); PG8_STAGE(PG8_SA(0, 1), a2 + hstep, voffA);
            PG8_WAIT_V(8); PG8_WAIT_L(0); PG8_BAR; PG8_MMA(0, 0, At, B0); PG8_MMA(0, 1, At, B1); PG8_BAR; PG8_SCHED;
            PG8_LDA(At, 1, 1); PG8_STAGE(PG8_SB(1, 0), b3, voffB); PG8_STAGE(PG8_SB(1, 1), b3 + hstep, voffB); PG8_STAGE(PG8_SA(1, 0), a3, voffA);
            PG8_WAIT_V(8); PG8_WAIT_L(0); PG8_BAR; PG8_MMA(1, 0, At, B0); PG8_MMA(1, 1, At, B1); PG8_BAR; PG8_SCHED;
        }
        if (wr == 0) PG8_BAR;
        E(acc, cur, wr, wc, fr, fq);
        if (!has_next) break;
#pragma unroll
        for (int a = 0; a < 2; ++a)
#pragma unroll
            for (int b = 0; b < 2; ++b)
#pragma unroll
                for (int m = 0; m < 4; ++m)
#pragma unroll
                    for (int n = 0; n < 2; ++n) acc[a][b][m][n] = (f32x4){0.f, 0.f, 0.f, 0.f};
        cur = nxt; cA = nA; cB = nB; ++ui;
        if (wr == 1) PG8_BAR;
    }
    PG8_WAIT_V(0);
    PG8_BAR;
#undef PG8_SA
#undef PG8_SB
#undef PG8_STAGE
#undef PG8_LDA
#undef PG8_LDB
#undef PG8_MMA
#undef PG8_WAIT_V
#undef PG8_WAIT_L
#undef PG8_BAR
#undef PG8_SCHED
}
}
using pg8::Unit;
typedef f32x4 Acc[2][2][4][2];

struct EpiProj {
    static constexpr bool PERM = true, MID = false, SWAP = false; bf16_t* O; float* dt; int tsplit;
    DI void midscale(Acc&, const Unit&, int, int) const {}
    DI void operator()(const Acc& acc, const Unit& u, int wr, int wc, int fr, int fq) const {
        const int row0 = u.pm * 256 + wr * 64 + fr, col0 = u.pn * 256 + wc * 32 + 8 * fq;
#pragma unroll
        for (int ai = 0; ai < 2; ++ai)
#pragma unroll
            for (int m = 0; m < 4; ++m) { const int row = row0 + ai * 128 + m * 16; bf16_t* rowp = O + (size_t)row * DINP + col0;
#pragma unroll
                for (int bj = 0; bj < 2; ++bj) { const f32x4 v0 = acc[ai][bj][m][0], v1 = acc[ai][bj][m][1]; u32x4 w; w.x = pk2(v0[0], v0[1]); w.y = pk2(v0[2], v0[3]); w.z = pk2(v1[0], v1[1]); w.w = pk2(v1[2], v1[3]);
                    *(u32x4*)(rowp + bj * 128) = w; }
                if (u.pn == 26 && wc == 0) { float* d = dt + (size_t)row * 32 + 8 * fq; *(f32x4*)d = acc[ai][0][m][0]; *(f32x4*)(d + 4) = acc[ai][0][m][1]; } }
    }
};
struct EpiMem {
    static constexpr bool PERM = false, MID = false, SWAP = false; float* outK; float* outV; int tsplit;
    DI void midscale(Acc&, const Unit&, int, int) const {}
    DI void operator()(const Acc& acc, const Unit& u, int wr, int wc, int fr, int fq) const {
        float* base = (u.pn < 2) ? outK : outV; const int colt = (u.pn & 1) * 256 + wc * 32 + 4 * fq;
#pragma unroll
        for (int ai = 0; ai < 2; ++ai)
#pragma unroll
            for (int m = 0; m < 4; ++m) { const int row = u.pm * 256 + ai * 128 + wr * 64 + m * 16 + fr;
#pragma unroll
                for (int bj = 0; bj < 2; ++bj)
#pragma unroll
                    for (int n = 0; n < 2; ++n) *(f32x4*)(base + (size_t)row * 512 + colt + bj * 128 + n * 16) = acc[ai][bj][m][n]; }
    }
};
template <bool MIDS> struct EpiRes {
    static constexpr bool PERM = false, MID = MIDS, SWAP = false;
    const float* baseP; const float* baseS; const bf16_t* baseB; float* outP; float* outS; bf16_t* abf; float* ssq; const float* ssq_in; int tsplit;
    DI void midscale(Acc& acc, const Unit& u, int wr, int fr) const {
        int rbase = u.pm * 256 + wr * 64 + fr; asm volatile("" : "+v"(rbase));
#pragma unroll
        for (int ai = 0; ai < 2; ++ai)
#pragma unroll
            for (int m = 0; m < 4; ++m) { const int row = rbase + ai * 128 + m * 16; const float s = rsqrtf(ssq_in[row] * (1.f / 2048.f) + EPS);
#pragma unroll
                for (int bj = 0; bj < 2; ++bj)
#pragma unroll
                    for (int n = 0; n < 2; ++n) acc[ai][bj][m][n] = acc[ai][bj][m][n] * s; }
    }
    DI void operator()(const Acc& acc, const Unit& u, int wr, int wc, int fr, int fq) const {
        const int col0 = u.pn * 256 + wc * 32 + 4 * fq;
#pragma unroll
        for (int ai = 0; ai < 2; ++ai)
#pragma unroll
            for (int m = 0; m < 4; ++m) { const int row = u.pm * 256 + ai * 128 + wr * 64 + m * 16 + fr;
                if (row < MTOK) {
                    const float* bp = baseB ? nullptr : (row < MP ? baseP + (size_t)row * DM : baseS + (size_t)(row - MP) * DM);
                    float* op = outP ? (row < MP ? outP + (size_t)row * DM : outS + (size_t)(row - MP) * DM) : nullptr;
                    float sq = 0.f;
#pragma unroll
                    for (int bj = 0; bj < 2; ++bj)
#pragma unroll
                        for (int n = 0; n < 2; ++n) { const int c = col0 + bj * 128 + n * 16; f32x4 bs;
                            if (baseB) { const u32x2 r = *(const u32x2*)(baseB + (size_t)row * DM + c); bs = (f32x4){bflo(r.x), bfhi(r.x), bflo(r.y), bfhi(r.y)}; } else bs = *(const f32x4*)(bp + c);
                            const f32x4 o = bs + acc[ai][bj][m][n]; if (op) *(f32x4*)(op + c) = o;
                            if (abf) { u32x2 w; w.x = pk2(o[0], o[1]); w.y = pk2(o[2], o[3]); *(u32x2*)(abf + (size_t)row * DM + c) = w; sq += (o[0] * o[0] + o[1] * o[1]) + (o[2] * o[2] + o[3] * o[3]); } }
                    if (abf) { sq += __shfl_xor(sq, 16); sq += __shfl_xor(sq, 32); if (fq == 0) atomicAdd(ssq + row, sq); }
                }
                asm volatile("" ::: "memory"); }
    }
};
struct EpiScale {
    static constexpr bool PERM = true, MID = false, SWAP = false; bf16_t* O; int ldc; const float* ssq_in; int tsplit;
    DI void midscale(Acc&, const Unit&, int, int) const {}
    DI void operator()(const Acc& acc, const Unit& u, int wr, int wc, int fr, int fq) const {
        const int row0 = u.pm * 256 + wr * 64 + fr, col0 = u.pn * 256 + wc * 32 + 8 * fq;
#pragma unroll
        for (int ai = 0; ai < 2; ++ai)
#pragma unroll
            for (int m = 0; m < 4; ++m) { const int row = row0 + ai * 128 + m * 16; bf16_t* rowp = O + (size_t)row * ldc + col0; const float s = rsqrtf(ssq_in[row] * (1.f / 2048.f) + EPS);
#pragma unroll
                for (int bj = 0; bj < 2; ++bj) { const f32x4 v0 = acc[ai][bj][m][0] * s, v1 = acc[ai][bj][m][1] * s; u32x4 w; w.x = pk2(v0[0], v0[1]); w.y = pk2(v0[2], v0[3]); w.z = pk2(v1[0], v1[1]); w.w = pk2(v1[2], v1[3]);
                    *(u32x4*)(rowp + bj * 128) = w; } }
    }
};

struct EpiGate {
    static constexpr bool PERM = false, MID = false, SWAP = true;
    bf16_t* H; const float* ssq_in; const float* fw; const float* fb; float* UF; float* UL; bf16_t* USMP; float* fcp; LAS float* ex; int tsplit;
    DI void midscale(Acc&, const Unit&, int, int) const {}
    DI void operator()(const Acc& acc, const Unit& u, int wr, int wc, int fr_in, int fq_in) const {
        int fr = fr_in, fq = fq_in; asm volatile("" : "+v"(fr), "+v"(fq));
        const int w = wr * 4 + wc, lane = fq * 16 + fr;
        const int rowq = u.pm * 256 + wr * 64 + 4 * fq;
        const int chan = u.pn * 128 + wc * 32 + fr;
        if (u.pm == 32) {
#pragma unroll
            for (int m = 0; m < 4; ++m) { const int rl = wr * 64 + 16 * m + 4 * fq; const f32x4 sq = *(const f32x4*)(ssq_in + MP + rl);
#pragma unroll
                for (int jj = 0; jj < 4; ++jj) { const float rsv = rsqrtf(sq[jj] * (1.f / 2048.f) + EPS);
#pragma unroll
                    for (int bj = 0; bj < 2; ++bj)
#pragma unroll
                        for (int n = 0; n < 2; ++n) USMP[(size_t)(rl + jj) * DFF2 + bj * DFF + chan + 16 * n] = f2bf(acc[0][bj][m][n][jj] * rsv); } }
            return;
        }
        if (fq == 3) {
#pragma unroll
            for (int ai = 0; ai < 2; ++ai) { const f32x4 sq = *(const f32x4*)(ssq_in + rowq + 128 * ai + 48);
                const float r2 = rsqrtf(sq[2] * (1.f / 2048.f) + EPS), r3 = rsqrtf(sq[3] * (1.f / 2048.f) + EPS);
#pragma unroll
                for (int bj = 0; bj < 2; ++bj)
#pragma unroll
                    for (int n = 0; n < 2; ++n) { const float v2 = acc[ai][bj][3][n][2] * r2, v3 = acc[ai][bj][3][n][3] * r3;
                        LAS float* e = ex + ((w * 2 + ai) * 2) * 64 + bj * 32 + n * 16 + fr; e[0] = v2; e[64] = v3;
                        if (ai == 1 && wr == 1) { float* ul = UL + (size_t)(u.pm * 2) * DFF2 + bj * DFF + chan + 16 * n; ul[0] = v2; ul[DFF2] = v3;
                            if ((u.pm & 7) == 7) { float* fo = fcp + (size_t)((u.pm >> 3) * 2) * DFF2 + bj * DFF + chan + 16 * n; fo[0] = v2; fo[DFF2] = v3; } } } }
        }
        if (fq == 0 && wr == 0) { const f32x4 sq = *(const f32x4*)(ssq_in + rowq);
            const float r0 = rsqrtf(sq[0] * (1.f / 2048.f) + EPS), r1 = rsqrtf(sq[1] * (1.f / 2048.f) + EPS);
#pragma unroll
            for (int bj = 0; bj < 2; ++bj)
#pragma unroll
                for (int n = 0; n < 2; ++n) { float* uf = UF + (size_t)(u.pm * 2) * DFF2 + bj * DFF + chan + 16 * n; uf[0] = acc[0][bj][0][n][0] * r0; uf[DFF2] = acc[0][bj][0][n][1] * r1; } }
        asm volatile("s_waitcnt lgkmcnt(0)" ::: "memory"); __builtin_amdgcn_s_barrier(); asm volatile("" ::: "memory");
        float wg[2][3], wv[2][3], bg[2], bv[2];
#pragma unroll
        for (int n = 0; n < 2; ++n) {
#pragma unroll
            for (int t = 0; t < 3; ++t) { wg[n][t] = fw[(size_t)t * DFF2 + chan + 16 * n]; wv[n][t] = fw[(size_t)t * DFF2 + DFF + chan + 16 * n]; }
            bg[n] = fb[chan + 16 * n]; bv[n] = fb[DFF + chan + 16 * n]; }
        const int srcl = (lane + 48) & 63;
#pragma unroll
        for (int ai = 0; ai < 2; ++ai) {
            const bool hal = (wr == 1 || ai == 1);
            const LAS float* hb = ex + (wr == 1 ? ((w - 4) * 2 + ai) * 2 : ((w + 4) * 2 + 0) * 2) * 64 + fr;
            f32x4 gl[2], vl[2];
#pragma unroll
            for (int m = 0; m < 4; ++m) {
                const f32x4 sq = *(const f32x4*)(ssq_in + rowq + 128 * ai + 16 * m); f32x4 rs4;
#pragma unroll
                for (int jj = 0; jj < 4; ++jj) rs4[jj] = rsqrtf(sq[jj] * (1.f / 2048.f) + EPS);
#pragma unroll
                for (int n = 0; n < 2; ++n) {
                    const f32x4 g = acc[ai][0][m][n] * rs4, v = acc[ai][1][m][n] * rs4;
                    float g2 = __shfl(g[2], srcl), g3 = __shfl(g[3], srcl), v2 = __shfl(v[2], srcl), v3 = __shfl(v[3], srcl);
                    if (m > 0) { const float a2 = __shfl(gl[n][2], srcl), a3 = __shfl(gl[n][3], srcl), c2 = __shfl(vl[n][2], srcl), c3 = __shfl(vl[n][3], srcl);
                        if (fq == 0) { g2 = a2; g3 = a3; v2 = c2; v3 = c3; } }
                    else { const float t0 = hb[n * 16], t1 = hb[32 + n * 16], t2 = hb[64 + n * 16], t3 = hb[96 + n * 16];
                        if (fq == 0) { g2 = hal ? t0 : 0.f; v2 = hal ? t1 : 0.f; g3 = hal ? t2 : 0.f; v3 = hal ? t3 : 0.f; } }
                    gl[n] = g; vl[n] = v;
                    float hh[4];
                    { const float c0 = bg[n] + wg[n][0] * g2 + wg[n][1] * g3 + wg[n][2] * g[0], d0 = bv[n] + wv[n][0] * v2 + wv[n][1] * v3 + wv[n][2] * v[0]; hh[0] = silu_f(c0) * d0; }
                    { const float c1 = bg[n] + wg[n][0] * g3 + wg[n][1] * g[0] + wg[n][2] * g[1], d1 = bv[n] + wv[n][0] * v3 + wv[n][1] * v[0] + wv[n][2] * v[1]; hh[1] = silu_f(c1) * d1; }
                    { const float c2 = bg[n] + wg[n][0] * g[0] + wg[n][1] * g[1] + wg[n][2] * g[2], d2 = bv[n] + wv[n][0] * v[0] + wv[n][1] * v[1] + wv[n][2] * v[2]; hh[2] = silu_f(c2) * d2; }
                    { const float c3 = bg[n] + wg[n][0] * g[1] + wg[n][1] * g[2] + wg[n][2] * g[3], d3 = bv[n] + wv[n][0] * v[1] + wv[n][1] * v[2] + wv[n][2] * v[3]; hh[3] = silu_f(c3) * d3; }
                    bf16_t* hp = H + (size_t)(rowq + 128 * ai + 16 * m) * DFF + chan + 16 * n;
                    const bool skip01 = (ai == 0 && m == 0 && wr == 0 && fq == 0 && (u.pm & 7) != 0);
                    if (!skip01) { hp[0] = f2bf(hh[0]); hp[DFF] = f2bf(hh[1]); }
                    hp[2 * DFF] = f2bf(hh[2]); hp[3 * DFF] = f2bf(hh[3]);
                }
            }
        }
    }
};

#define XB_TMO      128
#define XB_XCNT(j)  (256  + 64 * (j))
#define XB_XSUB(j)  (1280 + 64 * (j))
#define XB_XGEN(j)  (2304 + 64 * (j))
#define XB_TOP      3328
#define XB_TOPGEN   3392
#define XCD_BAR_WORDS 3456
#define XB_SPIN_CAP (1u << 18)

__device__ __forceinline__ unsigned xb_ld(unsigned* p)              { return __hip_atomic_load(p, __ATOMIC_RELAXED, __HIP_MEMORY_SCOPE_AGENT); }
__device__ __forceinline__ unsigned xb_add(unsigned* p, unsigned v) { return __hip_atomic_fetch_add(p, v, __ATOMIC_RELAXED, __HIP_MEMORY_SCOPE_AGENT); }
__device__ __forceinline__ unsigned xb_xcc_id() { return (unsigned)__builtin_amdgcn_s_getreg((3 << 11) | 20) & 0xFu; }
#define XB_SPIN(cond, bar) do { unsigned _sp = 0; while (cond) { __builtin_amdgcn_s_sleep(1); \
    if ((++_sp & 255u) == 0u) { if (xb_ld(&(bar)[XB_TMO])) break; if (_sp > XB_SPIN_CAP) { atomicAdd(&(bar)[XB_TMO], 1u); break; } } } } while (0)

struct XcdBarrier {
    unsigned* bar; unsigned x;
    volatile LAS unsigned* st;
};

__device__ __forceinline__ XcdBarrier xcd_barrier_post(unsigned* bar, volatile LAS unsigned* st) {
    XcdBarrier b; b.bar = bar; b.x = xb_xcc_id(); b.st = st;
    if (threadIdx.x == 0) (void)xb_add(&bar[XB_XCNT(b.x)], 1u);
    return b;
}
__device__ __forceinline__ void xcd_barrier_complete(unsigned* bar, unsigned x, unsigned& nloc, unsigned& nx) {
    const unsigned G = gridDim.x * gridDim.y * gridDim.z;
    unsigned sum, cnt, mine, sp = 0u;
    for (;;) {
        sum = 0u; cnt = 0u; mine = 0u;
#pragma unroll
        for (unsigned j = 0; j < 16; ++j) { const unsigned c = xb_ld(&bar[XB_XCNT(j)]); sum += c; cnt += (c > 0u) ? 1u : 0u; mine = (j == x) ? c : mine; }
        if (sum == G) break;
        __builtin_amdgcn_s_sleep(1);
        if ((++sp & 255u) == 0u) { if (xb_ld(&bar[XB_TMO])) break; if (sp > XB_SPIN_CAP) { atomicAdd(&bar[XB_TMO], 1u); break; } }
    }
    nloc = mine > 0u ? mine : 1u; nx = cnt > 0u ? cnt : 1u;
}

__device__ __forceinline__ void xcd_barrier(const XcdBarrier& b) {
    asm volatile("s_waitcnt vmcnt(0)" ::: "memory");
    __syncthreads();
    if (threadIdx.x == 0) {
        unsigned* bar = b.bar;
        __builtin_amdgcn_s_waitcnt(0);
        unsigned nloc = b.st[0], nx = b.st[1];
        if (nloc == 0u) { xcd_barrier_complete(bar, b.x, nloc, nx); b.st[0] = nloc; b.st[1] = nx; }
        const unsigned old = xb_add(&bar[XB_XSUB(b.x)], 1u);
        const unsigned gen = old / nloc;
        if (old + 1u == (gen + 1u) * nloc) {
            __builtin_amdgcn_fence(__ATOMIC_RELEASE, "agent");
            asm volatile("s_waitcnt vmcnt(0)" ::: "memory");
            const unsigned og = xb_add(&bar[XB_TOP], 1u);
            const unsigned tg = og / nx;
            if (og + 1u == (tg + 1u) * nx) xb_add(&bar[XB_TOPGEN], 1u);
            else XB_SPIN(xb_ld(&bar[XB_TOPGEN]) == tg, bar);
            __builtin_amdgcn_fence(__ATOMIC_ACQUIRE, "agent");
            xb_add(&bar[XB_XGEN(b.x)], 1u);
            asm volatile("s_waitcnt vmcnt(0)" ::: "memory");
        } else {
            XB_SPIN(xb_ld(&bar[XB_XGEN(b.x)]) == gen, bar);
            __builtin_amdgcn_fence(__ATOMIC_ACQUIRE, "agent");
            asm volatile("s_waitcnt vmcnt(0)" ::: "memory");
        }
    }
    __syncthreads();
}

struct Args { const float* in[35]; float* out; unsigned char* ws; int ph_lo, ph_hi; };
struct Ctx {
    LAS unsigned char* lds; int tid, lane, wave, G, bid;
    const float* const* in; float* out; unsigned char* ws; int dry;
};
#define IN_(i) (c.in[i])
enum { I_XP = 0, I_XS, I_CSK, I_CSV, I_SSC, I_SS, I_CMK, I_CMV, I_SFC, I_MEM, I_GMIX, I_WIN, I_QG, I_KG, I_SINK, I_SCW, I_SCB, I_DTB, I_ALOG, I_DSK, I_SNG, I_WOUT, I_GCR, I_GMEM, I_WCQ, I_WCK, I_WCV, I_CQG, I_CKG, I_WCO, I_GFFN, I_WUP, I_FCW, I_FCB, I_WDN };

struct TItem { const float* W; bf16_t* WT; const float* gain; int N, ldk, ksrc0, kdst0, n0, nrow_off, dn0; };
constexpr int TT_IN = 16 * 53, TT_OUT = 24 * 16, TT_C = 16 * 4, TT_CO = 4 * 16, TT_UP = 16 * 88, TT_DN = 44 * 16;
constexpr int TT_ALL = TT_IN + TT_OUT + 3 * TT_C + TT_CO + TT_UP + TT_DN;
constexpr int TT_P4_START = TT_ALL - 1400;
DI bool p0_decode(const Ctx& c, int it, TItem& t) {
    int r = it; t.nrow_off = 0;
    if (r < TT_IN) { const int kb = r / 53, nb = r % 53; t.W = IN_(I_WIN); t.N = DIN; t.WT = (bf16_t*)(c.ws + WS_WIN); t.ldk = 2048; t.ksrc0 = kb * 128; t.kdst0 = kb * 128; t.n0 = nb * 128; t.gain = IN_(I_GMIX) + kb * 128; t.dn0 = t.nrow_off + t.n0; return true; } r -= TT_IN;
    if (r < TT_OUT) { const int kb = r / 16, nb = r % 16, ks = kb * 128; const bool ssd = ks >= 1024; t.W = IN_(I_WOUT); t.N = 2048; t.WT = (bf16_t*)(c.ws + WS_WOUT); t.ldk = 3072; t.ksrc0 = ks; t.kdst0 = ssd ? ks - 1024 : ks + 2048; t.n0 = nb * 128;
        t.gain = ssd ? IN_(I_SNG) + (ks - 1024) : nullptr; t.dn0 = t.nrow_off + t.n0; return true; } r -= TT_OUT;
    if (r < TT_C) { const int kb = r / 4, nb = r % 4; t.W = IN_(I_WCQ); t.N = 512; t.WT = (bf16_t*)(c.ws + WS_WCQ); t.ldk = 2048; t.ksrc0 = kb * 128; t.kdst0 = kb * 128; t.n0 = nb * 128; t.gain = IN_(I_GCR) + kb * 128; t.dn0 = t.nrow_off + t.n0; return true; } r -= TT_C;
    if (r < TT_C) { const int kb = r / 4, nb = r % 4; t.W = IN_(I_WCK); t.N = 512; t.WT = (bf16_t*)(c.ws + WS_WCKV); t.ldk = 2048; t.ksrc0 = kb * 128; t.kdst0 = kb * 128; t.n0 = nb * 128; t.gain = IN_(I_GMEM) + kb * 128; t.dn0 = t.nrow_off + t.n0; return true; } r -= TT_C;
    if (r < TT_C) { const int kb = r / 4, nb = r % 4; t.W = IN_(I_WCV); t.N = 512; t.WT = (bf16_t*)(c.ws + WS_WCKV); t.ldk = 2048; t.ksrc0 = kb * 128; t.kdst0 = kb * 128; t.n0 = nb * 128; t.nrow_off = 512; t.gain = IN_(I_GMEM) + kb * 128; t.dn0 = t.nrow_off + t.n0; return true; } r -= TT_C;
    if (r < TT_CO) { const int kb = r / 16, nb = r % 16; t.W = IN_(I_WCO); t.N = 2048; t.WT = (bf16_t*)(c.ws + WS_WCO); t.ldk = 512; t.ksrc0 = kb * 128; t.kdst0 = kb * 128; t.n0 = nb * 128; t.gain = nullptr; t.dn0 = t.nrow_off + t.n0; return true; } r -= TT_CO;
    if (r < TT_UP) { const int kb = r / 88, nb = r % 88; t.W = IN_(I_WUP); t.N = DFF2; t.WT = (bf16_t*)(c.ws + WS_WUP); t.ldk = 2048; t.ksrc0 = kb * 128; t.kdst0 = kb * 128; t.n0 = nb * 128; t.gain = IN_(I_GFFN) + kb * 128; { const int half = nb >= 44 ? 1 : 0; t.dn0 = 256 * (nb - 44 * half) + 128 * half; } return true; } r -= TT_UP;
    if (r < TT_DN) { const int kb = r / 16, nb = r % 16; t.W = IN_(I_WDN); t.N = 2048; t.WT = (bf16_t*)(c.ws + WS_WDN); t.ldk = DFF; t.ksrc0 = kb * 128; t.kdst0 = kb * 128; t.n0 = nb * 128; t.gain = nullptr; t.dn0 = t.nrow_off + t.n0; return true; }
    return false;
}
DI void p0_load(const TItem& t, int tid, f32x4 (&buf)[8], float (&gv)[8]) {
    const int kr = tid >> 5, n4 = (tid & 31) * 4; const bool ok = t.n0 + n4 < t.N;
    const float* p = t.W + (size_t)(t.ksrc0 + kr) * t.N + t.n0 + (ok ? n4 : 0);
#pragma unroll
    for (int i = 0; i < 8; ++i) { buf[i] = *(const f32x4*)(p + (size_t)(16 * i) * t.N); gv[i] = t.gain ? t.gain[16 * i + kr] : 1.f; if (!ok) gv[i] = 0.f; }
}
DI void p0_transposes(const Ctx& c, int it_lo, int it_hi, int vb, int nvb) {
    int tid_ = c.tid; asm volatile("" : "+v"(tid_)); const int tid = tid_;
    f32x4 buf[8]; float gv[8]; TItem cur, nxt;
    int it = it_lo + vb; bool have = (it < it_hi) && p0_decode(c, it, cur);
    if (have) p0_load(cur, tid, buf, gv);
    const int kr = tid >> 5, n4 = (tid & 31) * 4, cc = tid & 15, nr = tid >> 4; int pb = 0;
    while (have) {
        const int itn = it + nvb; const bool hn = (itn < it_hi) && p0_decode(c, itn, nxt);
        LAS float* scr = (LAS float*)(c.lds + pb * 66048);
#pragma unroll
        for (int i = 0; i < 8; ++i) { LAS float* d = scr + (16 * i + kr) * 129 + n4; const f32x4 v = buf[i] * gv[i]; d[0] = v.x; d[1] = v.y; d[2] = v.z; d[3] = v.w; }
        if (hn) p0_load(nxt, tid, buf, gv);
        __syncthreads();
#pragma unroll
        for (int j = 0; j < 4; ++j) { const int n = nr + 32 * j; const LAS float* sp = scr + (8 * cc) * 129 + n;
            u32x4 o; o.x = pk2(sp[0 * 129], sp[1 * 129]); o.y = pk2(sp[2 * 129], sp[3 * 129]); o.z = pk2(sp[4 * 129], sp[5 * 129]); o.w = pk2(sp[6 * 129], sp[7 * 129]);
            *(u32x4*)(cur.WT + (size_t)(cur.dn0 + n) * cur.ldk + cur.kdst0 + 8 * cc) = o; }
        pb ^= 1; cur = nxt; it = itn; have = hn;
    }
    __syncthreads();
}
DI void norm_row_to_bf16(const float* xrow, bf16_t* orow, int lane) {
    f32x4 v[8]; float s = 0.f;
    if (xrow) {
#pragma unroll
        for (int j = 0; j < 8; ++j) { v[j] = ((const f32x4*)xrow)[lane + 64 * j]; s += (v[j].x * v[j].x + v[j].y * v[j].y) + (v[j].z * v[j].z + v[j].w * v[j].w); }
    } else {
#pragma unroll
        for (int j = 0; j < 8; ++j) v[j] = (f32x4){0.f, 0.f, 0.f, 0.f};
    }
    const float rs = rsqrtf(wave_sum(s) * (1.f / 2048.f) + EPS);
#pragma unroll
    for (int j = 0; j < 8; ++j) { u32x2 w; w.x = pk2(v[j].x * rs, v[j].y * rs); w.y = pk2(v[j].z * rs, v[j].w * rs); ((u32x2*)orow)[lane + 64 * j] = w; }
}
DI void p0_prologue(const Ctx& c) {
    const int gw = c.bid * 8 + c.wave, NGW = c.G * 8, lane = c.lane;
    bf16_t* WINT = (bf16_t*)(c.ws + WS_WIN);
    p0_transposes(c, 0, c.G == 256 ? TT_P4_START : TT_ALL, c.bid, c.G);
    { u32x4* z = (u32x4*)(WINT + (size_t)6784 * 2048); const int n16 = (DINP - 6784) * 2048 * 2 / 16;
        for (int i = c.bid * 512 + c.tid; i < n16; i += c.G * 512) z[i] = (u32x4){0u, 0u, 0u, 0u}; }
    { float* z = (float*)(c.ws + WS_SSQ); for (int i = c.bid * 512 + c.tid; i < 3 * MPAD; i += c.G * 512) z[i] = 0.f; }
    bf16_t* A0 = (bf16_t*)(c.ws + WS_A0); bf16_t* MEMN = (bf16_t*)(c.ws + WS_MEMN);
    for (int m = gw; m < MPAD + 1024; m += NGW) {
        if (m < MPAD) { const float* xr = m < MP ? IN_(I_XP) + (size_t)m * DM : (m < MTOK ? IN_(I_XS) + (size_t)(m - MP) * DM : nullptr); norm_row_to_bf16(xr, A0 + (size_t)m * DM, lane); }
        else { const int r = m - MPAD; norm_row_to_bf16(IN_(I_MEM) + (size_t)r * DM, MEMN + (size_t)r * DM, lane); }
    }
}

constexpr int SP = 136;
DI void p1b_conv(const Ctx& c) {
    const bf16_t* PROJ = (const bf16_t*)(c.ws + WS_PROJ); bf16_t* XBC = (bf16_t*)(c.ws + WS_H);
    const float* cw = IN_(I_SCW); const float* cb = IN_(I_SCB);
    const int gw = c.bid * 8 + c.wave, NGW = c.G * 8, lane = c.lane;
    for (int task = gw; task < 512 * 6; task += NGW) {
        const int seg = task / 6, c8 = (task % 6) * 64 + lane, r0 = seg * 16, tl0 = r0 & (SEQ - 1), cch = c8 * 8;
        float w[4][8], bias[8];
#pragma unroll
        for (int i = 0; i < 4; ++i) { const f32x4 a = *(const f32x4*)(cw + (size_t)i * CONVD + cch), a2 = *(const f32x4*)(cw + (size_t)i * CONVD + cch + 4);
            w[i][0] = a.x; w[i][1] = a.y; w[i][2] = a.z; w[i][3] = a.w; w[i][4] = a2.x; w[i][5] = a2.y; w[i][6] = a2.z; w[i][7] = a2.w; }
        { const f32x4 a = *(const f32x4*)(cb + cch), a2 = *(const f32x4*)(cb + cch + 4); bias[0] = a.x; bias[1] = a.y; bias[2] = a.z; bias[3] = a.w; bias[4] = a2.x; bias[5] = a2.y; bias[6] = a2.z; bias[7] = a2.w; }
        float h1[8], h2[8], h3[8];
        if (tl0 == 0) {
#pragma unroll
            for (int j = 0; j < 8; ++j) { h1[j] = 0.f; h2[j] = 0.f; h3[j] = 0.f; }
        } else { const bf16_t* p = PROJ + (size_t)(r0 - 3) * DINP + C_XBC + cch; unpack8(*(const u32x4*)p, h1); unpack8(*(const u32x4*)(p + DINP), h2); unpack8(*(const u32x4*)(p + 2 * DINP), h3); }
#pragma unroll 1
        for (int rb = 0; rb < 16; rb += 4) { u32x4 lr_[4];
#pragma unroll
          for (int r4 = 0; r4 < 4; ++r4) lr_[r4] = *(const u32x4*)(PROJ + ((size_t)r0 + rb + r4) * DINP + C_XBC + cch);
#pragma unroll
          for (int r4 = 0; r4 < 4; ++r4) { const size_t row = (size_t)r0 + rb + r4; float cur[8], o[8]; unpack8(lr_[r4], cur);
#pragma unroll
            for (int j = 0; j < 8; ++j) { o[j] = silu_f(bias[j] + w[0][j] * h1[j] + w[1][j] * h2[j] + w[2][j] * h3[j] + w[3][j] * cur[j]); h1[j] = h2[j]; h2[j] = h3[j]; h3[j] = cur[j]; }
            u32x4 q; q.x = pk2(o[0], o[1]); q.y = pk2(o[2], o[3]); q.z = pk2(o[4], o[5]); q.w = pk2(o[6], o[7]); *(u32x4*)(XBC + row * CONVD + cch) = q; } }
    }
}
DI void ssd_prompt_unit(const Ctx& c, int unit) {
    const int b = unit >> 6, h = (unit >> 1) & 31, ph = unit & 1, g = h >> 3;
    int tid_ = c.tid; asm volatile("" : "+v"(tid_)); const int tid = tid_, lane = tid & 63, w = __builtin_amdgcn_readfirstlane(tid >> 6), fr = lane & 15, fq = lane >> 4;
    constexpr int XP = 40;
    LAS bf16_t* Cs = (LAS bf16_t*)(c.lds); LAS bf16_t* Bs = (LAS bf16_t*)(c.lds + 34816); LAS bf16_t* Xn = (LAS bf16_t*)(c.lds + 69632); LAS bf16_t* Hb = (LAS bf16_t*)(c.lds + 90112);
    LAS float* dts = (LAS float*)(c.lds + 98816); LAS float* las = (LAS float*)(c.lds + 99328); LAS float* scl = (LAS float*)(c.lds + 99840);
    const bf16_t* PROJ = (const bf16_t*)(c.ws + WS_PROJ); const bf16_t* XBC = (const bf16_t*)(c.ws + WS_H); const float* DTR = (const float*)(c.ws + WS_DT);
    bf16_t* MIX = (bf16_t*)(c.ws + WS_MIX); float* SSQS = (float*)(c.ws + WS_SSQ) + (c.dry ? 3 * MPAD : 0);
    const float av = -__expf(IN_(I_ALOG)[h]), dtb = IN_(I_DTB)[h], Dh = IN_(I_DSK)[h];
    f32x4 st[2] = {(f32x4){0.f, 0.f, 0.f, 0.f}, (f32x4){0.f, 0.f, 0.f, 0.f}};
    for (int i = tid; i < 32 * SP / 2; i += 512) ((LAS unsigned*)Hb)[i] = 0u;
    const int sx = tid >> 2, c8 = tid & 3, cb8 = tid & 15, s0 = tid >> 4;
    u32x4 xq, bq[4], cq[4]; float dtrA = 0.f, dtrB = 0.f; u32x2 zn[2], zc[2];
#define SSD_LOADS(CK) do { const size_t r0_ = (size_t)b * SEQ + (CK) * 128; xq = *(const u32x4*)(XBC + (r0_ + sx) * CONVD + h * 64 + ph * 32 + c8 * 8); \
        _Pragma("unroll") for (int i = 0; i < 4; ++i) { const bf16_t* p_ = XBC + (r0_ + s0 + 32 * i) * CONVD + 2048 + g * 128 + cb8 * 8; bq[i] = *(const u32x4*)p_; cq[i] = *(const u32x4*)(p_ + 512); } \
        if (w < 2) { dtrA = DTR[(r0_ + lane) * 32 + h]; dtrB = DTR[(r0_ + 64 + lane) * 32 + h]; } \
        _Pragma("unroll") for (int np = 0; np < 2; ++np) zn[np] = *(const u32x2*)(PROJ + (r0_ + 16 * w + fr) * DINP + C_Z + h * 64 + ph * 32 + 16 * np + 4 * fq); } while (0)
    SSD_LOADS(0);
    for (int ck = 0; ck < 16; ++ck) {
        const size_t row0 = (size_t)b * SEQ + ck * 128;
        {
            if (w < 2) {
                const float dA = softplus_f(dtrA + dtb), dB = softplus_f(dtrB + dtb);
                float sA = dA, sB = dB;
#pragma unroll
                for (int o = 1; o < 64; o <<= 1) { const float tA = __shfl_up(sA, o), tB = __shfl_up(sB, o); if (lane >= o) { sA += tA; sB += tB; } }
                const float totA = __shfl(sA, 63), tot = totA + __shfl(sB, 63);
                if (w == 0) { dts[lane] = dA; las[lane] = av * sA; scl[lane] = dA * __expf(av * (tot - sA)); }
                else { dts[64 + lane] = dB; las[64 + lane] = av * (totA + sB); scl[64 + lane] = dB * __expf(av * (tot - totA - sB)); }
            }
            *(LAS u32x4*)(Xn + sx * XP + c8 * 8) = xq;
#pragma unroll
            for (int i = 0; i < 4; ++i) { *(LAS u32x4*)(Bs + (s0 + 32 * i) * SP + cb8 * 8) = bq[i]; *(LAS u32x4*)(Cs + (s0 + 32 * i) * SP + cb8 * 8) = cq[i]; }
        }
        zc[0] = zn[0]; zc[1] = zn[1];
        __syncthreads();
        if (ck + 1 < 16) SSD_LOADS(ck + 1);
        asm volatile("" ::: "memory");
        const int l = 16 * w + fr; const float la_l = las[l];
        f32x4 cbm[8];
#pragma unroll
        for (int ni = 0; ni < 8; ++ni) cbm[ni] = (f32x4){0.f, 0.f, 0.f, 0.f};
#pragma unroll
        for (int kk = 0; kk < 4; ++kk) { __builtin_amdgcn_sched_barrier(0); const bf16x8 af = *(const LAS bf16x8*)(Cs + l * SP + kk * 32 + fq * 8);
#pragma unroll
            for (int ni = 0; ni < 8; ++ni) { const bf16x8 bf = *(const LAS bf16x8*)(Bs + (16 * ni + fr) * SP + kk * 32 + fq * 8); cbm[ni] = MFMA16(bf, af, cbm[ni]); } }
        int lim = l - 4 * fq; asm volatile("" : "+v"(lim));
#pragma unroll
        for (int ni = 0; ni < 8; ++ni) { const int s = 16 * ni + 4 * fq; const f32x4 ls = *(const LAS f32x4*)(las + s), ds = *(const LAS f32x4*)(dts + s);
#pragma unroll
            for (int j = 0; j < 4; ++j) cbm[ni][j] = (16 * ni + j <= lim) ? cbm[ni][j] * __expf(la_l - ls[j]) * ds[j] : 0.f; }
        f32x4 y[2] = {(f32x4){0.f, 0.f, 0.f, 0.f}, (f32x4){0.f, 0.f, 0.f, 0.f}}, yi[2] = {(f32x4){0.f, 0.f, 0.f, 0.f}, (f32x4){0.f, 0.f, 0.f, 0.f}};
#pragma unroll
        for (int k2 = 0; k2 < 4; ++k2) { __builtin_amdgcn_sched_barrier(0); u32x4 pa; pa.x = pk2(cbm[2 * k2][0], cbm[2 * k2][1]); pa.y = pk2(cbm[2 * k2][2], cbm[2 * k2][3]); pa.z = pk2(cbm[2 * k2 + 1][0], cbm[2 * k2 + 1][1]); pa.w = pk2(cbm[2 * k2 + 1][2], cbm[2 * k2 + 1][3]);
            const bf16x8 af = __builtin_bit_cast(bf16x8, pa);
#pragma unroll
            for (int np = 0; np < 2; ++np) { const LAS bf16_t* xp = Xn + (32 * k2 + 4 * fq + (fr >> 2)) * XP + 16 * np + 4 * (fr & 3);
                y[np] = MFMA16(cat8(vtr(xp), vtr(xp + 16 * XP)), af, y[np]); } }
#pragma unroll
        for (int kk = 0; kk < 4; ++kk) { const bf16x8 af = *(const LAS bf16x8*)(Cs + l * SP + kk * 32 + fq * 8);
#pragma unroll
            for (int np = 0; np < 2; ++np) { const bf16x8 bf = *(const LAS bf16x8*)(Hb + (16 * np + fr) * SP + kk * 32 + fq * 8); yi[np] = MFMA16(bf, af, yi[np]); } }
        {
            const float el = __expf(la_l); const size_t row = row0 + l; float sq = 0.f;
#pragma unroll
            for (int np = 0; np < 2; ++np) { const int p0 = 16 * np + 4 * fq; const u32x2 zr = zc[np];
                const u32x2 xr = *(const LAS u32x2*)(Xn + l * XP + p0);
                const float zf[4] = {bflo(zr.x), bfhi(zr.x), bflo(zr.y), bfhi(zr.y)}, xf[4] = {bflo(xr.x), bfhi(xr.x), bflo(xr.y), bfhi(xr.y)}; float o[4];
#pragma unroll
                for (int j = 0; j < 4; ++j) { float v = y[np][j] + el * yi[np][j] + Dh * xf[j]; v *= silu_f(zf[j]); o[j] = v; sq += v * v; }
                u32x2 wv; wv.x = pk2(o[0], o[1]); wv.y = pk2(o[2], o[3]); *(u32x2*)(MIX + row * DMIX + h * 64 + ph * 32 + p0) = wv; }
            sq += __shfl_xor(sq, 16); sq += __shfl_xor(sq, 32); if (fq == 0) atomicAdd(SSQS + row, sq);
        }
        {
            f32x4 sa[2] = {(f32x4){0.f, 0.f, 0.f, 0.f}, (f32x4){0.f, 0.f, 0.f, 0.f}};
#pragma unroll
            for (int kk = 0; kk < 4; ++kk) { __builtin_amdgcn_sched_barrier(0); const int sb = 32 * kk + 8 * fq;
                const LAS bf16_t* bp = Bs + (sb + (fr >> 2)) * SP + 16 * w + 4 * (fr & 3); const bf16x8 bf = cat8(vtr(bp), vtr(bp + 4 * SP));
                const f32x4 s0 = *(const LAS f32x4*)(scl + sb), s1 = *(const LAS f32x4*)(scl + sb + 4);
#pragma unroll
                for (int mi = 0; mi < 2; ++mi) { const LAS bf16_t* xp = Xn + (sb + (fr >> 2)) * XP + 16 * mi + 4 * (fr & 3); const s16x4 x0 = vtr(xp), x1 = vtr(xp + 4 * XP);
                    const u32x2 a0 = __builtin_bit_cast(u32x2, x0), a1 = __builtin_bit_cast(u32x2, x1); u32x4 q;
                    q.x = pk2(bflo(a0.x) * s0[0], bfhi(a0.x) * s0[1]); q.y = pk2(bflo(a0.y) * s0[2], bfhi(a0.y) * s0[3]); q.z = pk2(bflo(a1.x) * s1[0], bfhi(a1.x) * s1[1]); q.w = pk2(bflo(a1.y) * s1[2], bfhi(a1.y) * s1[3]);
                    sa[mi] = MFMA16(bf, __builtin_bit_cast(bf16x8, q), sa[mi]); } }
            const float ee = __expf(las[127]);
#pragma unroll
            for (int mi = 0; mi < 2; ++mi) st[mi] = st[mi] * ee + sa[mi];
        }
        __syncthreads();
#pragma unroll
        for (int mi = 0; mi < 2; ++mi) { u32x2 wv; wv.x = pk2(st[mi][0], st[mi][1]); wv.y = pk2(st[mi][2], st[mi][3]); *(LAS u32x2*)(Hb + (16 * mi + fr) * SP + 16 * w + 4 * fq) = wv; }
    }
    float* so = c.out + O_SSP;
#pragma unroll
    for (int mi = 0; mi < 2; ++mi) *(f32x4*)(so + ((size_t)(b * 32 + h) * 64 + ph * 32 + 16 * mi + fr) * 128 + 16 * w + 4 * fq) = st[mi];
    __syncthreads();
}

DI void swa_prompt_unit(const Ctx& c, int unit) {
    const int b = unit >> 6, blk = (unit >> 2) & 15, kvh = unit & 3;
    int tid_ = c.tid; asm volatile("" : "+v"(tid_)); const int tid = tid_, lane = tid & 63, w = __builtin_amdgcn_readfirstlane(tid >> 6), fr = lane & 15, fq = lane >> 4;
    constexpr int KP = 72, VP = 72;
    LAS bf16_t* Ks = (LAS bf16_t*)(c.lds); LAS bf16_t* Vn = (LAS bf16_t*)(c.lds + 36864);
    const bf16_t* PROJ = (const bf16_t*)(c.ws + WS_PROJ); bf16_t* MIX = (bf16_t*)(c.ws + WS_MIX);
    u32x4 qraw[4][2];
#pragma unroll
    for (int it = 0; it < 4; ++it) { const int combo = w * 2 + (it >> 1), mi = it & 1, gq = combo & 3, rg = combo >> 2; const size_t row = (size_t)b * SEQ + blk * 128 + 32 * rg + 16 * mi + fr;
#pragma unroll
        for (int kk = 0; kk < 2; ++kk) qraw[it][kk] = *(const u32x4*)(PROJ + row * DINP + C_Q + (kvh * 4 + gq) * 64 + kk * 32 + fq * 8); }
    {
        const int key = tid >> 1, half = tid & 1, tk = blk * 128 - 128 + key;
        const bf16_t* pr = PROJ + ((size_t)b * SEQ + (tk >= 0 ? tk : 0)) * DINP;
        const bool wout = (blk == 15 && key >= 128);
        unsigned ooff = (unsigned)(((b * 128 + (key & 127)) * 4 + kvh) * 64 + half * 32); asm volatile("" : "+v"(ooff));
        {
            float kf[32]; float sq = 0.f;
#pragma unroll
            for (int i = 0; i < 4; ++i) unpack8(*(const u32x4*)(pr + C_K + kvh * 64 + half * 32 + i * 8), kf + 8 * i);
#pragma unroll
            for (int i = 0; i < 32; ++i) sq += kf[i] * kf[i];
            sq += __shfl_xor(sq, 1); const float rs = (tk >= 0) ? rsqrtf(sq * (1.f / 64.f) + EPS) : 0.f; const float* kg = IN_(I_KG) + half * 32;
#pragma unroll
            for (int i = 0; i < 4; ++i) { const f32x4 g0 = *(const f32x4*)(kg + 8 * i), g1 = *(const f32x4*)(kg + 8 * i + 4);
                const f32x4 k0 = (f32x4){kf[8 * i], kf[8 * i + 1], kf[8 * i + 2], kf[8 * i + 3]} * g0 * rs, k1 = (f32x4){kf[8 * i + 4], kf[8 * i + 5], kf[8 * i + 6], kf[8 * i + 7]} * g1 * rs;
                u32x4 q; q.x = pk2(k0[0], k0[1]); q.y = pk2(k0[2], k0[3]); q.z = pk2(k1[0], k1[1]); q.w = pk2(k1[2], k1[3]);
                *(LAS u32x4*)(Ks + key * KP + half * 32 + i * 8) = q;
                if (wout) { float* ok = c.out + O_SKP + ooff; *(f32x4*)(ok + 8 * i) = k0; *(f32x4*)(ok + 8 * i + 4) = k1; } }
        }
        asm volatile("" ::: "memory");
        {
            float vf[32];
#pragma unroll
            for (int i = 0; i < 4; ++i) unpack8(*(const u32x4*)(pr + C_V + kvh * 64 + half * 32 + i * 8), vf + 8 * i);
            if (tk < 0) {
#pragma unroll
                for (int i = 0; i < 32; ++i) vf[i] = 0.f;
            }
#pragma unroll
            for (int i = 0; i < 4; ++i) { u32x4 q; q.x = pk2(vf[8 * i], vf[8 * i + 1]); q.y = pk2(vf[8 * i + 2], vf[8 * i + 3]); q.z = pk2(vf[8 * i + 4], vf[8 * i + 5]); q.w = pk2(vf[8 * i + 6], vf[8 * i + 7]);
                *(LAS u32x4*)(Vn + key * VP + half * 32 + i * 8) = q; }
            if (wout) { float* ov = c.out + O_SVP + ooff;
#pragma unroll
                for (int i = 0; i < 8; ++i) *(f32x4*)(ov + 4 * i) = (f32x4){vf[4 * i], vf[4 * i + 1], vf[4 * i + 2], vf[4 * i + 3]}; }
        }
    }
    __syncthreads();
#pragma unroll
    for (int it = 0; it < 4; ++it) {
        asm volatile("" ::: "memory");
        const int combo = w * 2 + (it >> 1), mi = it & 1, gq = combo & 3, rg = combo >> 2, head = kvh * 4 + gq; const float sink = IN_(I_SINK)[head];
        const int r = 16 * mi + fr; const size_t row = (size_t)b * SEQ + blk * 128 + 32 * rg + r;
        bf16x8 qf[2];
        { float f[16]; float sq = 0.f;
#pragma unroll
            for (int kk = 0; kk < 2; ++kk) unpack8(qraw[it][kk], f + 8 * kk);
#pragma unroll
            for (int i = 0; i < 16; ++i) sq += f[i] * f[i];
            sq += __shfl_xor(sq, 16); sq += __shfl_xor(sq, 32); const float rs = rsqrtf(sq * (1.f / 64.f) + EPS) * 0.125f;
#pragma unroll
            for (int kk = 0; kk < 2; ++kk) { const float* qg = IN_(I_QG) + kk * 32 + fq * 8; u32x4 q; q.x = pk2(f[8 * kk] * rs * qg[0], f[8 * kk + 1] * rs * qg[1]); q.y = pk2(f[8 * kk + 2] * rs * qg[2], f[8 * kk + 3] * rs * qg[3]);
                q.z = pk2(f[8 * kk + 4] * rs * qg[4], f[8 * kk + 5] * rs * qg[5]); q.w = pk2(f[8 * kk + 6] * rs * qg[6], f[8 * kk + 7] * rs * qg[7]); qf[kk] = __builtin_bit_cast(bf16x8, q); } }
        f32x4 S[10];
#pragma unroll
        for (int ni = 0; ni < 10; ++ni) S[ni] = (f32x4){0.f, 0.f, 0.f, 0.f};
#pragma unroll
        for (int ni = 0; ni < 10; ++ni)
#pragma unroll
            for (int kk = 0; kk < 2; ++kk) { __builtin_amdgcn_sched_barrier(0); const bf16x8 bf = *(const LAS bf16x8*)(Ks + (32 * rg + 16 * ni + fr) * KP + kk * 32 + fq * 8); S[ni] = MFMA16(bf, qf[kk], S[ni]); }
        float mx = sink;
        const int lowlim = blk > 0 ? -100000 : 128 - 32 * rg; const int lo_ = r > lowlim ? r : lowlim;
        int xoff = 4 * fq - lo_; const unsigned hi_ = (unsigned)(r + 128 - lo_); asm volatile("" : "+v"(xoff));
#pragma unroll
        for (int ni = 0; ni < 10; ++ni)
#pragma unroll
            for (int j = 0; j < 4; ++j) { const bool ok = (unsigned)(xoff + (16 * ni + j)) <= hi_;
                S[ni][j] = ok ? S[ni][j] : -1e30f; mx = fmaxf(mx, S[ni][j]); }
        mx = fmaxf(mx, __shfl_xor(mx, 16)); mx = fmaxf(mx, __shfl_xor(mx, 32));
        float sm = 0.f;
#pragma unroll
        for (int ni = 0; ni < 10; ++ni)
#pragma unroll
            for (int j = 0; j < 4; ++j) { const float p = __expf(S[ni][j] - mx); S[ni][j] = p; sm += p; }
        sm += __shfl_xor(sm, 16); sm += __shfl_xor(sm, 32); sm += __expf(sink - mx);
        const float inv = 1.f / sm;
        f32x4 O[4];
#pragma unroll
        for (int nd = 0; nd < 4; ++nd) O[nd] = (f32x4){0.f, 0.f, 0.f, 0.f};
#pragma unroll
        for (int k2 = 0; k2 < 5; ++k2) { __builtin_amdgcn_sched_barrier(0); u32x4 pa; pa.x = pk2(S[2 * k2][0], S[2 * k2][1]); pa.y = pk2(S[2 * k2][2], S[2 * k2][3]); pa.z = pk2(S[2 * k2 + 1][0], S[2 * k2 + 1][1]); pa.w = pk2(S[2 * k2 + 1][2], S[2 * k2 + 1][3]);
            const bf16x8 af = __builtin_bit_cast(bf16x8, pa);
#pragma unroll
            for (int nd = 0; nd < 4; ++nd) { const LAS bf16_t* vp = Vn + (32 * rg + 32 * k2 + 4 * fq + (fr >> 2)) * VP + 16 * nd + 4 * (fr & 3);
                O[nd] = MFMA16(cat8(vtr(vp), vtr(vp + 16 * VP)), af, O[nd]); } }
#pragma unroll
        for (int nd = 0; nd < 4; ++nd) { const f32x4 o = O[nd] * inv; u32x2 wv; wv.x = pk2(o[0], o[1]); wv.y = pk2(o[2], o[3]); *(u32x2*)(MIX + row * DMIX + 2048 + head * 64 + 16 * nd + 4 * fq) = wv; }
    }
    __syncthreads();
}

DI void swa_sample_pair(const Ctx& c, int P) {
    int tid_ = c.tid; asm volatile("" : "+v"(tid_)); const int tid = tid_, lane = tid & 63, w = __builtin_amdgcn_readfirstlane(tid >> 6);
    const int combo = 2 * P + (w >> 2), q4 = w & 3, b = combo >> 2, kvh = combo & 3;
    LAS float* qs = (LAS float*)(c.lds + w * 4096); LAS float* ps = qs + 256; LAS float* po = qs + 384; LAS float* pm = qs + 640; LAS float* psm = qs + 644;
    const bf16_t* pr = (const bf16_t*)(c.ws + WS_PROJ) + (size_t)(MP + b) * DINP; bf16_t* MIX = (bf16_t*)(c.ws + WS_MIX);
    const float* ck = IN_(I_CSK); const float* cv = IN_(I_CSV); float* ok = c.out + O_SKS; float* ov = c.out + O_SVS;
#pragma unroll
    for (int g = 0; g < 4; ++g) { const float qr = bf1(pr[C_Q + (kvh * 4 + g) * 64 + lane]); const float s2 = wave_sum(qr * qr); qs[g * 64 + lane] = qr * rsqrtf(s2 * (1.f / 64.f) + EPS) * IN_(I_QG)[lane] * 0.125f; }
    LDS_FENCE();
    const int s = 32 * q4 + (lane & 31), half = lane >> 5;
    float lg[4];
    {
        const float* kr = ck + ((size_t)(b * 128 + s) * 4 + kvh) * 64 + half * 32; f32x4 kv[8];
#pragma unroll
        for (int i = 0; i < 8; ++i) kv[i] = *(const f32x4*)(kr + 4 * i);
        if (s >= 1) { float* kw = ok + ((size_t)(b * 128 + s - 1) * 4 + kvh) * 64 + half * 32;
#pragma unroll
            for (int i = 0; i < 8; ++i) *(f32x4*)(kw + 4 * i) = kv[i]; }
#pragma unroll
        for (int g = 0; g < 4; ++g) { float a = 0.f;
#pragma unroll
            for (int i = 0; i < 8; ++i) { const f32x4 qv = *(const LAS f32x4*)(qs + g * 64 + half * 32 + 4 * i); a += (kv[i].x * qv.x + kv[i].y * qv.y) + (kv[i].z * qv.z + kv[i].w * qv.w); }
            a += __shfl_xor(a, 32); lg[g] = a; }
    }
#pragma unroll
    for (int g = 0; g < 4; ++g) { const float mx = wave_max(lg[g]); const float p = __expf(lg[g] - mx); const float sm = wave_sum(lane < 32 ? p : 0.f);
        if (lane < 32) ps[g * 32 + lane] = p; if (lane == 0) { pm[g] = mx; psm[g] = sm; } }
    LDS_FENCE();
    {
        float o[4] = {0.f, 0.f, 0.f, 0.f};
#pragma unroll 1
        for (int i0 = 0; i0 < 32; i0 += 8) { float v[8];
#pragma unroll
            for (int i = 0; i < 8; ++i) v[i] = cv[((size_t)(b * 128 + 32 * q4 + i0 + i) * 4 + kvh) * 64 + lane];
#pragma unroll
            for (int i = 0; i < 8; ++i) { const int sk = 32 * q4 + i0 + i; if (sk >= 1) ov[((size_t)(b * 128 + sk - 1) * 4 + kvh) * 64 + lane] = v[i];
#pragma unroll
                for (int g = 0; g < 4; ++g) o[g] += ps[g * 32 + i0 + i] * v[i]; } }
#pragma unroll
        for (int g = 0; g < 4; ++g) po[g * 64 + lane] = o[g];
    }
    __syncthreads();
    if (q4 == 0) {
        const float kraw = bf1(pr[C_K + kvh * 64 + lane]); const float ss = wave_sum(kraw * kraw); const float knew = kraw * rsqrtf(ss * (1.f / 64.f) + EPS) * IN_(I_KG)[lane];
        const float vnew = bf1(pr[C_V + kvh * 64 + lane]);
        ok[((size_t)(b * 128 + 127) * 4 + kvh) * 64 + lane] = knew; ov[((size_t)(b * 128 + 127) * 4 + kvh) * 64 + lane] = vnew;
#pragma unroll
        for (int g = 0; g < 4; ++g) { const float lnew = wave_sum(qs[g * 64 + lane] * knew), sink = IN_(I_SINK)[kvh * 4 + g];
            float m[4], sm[4]; float M = fmaxf(lnew, sink);
#pragma unroll
            for (int j = 0; j < 4; ++j) { const LAS float* qj = qs + j * 1024; m[j] = qj[640 + g]; sm[j] = qj[644 + g]; M = fmaxf(M, m[j]); }
            float S = __expf(lnew - M) + __expf(sink - M), o = __expf(lnew - M) * vnew;
#pragma unroll
            for (int j = 0; j < 4; ++j) { const float e = __expf(m[j] - M); S += sm[j] * e; o += (qs + j * 1024)[384 + g * 64 + lane] * e; }
            MIX[(size_t)(MP + b) * DMIX + 2048 + (kvh * 4 + g) * 64 + lane] = f2bf(o / S); }
    }
    __syncthreads();
}

DI void ssd_sample_wave(const Ctx& c, int wu) {
    int lane_ = c.lane; asm volatile("" : "+v"(lane_)); const int b = wu >> 5, h = wu & 31, g = h >> 3, lane = lane_;
    LAS float* xs = (LAS float*)(c.lds + c.wave * 4096); LAS float* Bsm = xs + 64; LAS float* Csm = xs + 192;
    const bf16_t* pr = (const bf16_t*)(c.ws + WS_PROJ) + (size_t)(MP + b) * DINP; bf16_t* MIX = (bf16_t*)(c.ws + WS_MIX);
    const float* cw = IN_(I_SCW); const float* cb = IN_(I_SCB); const float* scs = IN_(I_SSC) + (size_t)b * 3 * CONVD;
#pragma unroll
    for (int q = 0; q < 5; ++q) { const int cch = q == 0 ? h * 64 + lane : (q < 3 ? 2048 + g * 128 + (q - 1) * 64 + lane : 2560 + g * 128 + (q - 3) * 64 + lane);
        float v = cb[cch] + cw[cch] * scs[cch] + cw[CONVD + cch] * scs[CONVD + cch] + cw[2 * CONVD + cch] * scs[2 * CONVD + cch] + cw[3 * CONVD + cch] * bf1(pr[C_XBC + cch]);
        v = silu_f(v); if (q == 0) xs[lane] = v; else if (q < 3) Bsm[(q - 1) * 64 + lane] = v; else Csm[(q - 3) * 64 + lane] = v; }
    LDS_FENCE();
    const float dt = softplus_f(((const float*)(c.ws + WS_DT))[(size_t)(MP + b) * 32 + h] + IN_(I_DTB)[h]); const float dA = __expf(-dt * __expf(IN_(I_ALOG)[h])), Dh = IN_(I_DSK)[h];
    const int n4 = (lane & 31) * 4, psub = lane >> 5;
    const f32x4 Bv = *(const LAS f32x4*)(Bsm + n4), Cv = *(const LAS f32x4*)(Csm + n4);
    const float* hs = IN_(I_SS) + (size_t)(b * 32 + h) * 64 * 128; float* ho = c.out + O_SSS + (size_t)(b * 32 + h) * 64 * 128;
    float sq = 0.f;
#pragma unroll 1
    for (int it0 = 0; it0 < 32; it0 += 16) { f32x4 hv[16];
#pragma unroll
        for (int i = 0; i < 16; ++i) hv[i] = *(const f32x4*)(hs + (2 * (it0 + i) + psub) * 128 + n4);
#pragma unroll
        for (int i = 0; i < 16; ++i) { const int p = 2 * (it0 + i) + psub; const float xv = xs[p], xb = dt * xv;
            const f32x4 hn = hv[i] * dA + Bv * xb; *(f32x4*)(ho + p * 128 + n4) = hn;
            float part = (hn.x * Cv.x + hn.y * Cv.y) + (hn.z * Cv.z + hn.w * Cv.w);
#pragma unroll
            for (int o = 1; o < 32; o <<= 1) part += __shfl_xor(part, o);
            if ((lane & 31) == 0) { float yv = part + Dh * xv; yv *= silu_f(bf1(pr[C_Z + h * 64 + p])); sq += yv * yv; MIX[(size_t)(MP + b) * DMIX + h * 64 + p] = f2bf(yv); } } }
    sq = wave_sum(sq); if (lane == 0) atomicAdd((float*)(c.ws + WS_SSQ) + (c.dry ? 3 * MPAD : 0) + MP + b, sq);
    LDS_FENCE();
}

DI void p2_mixers(const Ctx& c) {
#ifndef P2SEL
#define P2SEL 15
#endif
#ifndef DRYSEL
#define DRYSEL 15
#endif
    const int sel_ = c.dry ? (DRYSEL) : (P2SEL);
    if (sel_ & 1) for (int u = c.bid; u < 256; u += c.G) ssd_prompt_unit(c, u);
    if (sel_ & 2) for (int u = c.bid; u < 256; u += c.G) swa_prompt_unit(c, u);
    const int gw = c.bid * 8 + c.wave, NGW = c.G * 8, lane = c.lane;
    if (sel_ & 4) for (int u = gw; u < 4096; u += NGW) ssd_sample_wave(c, u);
    if (sel_ & 8) for (int u = c.bid; u < 256; u += c.G) swa_sample_pair(c, u);
    if (!c.dry) for (int u = gw; u < 4096; u += NGW) { float* p = c.out + O_MKP + (size_t)u * 128; f32x2 v = ((f32x2*)p)[lane]; const float rs = rsqrtf(wave_sum(v.x * v.x + v.y * v.y) * (1.f / 128.f) + EPS);
        const f32x2 gg = ((const f32x2*)IN_(I_CKG))[lane]; v.x *= rs * gg.x; v.y *= rs * gg.y; ((f32x2*)p)[lane] = v; }
    const bf16_t* PROJ = (const bf16_t*)(c.ws + WS_PROJ);
    for (int i = c.bid * 512 + c.tid; i < NB * 3 * CONVD; i += c.G * 512) { const int b = i / (3 * CONVD), j = (i / CONVD) % 3, ch = i % CONVD; c.out[O_SCP + i] = bf1(PROJ[((size_t)b * SEQ + 2045 + j) * DINP + C_XBC + ch]); }
    for (int i = c.bid * 512 + c.tid; i < MS * 3 * CONVD; i += c.G * 512) { const int b = i / (3 * CONVD), j = (i / CONVD) % 3, ch = i % CONVD;
        c.out[O_SCS + i] = j < 2 ? IN_(I_SSC)[((size_t)b * 3 + j + 1) * CONVD + ch] : bf1(PROJ[(size_t)(MP + b) * DINP + C_XBC + ch]); }
}

DI void xattn_prompt_unit(const Ctx& c, int unit) {
    const int b = unit >> 6, head = (unit >> 4) & 3, qb = unit & 15;
    int tid_ = c.tid; asm volatile("" : "+v"(tid_)); const int tid = tid_, lane = tid & 63, w = __builtin_amdgcn_readfirstlane(tid >> 6), fr = lane & 15, fq = lane >> 4;
    constexpr int KP = 136, VP = 136;
    LAS bf16_t* Ks = (LAS bf16_t*)(c.lds); LAS bf16_t* Vn = (LAS bf16_t*)(c.lds + 69632);
    {
        const int key = tid >> 1, half = tid & 1; const float* kp = c.out + O_MKP + ((size_t)(b * 256 + key) * 4 + head) * 128 + half * 64; const float* vp = c.out + O_MVP + ((size_t)(b * 256 + key) * 4 + head) * 128 + half * 64;
#pragma unroll
        for (int i = 0; i < 8; ++i) { const f32x4 a = *(const f32x4*)(kp + 8 * i), bb = *(const f32x4*)(kp + 8 * i + 4); u32x4 q; q.x = pk2(a.x, a.y); q.y = pk2(a.z, a.w); q.z = pk2(bb.x, bb.y); q.w = pk2(bb.z, bb.w);
            *(LAS u32x4*)(Ks + key * KP + half * 64 + 8 * i) = q; }
#pragma unroll
        for (int i = 0; i < 8; ++i) { const f32x4 a = *(const f32x4*)(vp + 8 * i), bb = *(const f32x4*)(vp + 8 * i + 4); u32x4 q; q.x = pk2(a.x, a.y); q.y = pk2(a.z, a.w); q.z = pk2(bb.x, bb.y); q.w = pk2(bb.z, bb.w);
            *(LAS u32x4*)(Vn + key * VP + half * 64 + 8 * i) = q; }
    }
    __syncthreads();
    const bf16_t* QC = (const bf16_t*)(c.ws + WS_QC); bf16_t* OC = (bf16_t*)(c.ws + WS_OC);
    const size_t row = (size_t)b * SEQ + qb * 128 + 16 * w + fr;
    bf16x8 qf[4];
    { float f[32]; float sq = 0.f;
#pragma unroll
        for (int kk = 0; kk < 4; ++kk) unpack8(*(const u32x4*)(QC + row * DXA + head * 128 + kk * 32 + fq * 8), f + 8 * kk);
#pragma unroll
        for (int i = 0; i < 32; ++i) sq += f[i] * f[i];
        sq += __shfl_xor(sq, 16); sq += __shfl_xor(sq, 32); const float rs = rsqrtf(sq * (1.f / 128.f) + EPS) * 0.08838834764831845f;
#pragma unroll
        for (int kk = 0; kk < 4; ++kk) { const float* qg = IN_(I_CQG) + kk * 32 + fq * 8; u32x4 q; q.x = pk2(f[8 * kk] * rs * qg[0], f[8 * kk + 1] * rs * qg[1]); q.y = pk2(f[8 * kk + 2] * rs * qg[2], f[8 * kk + 3] * rs * qg[3]);
            q.z = pk2(f[8 * kk + 4] * rs * qg[4], f[8 * kk + 5] * rs * qg[5]); q.w = pk2(f[8 * kk + 6] * rs * qg[6], f[8 * kk + 7] * rs * qg[7]); qf[kk] = __builtin_bit_cast(bf16x8, q); } }
    f32x4 S[16];
#pragma unroll
    for (int ni = 0; ni < 16; ++ni) S[ni] = (f32x4){0.f, 0.f, 0.f, 0.f};
#pragma unroll
    for (int ni = 0; ni < 16; ++ni)
#pragma unroll
        for (int kk = 0; kk < 4; ++kk) { __builtin_amdgcn_sched_barrier(0); const bf16x8 bf = *(const LAS bf16x8*)(Ks + (16 * ni + fr) * KP + kk * 32 + fq * 8); S[ni] = MFMA16(bf, qf[kk], S[ni]); }
    float mx = -1e30f;
#pragma unroll
    for (int ni = 0; ni < 16; ++ni)
#pragma unroll
        for (int j = 0; j < 4; ++j) mx = fmaxf(mx, S[ni][j]);
    mx = fmaxf(mx, __shfl_xor(mx, 16)); mx = fmaxf(mx, __shfl_xor(mx, 32));
    float sm = 0.f;
#pragma unroll
    for (int ni = 0; ni < 16; ++ni)
#pragma unroll
        for (int j = 0; j < 4; ++j) { const float p = __expf(S[ni][j] - mx); S[ni][j] = p; sm += p; }
    sm += __shfl_xor(sm, 16); sm += __shfl_xor(sm, 32); const float inv = 1.f / sm;
    f32x4 O[8];
#pragma unroll
    for (int nd = 0; nd < 8; ++nd) O[nd] = (f32x4){0.f, 0.f, 0.f, 0.f};
#pragma unroll
    for (int k2 = 0; k2 < 8; ++k2) { __builtin_amdgcn_sched_barrier(0); u32x4 pa; pa.x = pk2(S[2 * k2][0], S[2 * k2][1]); pa.y = pk2(S[2 * k2][2], S[2 * k2][3]); pa.z = pk2(S[2 * k2 + 1][0], S[2 * k2 + 1][1]); pa.w = pk2(S[2 * k2 + 1][2], S[2 * k2 + 1][3]);
        const bf16x8 af = __builtin_bit_cast(bf16x8, pa);
#pragma unroll
        for (int nd = 0; nd < 8; ++nd) { const LAS bf16_t* vp = Vn + (32 * k2 + 4 * fq + (fr >> 2)) * VP + 16 * nd + 4 * (fr & 3);
            O[nd] = MFMA16(cat8(vtr(vp), vtr(vp + 16 * VP)), af, O[nd]); } }
#pragma unroll
    for (int nd = 0; nd < 8; ++nd) { const f32x4 o = O[nd] * inv; u32x2 wv; wv.x = pk2(o[0], o[1]); wv.y = pk2(o[2], o[3]); *(u32x2*)(OC + row * DXA + head * 128 + 16 * nd + 4 * fq) = wv; }
    __syncthreads();
}
DI void xattn_sample_pair(const Ctx& c, int P) {
    int tid_ = c.tid; asm volatile("" : "+v"(tid_)); const int tid = tid_, lane = tid & 63, w = __builtin_amdgcn_readfirstlane(tid >> 6);
    const int combo = 2 * P + (w >> 2), q4 = w & 3, b = combo >> 2, head = combo & 3;
    LAS float* qs = (LAS float*)(c.lds + w * 4096); LAS float* ps = qs + 128; LAS float* po = qs + 192; LAS float* pm = qs + 320;
    const bf16_t* QC = (const bf16_t*)(c.ws + WS_QC); bf16_t* OC = (bf16_t*)(c.ws + WS_OC);
    const unsigned qw = *(const unsigned*)(QC + (size_t)(MP + b) * DXA + head * 128 + 2 * lane); const float q0 = bflo(qw), q1 = bfhi(qw);
    const float rs = rsqrtf(wave_sum(q0 * q0 + q1 * q1) * (1.f / 128.f) + EPS) * 0.08838834764831845f; const f32x2 gg = ((const f32x2*)IN_(I_CQG))[lane];
    qs[2 * lane] = q0 * rs * gg.x; qs[2 * lane + 1] = q1 * rs * gg.y;
    LDS_FENCE();
    const int m0 = 64 * q4;
    float lg;
    { const float* kr = IN_(I_CMK) + ((size_t)(b * 256 + m0 + lane) * 4 + head) * 128; float a = 0.f;
#pragma unroll 1
        for (int d0 = 0; d0 < 32; d0 += 8) { f32x4 kv[8];
#pragma unroll
            for (int i = 0; i < 8; ++i) kv[i] = *(const f32x4*)(kr + 4 * (d0 + i));
#pragma unroll
            for (int i = 0; i < 8; ++i) { const f32x4 qv = *(const LAS f32x4*)(qs + 4 * (d0 + i)); a += (kv[i].x * qv.x + kv[i].y * qv.y) + (kv[i].z * qv.z + kv[i].w * qv.w); } }
        lg = a; }
    const float mx = wave_max(lg); const float p = __expf(lg - mx); const float sm = wave_sum(p);
    ps[lane] = p; if (lane == 0) { pm[0] = mx; pm[1] = sm; }
    LDS_FENCE();
    { float o0 = 0.f, o1 = 0.f; const float* vr = IN_(I_CMV) + ((size_t)(b * 256 + m0) * 4 + head) * 128 + 2 * lane;
#pragma unroll 1
        for (int i0 = 0; i0 < 64; i0 += 16) { f32x2 v[16];
#pragma unroll
            for (int i = 0; i < 16; ++i) v[i] = *(const f32x2*)(vr + (size_t)(i0 + i) * 512);
#pragma unroll
            for (int i = 0; i < 16; ++i) { const float pp = ps[i0 + i]; o0 += pp * v[i].x; o1 += pp * v[i].y; } }
        po[2 * lane] = o0; po[2 * lane + 1] = o1; }
    __syncthreads();
    if (q4 == 0) {
        float m[4], sm4[4]; float M = -1e30f;
#pragma unroll
        for (int j = 0; j < 4; ++j) { const LAS float* qj = qs + j * 1024; m[j] = qj[320]; sm4[j] = qj[321]; M = fmaxf(M, m[j]); }
        float S = 0.f, o0 = 0.f, o1 = 0.f;
#pragma unroll
        for (int j = 0; j < 4; ++j) { const float e = __expf(m[j] - M); S += sm4[j] * e; o0 += (qs + j * 1024)[192 + 2 * lane] * e; o1 += (qs + j * 1024)[192 + 2 * lane + 1] * e; }
        const float inv = 1.f / S;
        *(unsigned*)(OC + (size_t)(MP + b) * DXA + head * 128 + 2 * lane) = pk2(o0 * inv, o1 * inv);
    }
    __syncthreads();
}

DI void p8_convgate(const Ctx& c) {
    const bf16_t* U = (const bf16_t*)(c.ws + WS_USMP) - (size_t)MP * DFF2;
    bf16_t* H = (bf16_t*)(c.ws + WS_H);
    const float* UF = (const float*)(c.ws + WS_UF); const float* UL = (const float*)(c.ws + WS_UL);
    const float* fw = IN_(I_FCW); const float* fb = IN_(I_FCB);
    for (int i = c.bid * 512 + c.tid; i < 31 * 2 * (DFF / 4); i += c.G * 512) { const int j4 = (i % (DFF / 4)) * 4, rr = (i / (DFF / 4)) & 1, pm = 1 + i / (2 * (DFF / 4));
        if ((pm & 7) == 0) continue;
        const size_t row = (size_t)pm * 256 + rr; float o[4];
#pragma unroll
        for (int hf = 0; hf < 2; ++hf) { const int col = hf * DFF + j4;
            const f32x4 ut = *(const f32x4*)(UF + (size_t)(pm * 2 + rr) * DFF2 + col);
            const f32x4 u1 = rr ? *(const f32x4*)(UF + (size_t)(pm * 2) * DFF2 + col) : *(const f32x4*)(UL + (size_t)((pm - 1) * 2 + 1) * DFF2 + col);
            const f32x4 u2 = rr ? *(const f32x4*)(UL + (size_t)((pm - 1) * 2 + 1) * DFF2 + col) : *(const f32x4*)(UL + (size_t)((pm - 1) * 2) * DFF2 + col);
            const f32x4 cv = *(const f32x4*)(fb + col) + *(const f32x4*)(fw + col) * u2 + *(const f32x4*)(fw + DFF2 + col) * u1 + *(const f32x4*)(fw + 2 * DFF2 + col) * ut;
#pragma unroll
            for (int j = 0; j < 4; ++j) o[j] = hf == 0 ? silu_f(cv[j]) : o[j] * cv[j]; }
        u32x2 q; q.x = pk2(o[0], o[1]); q.y = pk2(o[2], o[3]); *(u32x2*)(H + row * DFF + j4) = q; }
    for (int i = c.bid * 512 + c.tid; i < MS * 704; i += c.G * 512) { const int b = i / 704, j8 = i % 704; const size_t row = MP + b; const float* st = IN_(I_SFC) + (size_t)b * 2 * DFF2; float* fo = c.out + O_FCS + (size_t)b * 2 * DFF2;
        float g3[8], v3[8], o[8]; const bf16_t* up = U + row * DFF2 + j8 * 8; unpack8(*(const u32x4*)up, g3); unpack8(*(const u32x4*)(up + DFF), v3);
#pragma unroll
        for (int j = 0; j < 8; ++j) { const int cg_ = j8 * 8 + j, cv_ = DFF + cg_; const float g1 = st[cg_], g2 = st[DFF2 + cg_], v1 = st[cv_], v2 = st[DFF2 + cv_];
            const float cgv = fb[cg_] + fw[cg_] * g1 + fw[DFF2 + cg_] * g2 + fw[2 * DFF2 + cg_] * g3[j], cvv = fb[cv_] + fw[cv_] * v1 + fw[DFF2 + cv_] * v2 + fw[2 * DFF2 + cv_] * v3[j];
            o[j] = silu_f(cgv) * cvv; fo[cg_] = g2; fo[cv_] = v2; fo[DFF2 + cg_] = g3[j]; fo[DFF2 + cv_] = v3[j]; }
        u32x4 q; q.x = pk2(o[0], o[1]); q.y = pk2(o[2], o[3]); q.z = pk2(o[4], o[5]); q.w = pk2(o[6], o[7]); *(u32x4*)(H + row * DFF + j8 * 8) = q; }
}

struct Skinny { const bf16_t* A; const bf16_t* Bt; int K; int ksplit; const float* ssq_in; const float* base; const bf16_t* baseB; float* out; bf16_t* abf; float* ssq; };
DI void skinny_tile(const Ctx& c, const Skinny& g, int ct) {
    int tid_ = c.tid; asm volatile("" : "+v"(tid_)); const int tid = tid_, lane = tid & 63, w = __builtin_amdgcn_readfirstlane(tid >> 6), fr = lane & 15, fq = lane >> 4;
    const int K = g.K, kw = K >> 3, k0 = w * kw;
    f32x4 acc[8];
#pragma unroll
    for (int mi = 0; mi < 8; ++mi) acc[mi] = (f32x4){0.f, 0.f, 0.f, 0.f};
    const bf16_t* ap = g.A + (size_t)fr * K + k0 + fq * 8; const bf16_t* bp = g.Bt + (size_t)(16 * ct + fr) * K + k0 + fq * 8;
#pragma unroll 2
    for (int ks = 0; ks < kw; ks += 32) {
        if (k0 + ks == g.ksplit && ks != 0) {
#pragma unroll
            for (int mi = 0; mi < 8; ++mi) acc[mi] = acc[mi] * rsqrtf(g.ssq_in[16 * mi + fr] * (1.f / 2048.f) + EPS);
        }
        const bf16x8 bf = *(const bf16x8*)(bp + ks);
#pragma unroll
        for (int mi = 0; mi < 8; ++mi) { const bf16x8 af = *(const bf16x8*)(ap + (size_t)mi * 16 * K + ks); acc[mi] = MFMA16(bf, af, acc[mi]); }
    }
    if (k0 + kw <= g.ksplit) {
#pragma unroll
        for (int mi = 0; mi < 8; ++mi) acc[mi] = acc[mi] * rsqrtf(g.ssq_in[16 * mi + fr] * (1.f / 2048.f) + EPS);
    }
    LAS f32x4* red = (LAS f32x4*)c.lds;
#pragma unroll
    for (int mi = 0; mi < 8; ++mi) red[(w * 8 + mi) * 64 + lane] = acc[mi];
    __syncthreads();
    f32x4 sum = (f32x4){0.f, 0.f, 0.f, 0.f};
#pragma unroll
    for (int ww = 0; ww < 8; ++ww) sum = sum + red[(ww * 8 + w) * 64 + lane];
    const int row = 16 * w + fr, col = 16 * ct + 4 * fq;
    f32x4 bs;
    if (g.baseB) { const u32x2 r = *(const u32x2*)(g.baseB + (size_t)row * DM + col); bs = (f32x4){bflo(r.x), bfhi(r.x), bflo(r.y), bfhi(r.y)}; } else bs = *(const f32x4*)(g.base + (size_t)row * DM + col);
    const f32x4 o = bs + sum;
    if (g.out) *(f32x4*)(g.out + (size_t)row * DM + col) = o;
    if (g.abf) { u32x2 wv; wv.x = pk2(o[0], o[1]); wv.y = pk2(o[2], o[3]); *(u32x2*)(g.abf + (size_t)row * DM + col) = wv;
        float sq = (o[0] * o[0] + o[1] * o[1]) + (o[2] * o[2] + o[3] * o[3]); sq += __shfl_xor(sq, 16); sq += __shfl_xor(sq, 32); if (fq == 0) atomicAdd(g.ssq + row, sq); }
    __syncthreads();
}

__global__ void __launch_bounds__(512, 2) fwd_mega(Args args) {
    extern __shared__ __attribute__((aligned(16))) unsigned char lds_raw[];
    cg::grid_group grid = cg::this_grid();
    Ctx c; c.lds = (LAS unsigned char*)lds_raw; c.tid = threadIdx.x; c.lane = c.tid & 63; c.wave = __builtin_amdgcn_readfirstlane(c.tid >> 6); c.G = gridDim.x; c.bid = blockIdx.x;
    c.in = args.in; c.out = args.out; c.ws = args.ws; c.dry = 0;
    unsigned char* ws = args.ws;
    const int lo = args.ph_lo, hi = args.ph_hi;
#ifndef PHMASK
#define PHMASK 0x3ff
#endif
#define PH(k) ((((PHMASK) >> (k)) & 1) && lo <= (k) && (k) < hi)
    volatile LAS unsigned* bst = (volatile LAS unsigned*)(c.lds + LDS_BYTES - 64);
    if (c.tid < 2) bst[c.tid] = 0u;
    __syncthreads();
    XcdBarrier xbar = xcd_barrier_post((unsigned*)(ws + WS_BAR), bst);
    if (lo > 1000) grid.sync();
#define GSYNC() xcd_barrier(xbar)
#define SYNC(k) do { if (PH(k) && PH((k) + 1)) GSYNC(); } while (0)
#ifndef REPEAT_MASK
#define REPEAT_MASK 0
#endif
#define REP(k) (((REPEAT_MASK) >> (k)) & 1)
    float* SSQ = (float*)(ws + WS_SSQ);
    if (PH(0)) p0_prologue(c);
    if (REP(0)) { GSYNC(); p0_prologue(c); }
    SYNC(0);
    if (PH(1)) {
        { pg8::Gemm g{(const bf16_t*)(ws + WS_A0), (const bf16_t*)(ws + WS_WIN), MPAD, DINP, 2048}; pg8::StaticOrder S; S.init(MPAD, DINP, c.G, c.bid);
            EpiProj E{(bf16_t*)(ws + WS_PROJ), (float*)(ws + WS_DT), 0}; pg8::gemm_phase(c.lds, g, S, E); }
        { pg8::Gemm g{(const bf16_t*)(ws + WS_MEMN), (const bf16_t*)(ws + WS_WCKV), 1024, 1024, 2048}; pg8::StaticOrder S; S.init(1024, 1024, c.G, c.G - 1 - c.bid);
            EpiMem E{c.out + O_MKP, c.out + O_MVP, 0}; pg8::gemm_phase(c.lds, g, S, E); }
    }
    SYNC(1);
    if (PH(2)) { p1b_conv(c); GSYNC(); }
    if (PH(2)) p2_mixers(c);
    if (REP(2)) { GSYNC(); c.dry = 1; p2_mixers(c); c.dry = 0; }
    SYNC(2);
    if (PH(3)) { pg8::Gemm g{(const bf16_t*)(ws + WS_MIX), (const bf16_t*)(ws + WS_WOUT), MP, 2048, 3072}; pg8::StaticOrder S; S.init(MP, 2048, c.G, c.bid);
        EpiRes<true> E{IN_(I_XP), IN_(I_XS), nullptr, nullptr, nullptr, (bf16_t*)(ws + WS_A0), SSQ + MPAD, SSQ, 32}; pg8::gemm_phase(c.lds, g, S, E);
        const Skinny sk{(const bf16_t*)(ws + WS_MIX) + (size_t)MP * DMIX, (const bf16_t*)(ws + WS_WOUT), 3072, 2048, SSQ + MP, IN_(I_XS), nullptr, nullptr, (bf16_t*)(ws + WS_A0) + (size_t)MP * DM, SSQ + MPAD + MP};
        for (int t = c.bid; t < 256; t += c.G) if ((t & 1) == 0) skinny_tile(c, sk, t >> 1); }
    SYNC(3);
    if (PH(4)) { pg8::Gemm g{(const bf16_t*)(ws + WS_A0), (const bf16_t*)(ws + WS_WCQ), MPAD, 512, 2048}; pg8::StaticOrder S; S.init(MPAD, 512, c.G, c.bid);
        EpiScale E{(bf16_t*)(ws + WS_QC), DXA, SSQ + MPAD, 0}; pg8::gemm_phase(c.lds, g, S, E);
        constexpr int NT3 = (MPAD / 256) * 2;
        if (c.G == 256 && c.bid >= NT3) p0_transposes(c, TT_P4_START, TT_ALL, c.bid - NT3, c.G - NT3); }
    SYNC(4);
    for (int rep = 0; rep < 1 + REP(5); ++rep) if (PH(5)) {
        if (rep) GSYNC();
        for (int u = c.bid; u < 256; u += c.G) xattn_prompt_unit(c, u);
        for (int u = c.bid; u < 256; u += c.G) xattn_sample_pair(c, u);
    }
    SYNC(5);
    if (PH(6)) { pg8::Gemm g{(const bf16_t*)(ws + WS_OC), (const bf16_t*)(ws + WS_WCO), MP, 2048, 512}; pg8::StaticOrder S; S.init(MP, 2048, c.G, c.bid);
        bf16_t* XB = (bf16_t*)(ws + WS_A0);
        EpiRes<false> E{nullptr, nullptr, XB, nullptr, nullptr, XB, SSQ + 2 * MPAD, nullptr, 0}; pg8::gemm_phase(c.lds, g, S, E);
        const Skinny sk{(const bf16_t*)(ws + WS_OC) + (size_t)MP * DXA, (const bf16_t*)(ws + WS_WCO), 512, -1, nullptr, nullptr, XB + (size_t)MP * DM, nullptr, XB + (size_t)MP * DM, SSQ + 2 * MPAD + MP};
        for (int t = c.bid; t < 256; t += c.G) if ((t & 1) == 0) skinny_tile(c, sk, t >> 1); }
    SYNC(6);
    if (PH(7)) { pg8::Gemm g{(const bf16_t*)(ws + WS_A0), (const bf16_t*)(ws + WS_WUP), MPAD, DFF2, 2048}; pg8::StaticOrder S; S.init(MPAD, DFF2, c.G, c.bid);
        EpiGate E{(bf16_t*)(ws + WS_H), SSQ + 2 * MPAD, IN_(I_FCW), IN_(I_FCB), (float*)(ws + WS_UF), (float*)(ws + WS_UL), (bf16_t*)(ws + WS_USMP), c.out + O_FCP, (LAS float*)(c.lds + 131072), 0}; pg8::gemm_phase(c.lds, g, S, E); }
    SYNC(7);
    if (PH(8)) p8_convgate(c);
    if (REP(8)) { GSYNC(); p8_convgate(c); }
    SYNC(8);
#ifdef EXTRA_SYNCS
    for (int i = 0; i < EXTRA_SYNCS; ++i) GSYNC();
#endif
    if (PH(9)) { pg8::Gemm g{(const bf16_t*)(ws + WS_H), (const bf16_t*)(ws + WS_WDN), MP, 2048, DFF}; pg8::StaticOrder S; S.init(MP, 2048, c.G, c.bid);
        const bf16_t* XB = (const bf16_t*)(ws + WS_A0);
        EpiRes<false> E{nullptr, nullptr, XB, c.out + O_Y, c.out + O_YS, nullptr, nullptr, nullptr, 0}; pg8::gemm_phase(c.lds, g, S, E);
        const Skinny sk{(const bf16_t*)(ws + WS_H) + (size_t)MP * DFF, (const bf16_t*)(ws + WS_WDN), DFF, -1, nullptr, nullptr, XB + (size_t)MP * DM, c.out + O_YS, nullptr, nullptr};
        for (int t = c.bid; t < 256; t += c.G) if ((t & 1) == 0) skinny_tile(c, sk, t >> 1); }
}

extern "C" void kernel_launch(void* const* d_in, const int* in_sizes, int n_in, void* d_out, int out_size, void* d_ws, size_t ws_size, hipStream_t stream) {
    static int grid = 0;
    if (grid == 0) {
        if (n_in != 35 || (size_t)out_size != O_END || ws_size < WS_END) { fprintf(stderr, "kernel_launch: unexpected shapes n_in %d out %d ws %zu (need %zu)\n", n_in, out_size, ws_size, (size_t)WS_END); grid = -1; return; }
        int dev = 0, cus = 0, per_cu = 0;
        hipGetDevice(&dev);
        hipDeviceGetAttribute(&cus, hipDeviceAttributeMultiprocessorCount, dev);
        hipFuncSetAttribute((const void*)fwd_mega, hipFuncAttributeMaxDynamicSharedMemorySize, LDS_BYTES);
        hipOccupancyMaxActiveBlocksPerMultiprocessor(&per_cu, (const void*)fwd_mega, 512, LDS_BYTES);
        if (per_cu < 1) fprintf(stderr, "kernel_launch: occupancy query says %d blocks/CU\n", per_cu);
        grid = cus;
    }
    if (grid < 0) return;
    if (hipMemsetAsync((char*)d_ws + WS_BAR, 0, WS_BAR_BYTES, stream) != hipSuccess) { fprintf(stderr, "kernel_launch: hipMemsetAsync failed\n"); return; }
    Args a{};
    for (int i = 0; i < 35; ++i) a.in[i] = (const float*)d_in[i];
    a.out = (float*)d_out; a.ws = (unsigned char*)d_ws; a.ph_lo = 0; a.ph_hi = 10;
    void* args[] = {&a};
    hipError_t e = hipLaunchCooperativeKernel((const void*)fwd_mega, dim3(grid), dim3(512), args, LDS_BYTES, stream);
    if (e != hipSuccess) fprintf(stderr, "cooperative launch failed: %s (grid %d)\n", hipGetErrorString(e), grid);
}
```

```cpp
#include <hip/hip_runtime.h>
#include <hip/hip_cooperative_groups.h>
#include <cstdio>
#include <cstdint>
namespace cg = cooperative_groups;

#define DI __device__ __forceinline__
#define LAS __attribute__((address_space(3)))
typedef unsigned short bf16_t;
typedef short bf16x8 __attribute__((ext_vector_type(8)));
typedef short s16x4 __attribute__((ext_vector_type(4)));
typedef float f32x4 __attribute__((ext_vector_type(4)));
typedef float f32x2 __attribute__((ext_vector_type(2)));
typedef unsigned u32x4 __attribute__((ext_vector_type(4)));
typedef unsigned u32x2 __attribute__((ext_vector_type(2)));
typedef __bf16 bf16x2_t __attribute__((ext_vector_type(2)));

DI unsigned pk2(float lo, float hi) { f32x2 v = {lo, hi}; bf16x2_t b = __builtin_convertvector(v, bf16x2_t); return __builtin_bit_cast(unsigned, b); }
DI float bflo(unsigned w) { return __uint_as_float(w << 16); }
DI float bfhi(unsigned w) { return __uint_as_float(w & 0xffff0000u); }
DI float bf1(bf16_t h) { return __uint_as_float(((unsigned)h) << 16); }
DI bf16_t f2bf(float f) { return (bf16_t)(pk2(f, 0.f) & 0xffffu); }
DI void unpack8(u32x4 r, float* o) { o[0] = bflo(r.x); o[1] = bfhi(r.x); o[2] = bflo(r.y); o[3] = bfhi(r.y); o[4] = bflo(r.z); o[5] = bfhi(r.z); o[6] = bflo(r.w); o[7] = bfhi(r.w); }
DI float wave_sum(float v) {
#pragma unroll
    for (int o = 1; o < 64; o <<= 1) v += __shfl_xor(v, o);
    return v;
}
DI float wave_max(float v) {
#pragma unroll
    for (int o = 1; o < 64; o <<= 1) v = fmaxf(v, __shfl_xor(v, o));
    return v;
}
DI float silu_f(float x) { return x / (1.f + __expf(-x)); }
DI float softplus_f(float x) { return x > 20.f ? x : log1pf(__expf(x)); }
#define MFMA16(a, b, c) __builtin_amdgcn_mfma_f32_16x16x32_bf16((a), (b), (c), 0, 0, 0)
#define LDS_FENCE() asm volatile("s_waitcnt lgkmcnt(0)" ::: "memory")
typedef short v4i16_t __attribute__((ext_vector_type(4)));
DI s16x4 vtr(const LAS bf16_t* p) { return __builtin_bit_cast(s16x4, __builtin_amdgcn_ds_read_tr16_b64_v4i16((LAS v4i16_t*)p)); }
DI bf16x8 cat8(s16x4 lo, s16x4 hi) { return __builtin_shufflevector(lo, hi, 0, 1, 2, 3, 4, 5, 6, 7); }

constexpr int DM = 2048, MP = 8192, MS = 128, MTOK = MP + MS, MPAD = 8448, SEQ = 2048, NB = 4;
constexpr int DIN = 6688, DINP = 6912, DMIX = 3072, DXA = 512, DFF = 5632, DFF2 = 11264, CONVD = 3072;
constexpr int C_Q = 0, C_K = 1024, C_V = 1280, C_Z = 1536, C_XBC = 3584, C_DT = 6656;
constexpr float EPS = 1e-6f;
constexpr size_t O_Y = 0, O_YS = O_Y + (size_t)MP * DM, O_SKP = O_YS + (size_t)MS * DM, O_SVP = O_SKP + 131072, O_SKS = O_SVP + 131072,
    O_SVS = O_SKS + 4194304, O_SCP = O_SVS + 4194304, O_SCS = O_SCP + 36864, O_SSP = O_SCS + 1179648, O_SSS = O_SSP + 1048576,
    O_MKP = O_SSS + 33554432, O_MVP = O_MKP + 524288, O_FCP = O_MVP + 524288, O_FCS = O_FCP + 90112, O_END = O_FCS + 2883584;
constexpr size_t MiB = 1u << 20;
constexpr size_t WS_SSQ = 0;
constexpr size_t WS_BAR = 512 * 1024, WS_BAR_BYTES = 16384;
constexpr size_t WS_WIN = 1 * MiB;
constexpr size_t WS_WOUT = WS_WIN + 27 * MiB;
constexpr size_t WS_WCQ = WS_WOUT + 12 * MiB;
constexpr size_t WS_WCKV = WS_WCQ + 2 * MiB;
constexpr size_t WS_WCO = WS_WCKV + 4 * MiB;
constexpr size_t WS_WUP = WS_WCO + 2 * MiB;
constexpr size_t WS_WDN = WS_WUP + 44 * MiB;
constexpr size_t WS_A0 = WS_WDN + 22 * MiB;
constexpr size_t WS_MEMN = WS_A0 + 33 * MiB;
constexpr size_t WS_X1 = WS_MEMN + 4 * MiB;
constexpr size_t WS_QC = WS_X1 + 66 * MiB;
constexpr size_t WS_OC = WS_QC + 9 * MiB;
constexpr size_t WS_DT = WS_OC + 9 * MiB;
constexpr size_t WS_H = WS_DT + 2 * MiB;
constexpr size_t WS_R1 = WS_H + 91 * MiB;
constexpr size_t WS_PROJ = WS_R1, WS_MIX = WS_R1 + 112 * MiB, WS_U = WS_R1;
constexpr size_t WS_UF = WS_R1, WS_UL = WS_R1 + 4 * MiB, WS_USMP = WS_R1 + 8 * MiB;
constexpr size_t WS_END = WS_R1 + 182 * MiB;
constexpr int LDS_BYTES = 147456;

namespace pg8 {
constexpr int BM = 256, BK = 64, HALF = 128, HTB = HALF * BK * 2, STAGE_BYTES = 8 * HTB, NXCD = 8, WGM = 8;
__host__ __device__ __forceinline__ int lds_byte(int r, int c) { const int st = (r >> 4) * 2 + (c >> 5), rr = r & 15, cc = c & 31, ob = rr * 64 + cc * 2; return st * 1024 + (ob ^ (((ob >> 9) & 1) << 5)); }
__host__ __device__ __forceinline__ void stage_rc(int b, int& R, int& C) { const int st = b / 1024, sb = b % 1024, swz = sb ^ (((sb >> 9) & 1) << 5); R = (st >> 1) * 16 + swz / 64; C = (st & 1) * 32 + (swz % 64) / 2; }
__host__ __device__ __forceinline__ int perm32(int rho) { const int n = rho >> 4, i = rho & 15; return 8 * (i >> 2) + 4 * n + (i & 3); }
struct Unit { int pm, pn; };
struct Gemm { const bf16_t* A; const bf16_t* Bt; int M, N, K; };
struct StaticOrder {
    int nM, nN, nwg, G, c;
    __host__ __device__ void init(int M, int N, int G_, int c_) { nM = M / BM; nN = N / BM; nwg = nM * nN; G = G_; c = c_; }
    __host__ __device__ bool next(int i, Unit& u) const {
        const long L = (long)i * G + c; if (L >= nwg) return false;
        int wgid = (int)L; { const int q = nwg / NXCD, r = nwg % NXCD, xcd = wgid % NXCD, off = wgid / NXCD; wgid = (xcd < r ? xcd * (q + 1) : r * (q + 1) + (xcd - r) * q) + off; }
        const int nig = WGM * nN, gid = wgid / nig, fm = gid * WGM, gsz = (nM - fm) < WGM ? (nM - fm) : WGM;
        u.pm = fm + ((wgid % nig) % gsz); u.pn = (wgid % nig) / gsz; return true;
    }
};
template <class Epi, class Sched>
__device__ __forceinline__ void gemm_phase(LAS unsigned char* lds, const Gemm g, const Sched& S, const Epi& E) {
    const int tid = threadIdx.x, wid = __builtin_amdgcn_readfirstlane(tid >> 6), lane = tid & 63, wr = wid >> 2, wc = wid & 3, fr = lane & 15, fq = lane >> 4;
    const int K = g.K, nt = K / BK;
    unsigned voffA[2], voffB[2];
#pragma unroll
    for (int i = 0; i < 2; ++i) { int R, C; stage_rc(tid * 16 + i * 8192, R, C); const int Rb = Epi::PERM ? ((R & ~31) + perm32(R & 31)) : R;
        voffA[i] = (unsigned)(R * K + C) * 2u; voffB[i] = (unsigned)(Rb * K + C) * 2u; }
    const size_t kstep = (size_t)(BK * 2);
    const size_t hstep = (size_t)HALF * K * 2;
    const size_t tstep = 2 * hstep;
    const unsigned ldsw = (unsigned)wid * 1024u;
    const int aoff = lds_byte(wr * 64 + fr, fq * 8), boff = lds_byte(wc * 32 + fr, fq * 8);
#define PG8_SA(b, h) (((b) * 2 + (h)) * HTB)
#define PG8_SB(b, h) ((4 + (b) * 2 + (h)) * HTB)
#define PG8_STAGE(bufoff, gbase, voff) do { _Pragma("unroll") for (int _i = 0; _i < 2; ++_i) \
        __builtin_amdgcn_global_load_lds((const unsigned*)((const char*)(gbase) + (voff)[_i]), (LAS unsigned*)(lds + (bufoff) + ldsw + _i * 8192), 16, 0, 0); } while (0)
#define PG8_LDA(dst, b, h) do { _Pragma("unroll") for (int m = 0; m < 4; ++m) _Pragma("unroll") for (int k = 0; k < 2; ++k) dst[m][k] = *(const LAS bf16x8*)(lds + PG8_SA(b, h) + aoff + m * 2048 + k * 1024); } while (0)
#define PG8_LDB(dst, b, h) do { _Pragma("unroll") for (int n = 0; n < 2; ++n) _Pragma("unroll") for (int k = 0; k < 2; ++k) dst[n][k] = *(const LAS bf16x8*)(lds + PG8_SB(b, h) + boff + n * 2048 + k * 1024); } while (0)
#define PG8_MMA(ai, bj, At, Bt) do { __builtin_amdgcn_s_setprio(1); _Pragma("unroll") for (int m = 0; m < 4; ++m) _Pragma("unroll") for (int n = 0; n < 2; ++n) _Pragma("unroll") for (int k = 0; k < 2; ++k) \
        acc[ai][bj][m][n] = Epi::SWAP ? __builtin_amdgcn_mfma_f32_16x16x32_bf16(At[m][k], Bt[n][k], acc[ai][bj][m][n], 0, 0, 0) : __builtin_amdgcn_mfma_f32_16x16x32_bf16(Bt[n][k], At[m][k], acc[ai][bj][m][n], 0, 0, 0); __builtin_amdgcn_s_setprio(0); } while (0)
#define PG8_WAIT_V(n) asm volatile("s_waitcnt vmcnt(" #n ")" ::: "memory")
#define PG8_WAIT_L(n) asm volatile("s_waitcnt lgkmcnt(" #n ")" ::: "memory")
#define PG8_BAR __builtin_amdgcn_s_barrier()
#define PG8_SCHED __builtin_amdgcn_sched_barrier(0)
    Unit cur, nxt; int ui = 0;
    if (!S.next(0, cur)) return;
    f32x4 acc[2][2][4][2];
#pragma unroll
    for (int a = 0; a < 2; ++a)
#pragma unroll
        for (int b = 0; b < 2; ++b)
#pragma unroll
            for (int m = 0; m < 4; ++m)
#pragma unroll
                for (int n = 0; n < 2; ++n) acc[a][b][m][n] = (f32x4){0.f, 0.f, 0.f, 0.f};
    bf16x8 At[4][2], B0[2][2], B1[2][2];
    const char* cA = (const char*)g.A + (size_t)cur.pm * tstep; const char* cB = (const char*)g.Bt + (size_t)cur.pn * tstep;
    PG8_STAGE(PG8_SB(0, 0), cB, voffB); PG8_STAGE(PG8_SB(0, 1), cB + hstep, voffB); PG8_STAGE(PG8_SA(0, 0), cA, voffA); PG8_STAGE(PG8_SA(0, 1), cA + hstep, voffA);
    if (wr == 1) PG8_BAR;
    PG8_WAIT_V(2); PG8_BAR;
    PG8_STAGE(PG8_SB(1, 0), cB + kstep, voffB); PG8_STAGE(PG8_SA(1, 0), cA + kstep, voffA); PG8_STAGE(PG8_SB(1, 1), cB + hstep + kstep, voffB);
    PG8_WAIT_V(6); PG8_BAR;
    for (;;) {
        const bool has_next = S.next(ui + 1, nxt);
        const char* nA = has_next ? (const char*)g.A + (size_t)nxt.pm * tstep : cA; const char* nB = has_next ? (const char*)g.Bt + (size_t)nxt.pn * tstep : cB;
        for (int t = 0; t < nt; t += 2) {
            const bool last = (t == nt - 2);
            const char* a1 = cA + (size_t)(t + 1) * kstep;
            const char* a2 = last ? nA : cA + (size_t)(t + 2) * kstep; const char* b2 = last ? nB : cB + (size_t)(t + 2) * kstep;
            const char* a3 = a2 + kstep; const char* b3 = b2 + kstep;
            if constexpr (Epi::MID) { if (t == E.tsplit) E.midscale(acc, cur, wr, fr); }
            PG8_LDB(B0, 0, 0); PG8_LDB(B1, 0, 1); PG8_SCHED; PG8_LDA(At, 0, 0); PG8_STAGE(PG8_SA(1, 1), a1 + hstep, voffA);
            PG8_WAIT_V(8); PG8_WAIT_L(0); PG8_BAR; PG8_MMA(0, 0, At, B0); PG8_MMA(0, 1, At, B1); PG8_BAR; PG8_SCHED;
            PG8_LDA(At, 0, 1); PG8_STAGE(PG8_SB(0, 0), b2, voffB); PG8_STAGE(PG8_SB(0, 1), b2 + hstep, voffB); PG8_STAGE(PG8_SA(0, 0), a2, voffA);
            PG8_WAIT_V(8); PG8_WAIT_L(0); PG8_BAR; PG8_MMA(1, 0, At, B0); PG8_MMA(1, 1, At, B1); PG8_BAR; PG8_SCHED;
            PG8_LDB(B0, 1, 0); PG8_LDB(B1, 1, 1); PG8_SCHED; PG8_LDA(At, 1, 0); PG8_STAGE(PG8_SA(0, 1), a2 + hstep, voffA);
            PG8_WAIT_V(8); PG8_WAIT_L(0); PG8_BAR; PG8_MMA(0, 0, At, B0); PG8_MMA(0, 1, At, B1); PG8_BAR; PG8_SCHED;
            PG8_LDA(At, 1, 1); PG8_STAGE(PG8_SB(1, 0), b3, voffB); PG8_STAGE(PG8_SB(1, 1), b3 + hstep, voffB); PG8_STAGE(PG8_SA(1, 0), a3, voffA);
            PG8_WAIT_V(8); PG8_WAIT_L(0); PG8_BAR; PG8_MMA(1, 0, At, B0); PG8_MMA(1, 1, At, B1); PG8_BAR; PG8_SCHED;
        }
        if (wr == 0) PG8_BAR;
        E(acc, cur, wr, wc, fr, fq);
        if (!has_next) break;
#pragma unroll
        for (int a = 0; a < 2; ++a)
#pragma unroll
            for (int b = 0; b < 2; ++b)
#pragma unroll
                for (int m = 0; m < 4; ++m)
#pragma unroll
                    for (int n = 0; n < 2; ++n) acc[a][b][m][n] = (f32x4){0.f, 0.f, 0.f, 0.f};
        cur = nxt; cA = nA; cB = nB; ++ui;
        if (wr == 1) PG8_BAR;
    }
    PG8_WAIT_V(0);
    PG8_BAR;
#undef PG8_SA
#undef PG8_SB
#undef PG8_STAGE
#undef PG8_LDA
#undef PG8_LDB
#undef PG8_MMA
#undef PG8_WAIT_V
#undef PG8_WAIT_L
#undef PG8_BAR
#undef PG8_SCHED
}
}
using pg8::Unit;
typedef f32x4 Acc[2][2][4][2];

struct EpiProj {
    static constexpr bool PERM = true, MID = false, SWAP = false; bf16_t* O; float* dt; int tsplit;
    DI void midscale(Acc&, const Unit&, int, int) const {}
    DI void operator()(const Acc& acc, const Unit& u, int wr, int wc, int fr, int fq) const {
        const int row0 = u.pm * 256 + wr * 64 + fr, col0 = u.pn * 256 + wc * 32 + 8 * fq;
#pragma unroll
        for (int ai = 0; ai < 2; ++ai)
#pragma unroll
            for (int m = 0; m < 4; ++m) { const int row = row0 + ai * 128 + m * 16; bf16_t* rowp = O + (size_t)row * DINP + col0;
#pragma unroll
                for (int bj = 0; bj < 2; ++bj) { const f32x4 v0 = acc[ai][bj][m][0], v1 = acc[ai][bj][m][1]; u32x4 w; w.x = pk2(v0[0], v0[1]); w.y = pk2(v0[2], v0[3]); w.z = pk2(v1[0], v1[1]); w.w = pk2(v1[2], v1[3]);
                    *(u32x4*)(rowp + bj * 128) = w; }
                if (u.pn == 26 && wc == 0) { float* d = dt + (size_t)row * 32 + 8 * fq; *(f32x4*)d = acc[ai][0][m][0]; *(f32x4*)(d + 4) = acc[ai][0][m][1]; } }
    }
};
struct EpiMem {
    static constexpr bool PERM = false, MID = false, SWAP = false; float* outK; float* outV; int tsplit;
    DI void midscale(Acc&, const Unit&, int, int) const {}
    DI void operator()(const Acc& acc, const Unit& u, int wr, int wc, int fr, int fq) const {
        float* base = (u.pn < 2) ? outK : outV; const int colt = (u.pn & 1) * 256 + wc * 32 + 4 * fq;
#pragma unroll
        for (int ai = 0; ai < 2; ++ai)
#pragma unroll
            for (int m = 0; m < 4; ++m) { const int row = u.pm * 256 + ai * 128 + wr * 64 + m * 16 + fr;
#pragma unroll
                for (int bj = 0; bj < 2; ++bj)
#pragma unroll
                    for (int n = 0; n < 2; ++n) *(f32x4*)(base + (size_t)row * 512 + colt + bj * 128 + n * 16) = acc[ai][bj][m][n]; }
    }
};
template <bool MIDS> struct EpiRes {
    static constexpr bool PERM = false, MID = MIDS, SWAP = false;
    const float* baseP; const float* baseS; const bf16_t* baseB; float* outP; float* outS; bf16_t* abf; float* ssq; const float* ssq_in; int tsplit;
    DI void midscale(Acc& acc, const Unit& u, int wr, int fr) const {
        int rbase = u.pm * 256 + wr * 64 + fr; asm volatile("" : "+v"(rbase));
#pragma unroll
        for (int ai = 0; ai < 2; ++ai)
#pragma unroll
            for (int m = 0; m < 4; ++m) { const int row = rbase + ai * 128 + m * 16; const float s = rsqrtf(ssq_in[row] * (1.f / 2048.f) + EPS);
#pragma unroll
                for (int bj = 0; bj < 2; ++bj)
#pragma unroll
                    for (int n = 0; n < 2; ++n) acc[ai][bj][m][n] = acc[ai][bj][m][n] * s; }
    }
    DI void operator()(const Acc& acc, const Unit& u, int wr, int wc, int fr, int fq) const {
        const int col0 = u.pn * 256 + wc * 32 + 4 * fq;
#pragma unroll
        for (int ai = 0; ai < 2; ++ai)
#pragma unroll
            for (int m = 0; m < 4; ++m) { const int row = u.pm * 256 + ai * 128 + wr * 64 + m * 16 + fr;
                if (row < MTOK) {
                    const float* bp = baseB ? nullptr : (row < MP ? baseP + (size_t)row * DM : baseS + (size_t)(row - MP) * DM);
                    float* op = outP ? (row < MP ? outP + (size_t)row * DM : outS + (size_t)(row - MP) * DM) : nullptr;
                    float sq = 0.f;
#pragma unroll
                    for (int bj = 0; bj < 2; ++bj)
#pragma unroll
                        for (int n = 0; n < 2; ++n) { const int c = col0 + bj * 128 + n * 16; f32x4 bs;
                            if (baseB) { const u32x2 r = *(const u32x2*)(baseB + (size_t)row * DM + c); bs = (f32x4){bflo(r.x), bfhi(r.x), bflo(r.y), bfhi(r.y)}; } else bs = *(const f32x4*)(bp + c);
                            const f32x4 o = bs + acc[ai][bj][m][n]; if (op) *(f32x4*)(op + c) = o;
                            if (abf) { u32x2 w; w.x = pk2(o[0], o[1]); w.y = pk2(o[2], o[3]); *(u32x2*)(abf + (size_t)row * DM + c) = w; sq += (o[0] * o[0] + o[1] * o[1]) + (o[2] * o[2] + o[3] * o[3]); } }
                    if (abf) { sq += __shfl_xor(sq, 16); sq += __shfl_xor(sq, 32); if (fq == 0) atomicAdd(ssq + row, sq); }
                }
                asm volatile("" ::: "memory"); }
    }
};
struct EpiScale {
    static constexpr bool PERM = true, MID = false, SWAP = false; bf16_t* O; int ldc; const float* ssq_in; int tsplit;
    DI void midscale(Acc&, const Unit&, int, int) const {}
    DI void operator()(const Acc& acc, const Unit& u, int wr, int wc, int fr, int fq) const {
        const int row0 = u.pm * 256 + wr * 64 + fr, col0 = u.pn * 256 + wc * 32 + 8 * fq;
#pragma unroll
        for (int ai = 0; ai < 2; ++ai)
#pragma unroll
            for (int m = 0; m < 4; ++m) { const int row = row0 + ai * 128 + m * 16; bf16_t* rowp = O + (size_t)row * ldc + col0; const float s = rsqrtf(ssq_in[row] * (1.f / 2048.f) + EPS);
#pragma unroll
                for (int bj = 0; bj < 2; ++bj) { const f32x4 v0 = acc[ai][bj][m][0] * s, v1 = acc[ai][bj][m][1] * s; u32x4 w; w.x = pk2(v0[0], v0[1]); w.y = pk2(v0[2], v0[3]); w.z = pk2(v1[0], v1[1]); w.w = pk2(v1[2], v1[3]);
                    *(u32x4*)(rowp + bj * 128) = w; } }
    }
};

struct EpiGate {
    static constexpr bool PERM = false, MID = false, SWAP = true;
    bf16_t* H; const float* ssq_in; const float* fw; const float* fb; float* UF; float* UL; bf16_t* USMP; float* fcp; LAS float* ex; int tsplit;
    DI void midscale(Acc&, const Unit&, int, int) const {}
    DI void operator()(const Acc& acc, const Unit& u, int wr, int wc, int fr_in, int fq_in) const {
        int fr = fr_in, fq = fq_in; asm volatile("" : "+v"(fr), "+v"(fq));
        const int w = wr * 4 + wc, lane = fq * 16 + fr;
        const int rowq = u.pm * 256 + wr * 64 + 4 * fq;
        const int chan = u.pn * 128 + wc * 32 + fr;
        if (u.pm == 32) {
#pragma unroll
            for (int m = 0; m < 4; ++m) { const int rl = wr * 64 + 16 * m + 4 * fq; const f32x4 sq = *(const f32x4*)(ssq_in + MP + rl);
#pragma unroll
                for (int jj = 0; jj < 4; ++jj) { const float rsv = rsqrtf(sq[jj] * (1.f / 2048.f) + EPS);
#pragma unroll
                    for (int bj = 0; bj < 2; ++bj)
#pragma unroll
                        for (int n = 0; n < 2; ++n) USMP[(size_t)(rl + jj) * DFF2 + bj * DFF + chan + 16 * n] = f2bf(acc[0][bj][m][n][jj] * rsv); } }
            return;
        }
        if (fq == 3) {
#pragma unroll
            for (int ai = 0; ai < 2; ++ai) { const f32x4 sq = *(const f32x4*)(ssq_in + rowq + 128 * ai + 48);
                const float r2 = rsqrtf(sq[2] * (1.f / 2048.f) + EPS), r3 = rsqrtf(sq[3] * (1.f / 2048.f) + EPS);
#pragma unroll
                for (int bj = 0; bj < 2; ++bj)
#pragma unroll
                    for (int n = 0; n < 2; ++n) { const float v2 = acc[ai][bj][3][n][2] * r2, v3 = acc[ai][bj][3][n][3] * r3;
                        LAS float* e = ex + ((w * 2 + ai) * 2) * 64 + bj * 32 + n * 16 + fr; e[0] = v2; e[64] = v3;
                        if (ai == 1 && wr == 1) { float* ul = UL + (size_t)(u.pm * 2) * DFF2 + bj * DFF + chan + 16 * n; ul[0] = v2; ul[DFF2] = v3;
                            if ((u.pm & 7) == 7) { float* fo = fcp + (size_t)((u.pm >> 3) * 2) * DFF2 + bj * DFF + chan + 16 * n; fo[0] = v2; fo[DFF2] = v3; } } } }
        }
        if (fq == 0 && wr == 0) { const f32x4 sq = *(const f32x4*)(ssq_in + rowq);
            const float r0 = rsqrtf(sq[0] * (1.f / 2048.f) + EPS), r1 = rsqrtf(sq[1] * (1.f / 2048.f) + EPS);
#pragma unroll
            for (int bj = 0; bj < 2; ++bj)
#pragma unroll
                for (int n = 0; n < 2; ++n) { float* uf = UF + (size_t)(u.pm * 2) * DFF2 + bj * DFF + chan + 16 * n; uf[0] = acc[0][bj][0][n][0] * r0; uf[DFF2] = acc[0][bj][0][n][1] * r1; } }
        asm volatile("s_waitcnt lgkmcnt(0)" ::: "memory"); __builtin_amdgcn_s_barrier(); asm volatile("" ::: "memory");
        float wg[2][3], wv[2][3], bg[2], bv[2];
#pragma unroll
        for (int n = 0; n < 2; ++n) {
#pragma unroll
            for (int t = 0; t < 3; ++t) { wg[n][t] = fw[(size_t)t * DFF2 + chan + 16 * n]; wv[n][t] = fw[(size_t)t * DFF2 + DFF + chan + 16 * n]; }
            bg[n] = fb[chan + 16 * n]; bv[n] = fb[DFF + chan + 16 * n]; }
        const int srcl = (lane + 48) & 63;
#pragma unroll
        for (int ai = 0; ai < 2; ++ai) {
            const bool hal = (wr == 1 || ai == 1);
            const LAS float* hb = ex + (wr == 1 ? ((w - 4) * 2 + ai) * 2 : ((w + 4) * 2 + 0) * 2) * 64 + fr;
            f32x4 gl[2], vl[2];
#pragma unroll
            for (int m = 0; m < 4; ++m) {
                const f32x4 sq = *(const f32x4*)(ssq_in + rowq + 128 * ai + 16 * m); f32x4 rs4;
#pragma unroll
                for (int jj = 0; jj < 4; ++jj) rs4[jj] = rsqrtf(sq[jj] * (1.f / 2048.f) + EPS);
#pragma unroll
                for (int n = 0; n < 2; ++n) {
                    const f32x4 g = acc[ai][0][m][n] * rs4, v = acc[ai][1][m][n] * rs4;
                    float g2 = __shfl(g[2], srcl), g3 = __shfl(g[3], srcl), v2 = __shfl(v[2], srcl), v3 = __shfl(v[3], srcl);
                    if (m > 0) { const float a2 = __shfl(gl[n][2], srcl), a3 = __shfl(gl[n][3], srcl), c2 = __shfl(vl[n][2], srcl), c3 = __shfl(vl[n][3], srcl);
                        if (fq == 0) { g2 = a2; g3 = a3; v2 = c2; v3 = c3; } }
                    else { const float t0 = hb[n * 16], t1 = hb[32 + n * 16], t2 = hb[64 + n * 16], t3 = hb[96 + n * 16];
                        if (fq == 0) { g2 = hal ? t0 : 0.f; v2 = hal ? t1 : 0.f; g3 = hal ? t2 : 0.f; v3 = hal ? t3 : 0.f; } }
                    gl[n] = g; vl[n] = v;
                    float hh[4];
                    { const float c0 = bg[n] + wg[n][0] * g2 + wg[n][1] * g3 + wg[n][2] * g[0], d0 = bv[n] + wv[n][0] * v2 + wv[n][1] * v3 + wv[n][2] * v[0]; hh[0] = silu_f(c0) * d0; }
                    { const float c1 = bg[n] + wg[n][0] * g3 + wg[n][1] * g[0] + wg[n][2] * g[1], d1 = bv[n] + wv[n][0] * v3 + wv[n][1] * v[0] + wv[n][2] * v[1]; hh[1] = silu_f(c1) * d1; }
                    { const float c2 = bg[n] + wg[n][0] * g[0] + wg[n][1] * g[1] + wg[n][2] * g[2], d2 = bv[n] + wv[n][0] * v[0] + wv[n][1] * v[1] + wv[n][2] * v[2]; hh[2] = silu_f(c2) * d2; }
                    { const float c3 = bg[n] + wg[n][0] * g[1] + wg[n][1] * g[2] + wg[n][2] * g[3], d3 = bv[n] + wv[n][0] * v[1] + wv[n][1] * v[2] + wv[n][2] * v[3]; hh[3] = silu_f(c3) * d3; }
                    bf16_t* hp = H + (size_t)(rowq + 128 * ai + 16 * m) * DFF + chan + 16 * n;
                    const bool skip01 = (ai == 0 && m == 0 && wr == 0 && fq == 0 && (u.pm & 7) != 0);
                    if (!skip01) { hp[0] = f2bf(hh[0]); hp[DFF] = f2bf(hh[1]); }
                    hp[2 * DFF] = f2bf(hh[2]); hp[3 * DFF] = f2bf(hh[3]);
                }
            }
        }
    }
};

#define XB_TMO      128
#define XB_XCNT(j)  (256  + 64 * (j))
#define XB_XSUB(j)  (1280 + 64 * (j))
#define XB_XGEN(j)  (2304 + 64 * (j))
#define XB_TOP      3328
#define XB_TOPGEN   3392
#define XCD_BAR_WORDS 3456
#define XB_SPIN_CAP (1u << 18)

__device__ __forceinline__ unsigned xb_ld(unsigned* p)              { return __hip_atomic_load(p, __ATOMIC_RELAXED, __HIP_MEMORY_SCOPE_AGENT); }
__device__ __forceinline__ unsigned xb_add(unsigned* p, unsigned v) { return __hip_atomic_fetch_add(p, v, __ATOMIC_RELAXED, __HIP_MEMORY_SCOPE_AGENT); }
__device__ __forceinline__ unsigned xb_xcc_id() { return (unsigned)__builtin_amdgcn_s_getreg((3 << 11) | 20) & 0xFu; }
#define XB_SPIN(cond, bar) do { unsigned _sp = 0; while (cond) { __builtin_amdgcn_s_sleep(1); \
    if ((++_sp & 255u) == 0u) { if (xb_ld(&(bar)[XB_TMO])) break; if (_sp > XB_SPIN_CAP) { atomicAdd(&(bar)[XB_TMO], 1u); break; } } } } while (0)

struct XcdBarrier {
    unsigned* bar; unsigned x;
    volatile LAS unsigned* st;
};

__device__ __forceinline__ XcdBarrier xcd_barrier_post(unsigned* bar, volatile LAS unsigned* st) {
    XcdBarrier b; b.bar = bar; b.x = xb_xcc_id(); b.st = st;
    if (threadIdx.x == 0) (void)xb_add(&bar[XB_XCNT(b.x)], 1u);
    return b;
}
__device__ __forceinline__ void xcd_barrier_complete(unsigned* bar, unsigned x, unsigned& nloc, unsigned& nx) {
    const unsigned G = gridDim.x * gridDim.y * gridDim.z;
    unsigned sum, cnt, mine, sp = 0u;
    for (;;) {
        sum = 0u; cnt = 0u; mine = 0u;
#pragma unroll
        for (unsigned j = 0; j < 16; ++j) { const unsigned c = xb_ld(&bar[XB_XCNT(j)]); sum += c; cnt += (c > 0u) ? 1u : 0u; mine = (j == x) ? c : mine; }
        if (sum == G) break;
        __builtin_amdgcn_s_sleep(1);
        if ((++sp & 255u) == 0u) { if (xb_ld(&bar[XB_TMO])) break; if (sp > XB_SPIN_CAP) { atomicAdd(&bar[XB_TMO], 1u); break; } }
    }
    nloc = mine > 0u ? mine : 1u; nx = cnt > 0u ? cnt : 1u;
}

__device__ __forceinline__ void xcd_barrier(const XcdBarrier& b) {
    asm volatile("s_waitcnt vmcnt(0)" ::: "memory");
    __syncthreads();
    if (threadIdx.x == 0) {
        unsigned* bar = b.bar;
        __builtin_amdgcn_s_waitcnt(0);
        unsigned nloc = b.st[0], nx = b.st[1];
        if (nloc == 0u) { xcd_barrier_complete(bar, b.x, nloc, nx); b.st[0] = nloc; b.st[1] = nx; }
        const unsigned old = xb_add(&bar[XB_XSUB(b.x)], 1u);
        const unsigned gen = old / nloc;
        if (old + 1u == (gen + 1u) * nloc) {
            __builtin_amdgcn_fence(__ATOMIC_RELEASE, "agent");
            asm volatile("s_waitcnt vmcnt(0)" ::: "memory");
            const unsigned og = xb_add(&bar[XB_TOP], 1u);
            const unsigned tg = og / nx;
            if (og + 1u == (tg + 1u) * nx) xb_add(&bar[XB_TOPGEN], 1u);
            else XB_SPIN(xb_ld(&bar[XB_TOPGEN]) == tg, bar);
            __builtin_amdgcn_fence(__ATOMIC_ACQUIRE, "agent");
            xb_add(&bar[XB_XGEN(b.x)], 1u);
            asm volatile("s_waitcnt vmcnt(0)" ::: "memory");
        } else {
            XB_SPIN(xb_ld(&bar[XB_XGEN(b.x)]) == gen, bar);
            __builtin_amdgcn_fence(__ATOMIC_ACQUIRE, "agent");
            asm volatile("s_waitcnt vmcnt(0)" ::: "memory");
        }
    }
    __syncthreads();
}

struct Args { const float* in[35]; float* out; unsigned char* ws; int ph_lo, ph_hi; };
struct Ctx {
    LAS unsigned char* lds; int tid, lane, wave, G, bid;
    const float* const* in; float* out; unsigned char* ws; int dry;
};
#define IN_(i) (c.in[i])
enum { I_XP = 0, I_XS, I_CSK, I_CSV, I_SSC, I_SS, I_CMK, I_CMV, I_SFC, I_MEM, I_GMIX, I_WIN, I_QG, I_KG, I_SINK, I_SCW, I_SCB, I_DTB, I_ALOG, I_DSK, I_SNG, I_WOUT, I_GCR, I_GMEM, I_WCQ, I_WCK, I_WCV, I_CQG, I_CKG, I_WCO, I_GFFN, I_WUP, I_FCW, I_FCB, I_WDN };

struct TItem { const float* W; bf16_t* WT; const float* gain; int N, ldk, ksrc0, kdst0, n0, nrow_off, dn0; };
constexpr int TT_IN = 16 * 53, TT_OUT = 24 * 16, TT_C = 16 * 4, TT_CO = 4 * 16, TT_UP = 16 * 88, TT_DN = 44 * 16;
constexpr int TT_ALL = TT_IN + TT_OUT + 3 * TT_C + TT_CO + TT_UP + TT_DN;
constexpr int TT_P4_START = TT_ALL - 1400;
DI bool p0_decode(const Ctx& c, int it, TItem& t) {
    int r = it; t.nrow_off = 0;
    if (r < TT_IN) { const int kb = r / 53, nb = r % 53; t.W = IN_(I_WIN); t.N = DIN; t.WT = (bf16_t*)(c.ws + WS_WIN); t.ldk = 2048; t.ksrc0 = kb * 128; t.kdst0 = kb * 128; t.n0 = nb * 128; t.gain = IN_(I_GMIX) + kb * 128; t.dn0 = t.nrow_off + t.n0; return true; } r -= TT_IN;
    if (r < TT_OUT) { const int kb = r / 16, nb = r % 16, ks = kb * 128; const bool ssd = ks >= 1024; t.W = IN_(I_WOUT); t.N = 2048; t.WT = (bf16_t*)(c.ws + WS_WOUT); t.ldk = 3072; t.ksrc0 = ks; t.kdst0 = ssd ? ks - 1024 : ks + 2048; t.n0 = nb * 128;
        t.gain = ssd ? IN_(I_SNG) + (ks - 1024) : nullptr; t.dn0 = t.nrow_off + t.n0; return true; } r -= TT_OUT;
    if (r < TT_C) { const int kb = r / 4, nb = r % 4; t.W = IN_(I_WCQ); t.N = 512; t.WT = (bf16_t*)(c.ws + WS_WCQ); t.ldk = 2048; t.ksrc0 = kb * 128; t.kdst0 = kb * 128; t.n0 = nb * 128; t.gain = IN_(I_GCR) + kb * 128; t.dn0 = t.nrow_off + t.n0; return true; } r -= TT_C;
    if (r < TT_C) { const int kb = r / 4, nb = r % 4; t.W = IN_(I_WCK); t.N = 512; t.WT = (bf16_t*)(c.ws + WS_WCKV); t.ldk = 2048; t.ksrc0 = kb * 128; t.kdst0 = kb * 128; t.n0 = nb * 128; t.gain = IN_(I_GMEM) + kb * 128; t.dn0 = t.nrow_off + t.n0; return true; } r -= TT_C;
    if (r < TT_C) { const int kb = r / 4, nb = r % 4; t.W = IN_(I_WCV); t.N = 512; t.WT = (bf16_t*)(c.ws + WS_WCKV); t.ldk = 2048; t.ksrc0 = kb * 128; t.kdst0 = kb * 128; t.n0 = nb * 128; t.nrow_off = 512; t.gain = IN_(I_GMEM) + kb * 128; t.dn0 = t.nrow_off + t.n0; return true; } r -= TT_C;
    if (r < TT_CO) { const int kb = r / 16, nb = r % 16; t.W = IN_(I_WCO); t.N = 2048; t.WT = (bf16_t*)(c.ws + WS_WCO); t.ldk = 512; t.ksrc0 = kb * 128; t.kdst0 = kb * 128; t.n0 = nb * 128; t.gain = nullptr; t.dn0 = t.nrow_off + t.n0; return true; } r -= TT_CO;
    if (r < TT_UP) { const int kb = r / 88, nb = r % 88; t.W = IN_(I_WUP); t.N = DFF2; t.WT = (bf16_t*)(c.ws + WS_WUP); t.ldk = 2048; t.ksrc0 = kb * 128; t.kdst0 = kb * 128; t.n0 = nb * 128; t.gain = IN_(I_GFFN) + kb * 128; { const int half = nb >= 44 ? 1 : 0; t.dn0 = 256 * (nb - 44 * half) + 128 * half; } return true; } r -= TT_UP;
    if (r < TT_DN) { const int kb = r / 16, nb = r % 16; t.W = IN_(I_WDN); t.N = 2048; t.WT = (bf16_t*)(c.ws + WS_WDN); t.ldk = DFF; t.ksrc0 = kb * 128; t.kdst0 = kb * 128; t.n0 = nb * 128; t.gain = nullptr; t.dn0 = t.nrow_off + t.n0; return true; }
    return false;
}
DI void p0_load(const TItem& t, int tid, f32x4 (&buf)[8], float (&gv)[8]) {
    const int kr = tid >> 5, n4 = (tid & 31) * 4; const bool ok = t.n0 + n4 < t.N;
    const float* p = t.W + (size_t)(t.ksrc0 + kr) * t.N + t.n0 + (ok ? n4 : 0);
#pragma unroll
    for (int i = 0; i < 8; ++i) { buf[i] = *(const f32x4*)(p + (size_t)(16 * i) * t.N); gv[i] = t.gain ? t.gain[16 * i + kr] : 1.f; if (!ok) gv[i] = 0.f; }
}
DI void p0_transposes(const Ctx& c, int it_lo, int it_hi, int vb, int nvb) {
    int tid_ = c.tid; asm volatile("" : "+v"(tid_)); const int tid = tid_;
    f32x4 buf[8]; float gv[8]; TItem cur, nxt;
    int it = it_lo + vb; bool have = (it < it_hi) && p0_decode(c, it, cur);
    if (have) p0_load(cur, tid, buf, gv);
    const int kr = tid >> 5, n4 = (tid & 31) * 4, cc = tid & 15, nr = tid >> 4; int pb = 0;
    while (have) {
        const int itn = it + nvb; const bool hn = (itn < it_hi) && p0_decode(c, itn, nxt);
        LAS float* scr = (LAS float*)(c.lds + pb * 66048);
#pragma unroll
        for (int i = 0; i < 8; ++i) { LAS float* d = scr + (16 * i + kr) * 129 + n4; const f32x4 v = buf[i] * gv[i]; d[0] = v.x; d[1] = v.y; d[2] = v.z; d[3] = v.w; }
        if (hn) p0_load(nxt, tid, buf, gv);
        __syncthreads();
#pragma unroll
        for (int j = 0; j < 4; ++j) { const int n = nr + 32 * j; const LAS float* sp = scr + (8 * cc) * 129 + n;
            u32x4 o; o.x = pk2(sp[0 * 129], sp[1 * 129]); o.y = pk2(sp[2 * 129], sp[3 * 129]); o.z = pk2(sp[4 * 129], sp[5 * 129]); o.w = pk2(sp[6 * 129], sp[7 * 129]);
            *(u32x4*)(cur.WT + (size_t)(cur.dn0 + n) * cur.ldk + cur.kdst0 + 8 * cc) = o; }
        pb ^= 1; cur = nxt; it = itn; have = hn;
    }
    __syncthreads();
}
DI void norm_row_to_bf16(const float* xrow, bf16_t* orow, int lane) {
    f32x4 v[8]; float s = 0.f;
    if (xrow) {
#pragma unroll
        for (int j = 0; j < 8; ++j) { v[j] = ((const f32x4*)xrow)[lane + 64 * j]; s += (v[j].x * v[j].x + v[j].y * v[j].y) + (v[j].z * v[j].z + v[j].w * v[j].w); }
    } else {
#pragma unroll
        for (int j = 0; j < 8; ++j) v[j] = (f32x4){0.f, 0.f, 0.f, 0.f};
    }
    const float rs = rsqrtf(wave_sum(s) * (1.f / 2048.f) + EPS);
#pragma unroll
    for (int j = 0; j < 8; ++j) { u32x2 w; w.x = pk2(v[j].x * rs, v[j].y * rs); w.y = pk2(v[j].z * rs, v[j].w * rs); ((u32x2*)orow)[lane + 64 * j] = w; }
}
DI void p0_prologue(const Ctx& c) {
    const int gw = c.bid * 8 + c.wave, NGW = c.G * 8, lane = c.lane;
    bf16_t* WINT = (bf16_t*)(c.ws + WS_WIN);
    p0_transposes(c, 0, c.G == 256 ? TT_P4_START : TT_ALL, c.bid, c.G);
    { u32x4* z = (u32x4*)(WINT + (size_t)6784 * 2048); const int n16 = (DINP - 6784) * 2048 * 2 / 16;
        for (int i = c.bid * 512 + c.tid; i < n16; i += c.G * 512) z[i] = (u32x4){0u, 0u, 0u, 0u}; }
    { float* z = (float*)(c.ws + WS_SSQ); for (int i = c.bid * 512 + c.tid; i < 3 * MPAD; i += c.G * 512) z[i] = 0.f; }
    bf16_t* A0 = (bf16_t*)(c.ws + WS_A0); bf16_t* MEMN = (bf16_t*)(c.ws + WS_MEMN);
    for (int m = gw; m < MPAD + 1024; m += NGW) {
        if (m < MPAD) { const float* xr = m < MP ? IN_(I_XP) + (size_t)m * DM : (m < MTOK ? IN_(I_XS) + (size_t)(m - MP) * DM : nullptr); norm_row_to_bf16(xr, A0 + (size_t)m * DM, lane); }
        else { const int r = m - MPAD; norm_row_to_bf16(IN_(I_MEM) + (size_t)r * DM, MEMN + (size_t)r * DM, lane); }
    }
}

constexpr int SP = 136;
DI void p1b_conv(const Ctx& c) {
    const bf16_t* PROJ = (const bf16_t*)(c.ws + WS_PROJ); bf16_t* XBC = (bf16_t*)(c.ws + WS_H);
    const float* cw = IN_(I_SCW); const float* cb = IN_(I_SCB);
    const int gw = c.bid * 8 + c.wave, NGW = c.G * 8, lane = c.lane;
    for (int task = gw; task < 512 * 6; task += NGW) {
        const int seg = task / 6, c8 = (task % 6) * 64 + lane, r0 = seg * 16, tl0 = r0 & (SEQ - 1), cch = c8 * 8;
        float w[4][8], bias[8];
#pragma unroll
        for (int i = 0; i < 4; ++i) { const f32x4 a = *(const f32x4*)(cw + (size_t)i * CONVD + cch), a2 = *(const f32x4*)(cw + (size_t)i * CONVD + cch + 4);
            w[i][0] = a.x; w[i][1] = a.y; w[i][2] = a.z; w[i][3] = a.w; w[i][4] = a2.x; w[i][5] = a2.y; w[i][6] = a2.z; w[i][7] = a2.w; }
        { const f32x4 a = *(const f32x4*)(cb + cch), a2 = *(const f32x4*)(cb + cch + 4); bias[0] = a.x; bias[1] = a.y; bias[2] = a.z; bias[3] = a.w; bias[4] = a2.x; bias[5] = a2.y; bias[6] = a2.z; bias[7] = a2.w; }
        float h1[8], h2[8], h3[8];
        if (tl0 == 0) {
#pragma unroll
            for (int j = 0; j < 8; ++j) { h1[j] = 0.f; h2[j] = 0.f; h3[j] = 0.f; }
        } else { const bf16_t* p = PROJ + (size_t)(r0 - 3) * DINP + C_XBC + cch; unpack8(*(const u32x4*)p, h1); unpack8(*(const u32x4*)(p + DINP), h2); unpack8(*(const u32x4*)(p + 2 * DINP), h3); }
#pragma unroll 1
        for (int rb = 0; rb < 16; rb += 4) { u32x4 lr_[4];
#pragma unroll
          for (int r4 = 0; r4 < 4; ++r4) lr_[r4] = *(const u32x4*)(PROJ + ((size_t)r0 + rb + r4) * DINP + C_XBC + cch);
#pragma unroll
          for (int r4 = 0; r4 < 4; ++r4) { const size_t row = (size_t)r0 + rb + r4; float cur[8], o[8]; unpack8(lr_[r4], cur);
#pragma unroll
            for (int j = 0; j < 8; ++j) { o[j] = silu_f(bias[j] + w[0][j] * h1[j] + w[1][j] * h2[j] + w[2][j] * h3[j] + w[3][j] * cur[j]); h1[j] = h2[j]; h2[j] = h3[j]; h3[j] = cur[j]; }
            u32x4 q; q.x = pk2(o[0], o[1]); q.y = pk2(o[2], o[3]); q.z = pk2(o[4], o[5]); q.w = pk2(o[6], o[7]); *(u32x4*)(XBC + row * CONVD + cch) = q; } }
    }
}
template <int W> DI void ssd_causal(const LAS bf16_t* Cs, const LAS bf16_t* Bs, const LAS bf16_t* Xn, const LAS float* las, const LAS float* dts, int l, float la_l, int fr, int fq, f32x4 (&y)[2]) {
    constexpr int XP = 40;
    f32x4 cbm[8];
#pragma unroll
    for (int ni = 0; ni < 8; ++ni) cbm[ni] = (f32x4){0.f, 0.f, 0.f, 0.f};
#pragma unroll
    for (int kk = 0; kk < 4; ++kk) { __builtin_amdgcn_sched_barrier(0); const bf16x8 af = *(const LAS bf16x8*)(Cs + l * SP + kk * 32 + fq * 8);
#pragma unroll
        for (int ni = 0; ni < 8; ++ni) if (ni <= W) { const bf16x8 bf = *(const LAS bf16x8*)(Bs + (16 * ni + fr) * SP + kk * 32 + fq * 8); cbm[ni] = MFMA16(bf, af, cbm[ni]); } }
    int lim = l - 4 * fq; asm volatile("" : "+v"(lim));
#pragma unroll
    for (int ni = 0; ni < 8; ++ni) if (ni <= W) { const int s = 16 * ni + 4 * fq; const f32x4 ls = *(const LAS f32x4*)(las + s), ds = *(const LAS f32x4*)(dts + s);
#pragma unroll
        for (int j = 0; j < 4; ++j) cbm[ni][j] = (16 * ni + j <= lim) ? cbm[ni][j] * __expf(la_l - ls[j]) * ds[j] : 0.f; }
#pragma unroll
    for (int k2 = 0; k2 < 4; ++k2) if (2 * k2 <= W) { __builtin_amdgcn_sched_barrier(0); u32x4 pa; pa.x = pk2(cbm[2 * k2][0], cbm[2 * k2][1]); pa.y = pk2(cbm[2 * k2][2], cbm[2 * k2][3]); pa.z = pk2(cbm[2 * k2 + 1][0], cbm[2 * k2 + 1][1]); pa.w = pk2(cbm[2 * k2 + 1][2], cbm[2 * k2 + 1][3]);
        const bf16x8 af = __builtin_bit_cast(bf16x8, pa);
#pragma unroll
        for (int np = 0; np < 2; ++np) { const LAS bf16_t* xp = Xn + (32 * k2 + 4 * fq + (fr >> 2)) * XP + 16 * np + 4 * (fr & 3);
            y[np] = MFMA16(cat8(vtr(xp), vtr(xp + 16 * XP)), af, y[np]); } }
}
DI void ssd_prompt_unit(const Ctx& c, int unit) {
    const int b = unit >> 6, h = (unit >> 1) & 31, ph = unit & 1, g = h >> 3;
    int tid_ = c.tid; asm volatile("" : "+v"(tid_)); const int tid = tid_, lane = tid & 63, w = __builtin_amdgcn_readfirstlane(tid >> 6), fr = lane & 15, fq = lane >> 4;
    constexpr int XP = 40;
    LAS bf16_t* Cs = (LAS bf16_t*)(c.lds); LAS bf16_t* Bs = (LAS bf16_t*)(c.lds + 34816); LAS bf16_t* Xn = (LAS bf16_t*)(c.lds + 69632); LAS bf16_t* Hb = (LAS bf16_t*)(c.lds + 90112);
    LAS float* dts = (LAS float*)(c.lds + 98816); LAS float* las = (LAS float*)(c.lds + 99328); LAS float* scl = (LAS float*)(c.lds + 99840);
    const bf16_t* PROJ = (const bf16_t*)(c.ws + WS_PROJ); const bf16_t* XBC = (const bf16_t*)(c.ws + WS_H); const float* DTR = (const float*)(c.ws + WS_DT);
    bf16_t* MIX = (bf16_t*)(c.ws + WS_MIX); float* SSQS = (float*)(c.ws + WS_SSQ) + (c.dry ? 3 * MPAD : 0);
    const float av = -__expf(IN_(I_ALOG)[h]), dtb = IN_(I_DTB)[h], Dh = IN_(I_DSK)[h];
    f32x4 st[2] = {(f32x4){0.f, 0.f, 0.f, 0.f}, (f32x4){0.f, 0.f, 0.f, 0.f}};
    for (int i = tid; i < 32 * SP / 2; i += 512) ((LAS unsigned*)Hb)[i] = 0u;
    const int sx = tid >> 2, c8 = tid & 3, cb8 = tid & 15, s0 = tid >> 4;
    u32x4 xq, bq[4], cq[4]; float dtrA = 0.f, dtrB = 0.f; u32x2 zn[2], zc[2];
#define SSD_LOADS(CK) do { const size_t r0_ = (size_t)b * SEQ + (CK) * 128; xq = *(const u32x4*)(XBC + (r0_ + sx) * CONVD + h * 64 + ph * 32 + c8 * 8); \
        _Pragma("unroll") for (int i = 0; i < 4; ++i) { const bf16_t* p_ = XBC + (r0_ + s0 + 32 * i) * CONVD + 2048 + g * 128 + cb8 * 8; bq[i] = *(const u32x4*)p_; cq[i] = *(const u32x4*)(p_ + 512); } \
        if (w < 2) { dtrA = DTR[(r0_ + lane) * 32 + h]; dtrB = DTR[(r0_ + 64 + lane) * 32 + h]; } \
        _Pragma("unroll") for (int np = 0; np < 2; ++np) zn[np] = *(const u32x2*)(PROJ + (r0_ + 16 * w + fr) * DINP + C_Z + h * 64 + ph * 32 + 16 * np + 4 * fq); } while (0)
    SSD_LOADS(0);
    for (int ck = 0; ck < 16; ++ck) {
        const size_t row0 = (size_t)b * SEQ + ck * 128;
        {
            if (w < 2) {
                const float dA = softplus_f(dtrA + dtb), dB = softplus_f(dtrB + dtb);
                float sA = dA, sB = dB;
#pragma unroll
                for (int o = 1; o < 64; o <<= 1) { const float tA = __shfl_up(sA, o), tB = __shfl_up(sB, o); if (lane >= o) { sA += tA; sB += tB; } }
                const float totA = __shfl(sA, 63), tot = totA + __shfl(sB, 63);
                if (w == 0) { dts[lane] = dA; las[lane] = av * sA; scl[lane] = dA * __expf(av * (tot - sA)); }
                else { dts[64 + lane] = dB; las[64 + lane] = av * (totA + sB); scl[64 + lane] = dB * __expf(av * (tot - totA - sB)); }
            }
            *(LAS u32x4*)(Xn + sx * XP + c8 * 8) = xq;
#pragma unroll
            for (int i = 0; i < 4; ++i) { *(LAS u32x4*)(Bs + (s0 + 32 * i) * SP + cb8 * 8) = bq[i]; *(LAS u32x4*)(Cs + (s0 + 32 * i) * SP + cb8 * 8) = cq[i]; }
        }
        zc[0] = zn[0]; zc[1] = zn[1];
        __syncthreads();
        if (ck + 1 < 16) SSD_LOADS(ck + 1);
        asm volatile("" ::: "memory");
        const int l = 16 * w + fr; const float la_l = las[l];
        f32x4 y[2] = {(f32x4){0.f, 0.f, 0.f, 0.f}, (f32x4){0.f, 0.f, 0.f, 0.f}}, yi[2] = {(f32x4){0.f, 0.f, 0.f, 0.f}, (f32x4){0.f, 0.f, 0.f, 0.f}};
        switch (w) {
            case 0: ssd_causal<0>(Cs, Bs, Xn, las, dts, l, la_l, fr, fq, y); break;
            case 1: ssd_causal<1>(Cs, Bs, Xn, las, dts, l, la_l, fr, fq, y); break;
            case 2: ssd_causal<2>(Cs, Bs, Xn, las, dts, l, la_l, fr, fq, y); break;
            case 3: ssd_causal<3>(Cs, Bs, Xn, las, dts, l, la_l, fr, fq, y); break;
            case 4: ssd_causal<4>(Cs, Bs, Xn, las, dts, l, la_l, fr, fq, y); break;
            case 5: ssd_causal<5>(Cs, Bs, Xn, las, dts, l, la_l, fr, fq, y); break;
            case 6: ssd_causal<6>(Cs, Bs, Xn, las, dts, l, la_l, fr, fq, y); break;
            default: ssd_causal<7>(Cs, Bs, Xn, las, dts, l, la_l, fr, fq, y); break;
        }
#pragma unroll
        for (int kk = 0; kk < 4; ++kk) { const bf16x8 af = *(const LAS bf16x8*)(Cs + l * SP + kk * 32 + fq * 8);
#pragma unroll
            for (int np = 0; np < 2; ++np) { const bf16x8 bf = *(const LAS bf16x8*)(Hb + (16 * np + fr) * SP + kk * 32 + fq * 8); yi[np] = MFMA16(bf, af, yi[np]); } }
        {
            const float el = __expf(la_l); const size_t row = row0 + l; float sq = 0.f;
#pragma unroll
            for (int np = 0; np < 2; ++np) { const int p0 = 16 * np + 4 * fq; const u32x2 zr = zc[np];
                const u32x2 xr = *(const LAS u32x2*)(Xn + l * XP + p0);
                const float zf[4] = {bflo(zr.x), bfhi(zr.x), bflo(zr.y), bfhi(zr.y)}, xf[4] = {bflo(xr.x), bfhi(xr.x), bflo(xr.y), bfhi(xr.y)}; float o[4];
#pragma unroll
                for (int j = 0; j < 4; ++j) { float v = y[np][j] + el * yi[np][j] + Dh * xf[j]; v *= silu_f(zf[j]); o[j] = v; sq += v * v; }
                u32x2 wv; wv.x = pk2(o[0], o[1]); wv.y = pk2(o[2], o[3]); *(u32x2*)(MIX + row * DMIX + h * 64 + ph * 32 + p0) = wv; }
            sq += __shfl_xor(sq, 16); sq += __shfl_xor(sq, 32); if (fq == 0) atomicAdd(SSQS + row, sq);
        }
        {
            f32x4 sa[2] = {(f32x4){0.f, 0.f, 0.f, 0.f}, (f32x4){0.f, 0.f, 0.f, 0.f}};
#pragma unroll
            for (int kk = 0; kk < 4; ++kk) { __builtin_amdgcn_sched_barrier(0); const int sb = 32 * kk + 8 * fq;
                const LAS bf16_t* bp = Bs + (sb + (fr >> 2)) * SP + 16 * w + 4 * (fr & 3); const bf16x8 bf = cat8(vtr(bp), vtr(bp + 4 * SP));
                const f32x4 s0 = *(const LAS f32x4*)(scl + sb), s1 = *(const LAS f32x4*)(scl + sb + 4);
#pragma unroll
                for (int mi = 0; mi < 2; ++mi) { const LAS bf16_t* xp = Xn + (sb + (fr >> 2)) * XP + 16 * mi + 4 * (fr & 3); const s16x4 x0 = vtr(xp), x1 = vtr(xp + 4 * XP);
                    const u32x2 a0 = __builtin_bit_cast(u32x2, x0), a1 = __builtin_bit_cast(u32x2, x1); u32x4 q;
                    q.x = pk2(bflo(a0.x) * s0[0], bfhi(a0.x) * s0[1]); q.y = pk2(bflo(a0.y) * s0[2], bfhi(a0.y) * s0[3]); q.z = pk2(bflo(a1.x) * s1[0], bfhi(a1.x) * s1[1]); q.w = pk2(bflo(a1.y) * s1[2], bfhi(a1.y) * s1[3]);
                    sa[mi] = MFMA16(bf, __builtin_bit_cast(bf16x8, q), sa[mi]); } }
            const float ee = __expf(las[127]);
#pragma unroll
            for (int mi = 0; mi < 2; ++mi) st[mi] = st[mi] * ee + sa[mi];
        }
        __syncthreads();
#pragma unroll
        for (int mi = 0; mi < 2; ++mi) { u32x2 wv; wv.x = pk2(st[mi][0], st[mi][1]); wv.y = pk2(st[mi][2], st[mi][3]); *(LAS u32x2*)(Hb + (16 * mi + fr) * SP + 16 * w + 4 * fq) = wv; }
    }
    float* so = c.out + O_SSP;
#pragma unroll
    for (int mi = 0; mi < 2; ++mi) *(f32x4*)(so + ((size_t)(b * 32 + h) * 64 + ph * 32 + 16 * mi + fr) * 128 + 16 * w + 4 * fq) = st[mi];
    __syncthreads();
}

DI void swa_prompt_unit(const Ctx& c, int unit) {
    const int b = unit >> 6, blk = (unit >> 2) & 15, kvh = unit & 3;
    int tid_ = c.tid; asm volatile("" : "+v"(tid_)); const int tid = tid_, lane = tid & 63, w = __builtin_amdgcn_readfirstlane(tid >> 6), fr = lane & 15, fq = lane >> 4;
    constexpr int KP = 72, VP = 72;
    LAS bf16_t* Ks = (LAS bf16_t*)(c.lds); LAS bf16_t* Vn = (LAS bf16_t*)(c.lds + 36864);
    const bf16_t* PROJ = (const bf16_t*)(c.ws + WS_PROJ); bf16_t* MIX = (bf16_t*)(c.ws + WS_MIX);
    u32x4 qraw[4][2];
#pragma unroll
    for (int it = 0; it < 4; ++it) { const int combo = w * 2 + (it >> 1), mi = it & 1, gq = combo & 3, rg = combo >> 2; const size_t row = (size_t)b * SEQ + blk * 128 + 32 * rg + 16 * mi + fr;
#pragma unroll
        for (int kk = 0; kk < 2; ++kk) qraw[it][kk] = *(const u32x4*)(PROJ + row * DINP + C_Q + (kvh * 4 + gq) * 64 + kk * 32 + fq * 8); }
    {
        const int key = tid >> 1, half = tid & 1, tk = blk * 128 - 128 + key;
        const bf16_t* pr = PROJ + ((size_t)b * SEQ + (tk >= 0 ? tk : 0)) * DINP;
        const bool wout = (blk == 15 && key >= 128);
        unsigned ooff = (unsigned)(((b * 128 + (key & 127)) * 4 + kvh) * 64 + half * 32); asm volatile("" : "+v"(ooff));
        {
            float kf[32]; float sq = 0.f;
#pragma unroll
            for (int i = 0; i < 4; ++i) unpack8(*(const u32x4*)(pr + C_K + kvh * 64 + half * 32 + i * 8), kf + 8 * i);
#pragma unroll
            for (int i = 0; i < 32; ++i) sq += kf[i] * kf[i];
            sq += __shfl_xor(sq, 1); const float rs = (tk >= 0) ? rsqrtf(sq * (1.f / 64.f) + EPS) : 0.f; const float* kg = IN_(I_KG) + half * 32;
#pragma unroll
            for (int i = 0; i < 4; ++i) { const f32x4 g0 = *(const f32x4*)(kg + 8 * i), g1 = *(const f32x4*)(kg + 8 * i + 4);
                const f32x4 k0 = (f32x4){kf[8 * i], kf[8 * i + 1], kf[8 * i + 2], kf[8 * i + 3]} * g0 * rs, k1 = (f32x4){kf[8 * i + 4], kf[8 * i + 5], kf[8 * i + 6], kf[8 * i + 7]} * g1 * rs;
                u32x4 q; q.x = pk2(k0[0], k0[1]); q.y = pk2(k0[2], k0[3]); q.z = pk2(k1[0], k1[1]); q.w = pk2(k1[2], k1[3]);
                *(LAS u32x4*)(Ks + key * KP + half * 32 + i * 8) = q;
                if (wout) { float* ok = c.out + O_SKP + ooff; *(f32x4*)(ok + 8 * i) = k0; *(f32x4*)(ok + 8 * i + 4) = k1; } }
        }
        asm volatile("" ::: "memory");
        {
            float vf[32];
#pragma unroll
            for (int i = 0; i < 4; ++i) unpack8(*(const u32x4*)(pr + C_V + kvh * 64 + half * 32 + i * 8), vf + 8 * i);
            if (tk < 0) {
#pragma unroll
                for (int i = 0; i < 32; ++i) vf[i] = 0.f;
            }
#pragma unroll
            for (int i = 0; i < 4; ++i) { u32x4 q; q.x = pk2(vf[8 * i], vf[8 * i + 1]); q.y = pk2(vf[8 * i + 2], vf[8 * i + 3]); q.z = pk2(vf[8 * i + 4], vf[8 * i + 5]); q.w = pk2(vf[8 * i + 6], vf[8 * i + 7]);
                *(LAS u32x4*)(Vn + key * VP + half * 32 + i * 8) = q; }
            if (wout) { float* ov = c.out + O_SVP + ooff;
#pragma unroll
                for (int i = 0; i < 8; ++i) *(f32x4*)(ov + 4 * i) = (f32x4){vf[4 * i], vf[4 * i + 1], vf[4 * i + 2], vf[4 * i + 3]}; }
        }
    }
    __syncthreads();
#pragma unroll
    for (int it = 0; it < 4; ++it) {
        asm volatile("" ::: "memory");
        const int combo = w * 2 + (it >> 1), mi = it & 1, gq = combo & 3, rg = combo >> 2, head = kvh * 4 + gq; const float sink = IN_(I_SINK)[head];
        const int r = 16 * mi + fr; const size_t row = (size_t)b * SEQ + blk * 128 + 32 * rg + r;
        bf16x8 qf[2];
        { float f[16]; float sq = 0.f;
#pragma unroll
            for (int kk = 0; kk < 2; ++kk) unpack8(qraw[it][kk], f + 8 * kk);
#pragma unroll
            for (int i = 0; i < 16; ++i) sq += f[i] * f[i];
            sq += __shfl_xor(sq, 16); sq += __shfl_xor(sq, 32); const float rs = rsqrtf(sq * (1.f / 64.f) + EPS) * 0.125f;
#pragma unroll
            for (int kk = 0; kk < 2; ++kk) { const float* qg = IN_(I_QG) + kk * 32 + fq * 8; u32x4 q; q.x = pk2(f[8 * kk] * rs * qg[0], f[8 * kk + 1] * rs * qg[1]); q.y = pk2(f[8 * kk + 2] * rs * qg[2], f[8 * kk + 3] * rs * qg[3]);
                q.z = pk2(f[8 * kk + 4] * rs * qg[4], f[8 * kk + 5] * rs * qg[5]); q.w = pk2(f[8 * kk + 6] * rs * qg[6], f[8 * kk + 7] * rs * qg[7]); qf[kk] = __builtin_bit_cast(bf16x8, q); } }
        f32x4 S[10];
#pragma unroll
        for (int ni = 0; ni < 10; ++ni) S[ni] = (f32x4){0.f, 0.f, 0.f, 0.f};
#pragma unroll
        for (int ni = 0; ni < 10; ++ni)
#pragma unroll
            for (int kk = 0; kk < 2; ++kk) { __builtin_amdgcn_sched_barrier(0); const bf16x8 bf = *(const LAS bf16x8*)(Ks + (32 * rg + 16 * ni + fr) * KP + kk * 32 + fq * 8); S[ni] = MFMA16(bf, qf[kk], S[ni]); }
        float mx = sink;
        const int lowlim = blk > 0 ? -100000 : 128 - 32 * rg; const int lo_ = r > lowlim ? r : lowlim;
        int xoff = 4 * fq - lo_; const unsigned hi_ = (unsigned)(r + 128 - lo_); asm volatile("" : "+v"(xoff));
#pragma unroll
        for (int ni = 0; ni < 10; ++ni)
#pragma unroll
            for (int j = 0; j < 4; ++j) { const bool ok = (unsigned)(xoff + (16 * ni + j)) <= hi_;
                S[ni][j] = ok ? S[ni][j] : -1e30f; mx = fmaxf(mx, S[ni][j]); }
        mx = fmaxf(mx, __shfl_xor(mx, 16)); mx = fmaxf(mx, __shfl_xor(mx, 32));
        float sm = 0.f;
#pragma unroll
        for (int ni = 0; ni < 10; ++ni)
#pragma unroll
            for (int j = 0; j < 4; ++j) { const float p = __expf(S[ni][j] - mx); S[ni][j] = p; sm += p; }
        sm += __shfl_xor(sm, 16); sm += __shfl_xor(sm, 32); sm += __expf(sink - mx);
        const float inv = 1.f / sm;
        f32x4 O[4];
#pragma unroll
        for (int nd = 0; nd < 4; ++nd) O[nd] = (f32x4){0.f, 0.f, 0.f, 0.f};
#pragma unroll
        for (int k2 = 0; k2 < 5; ++k2) { __builtin_amdgcn_sched_barrier(0); u32x4 pa; pa.x = pk2(S[2 * k2][0], S[2 * k2][1]); pa.y = pk2(S[2 * k2][2], S[2 * k2][3]); pa.z = pk2(S[2 * k2 + 1][0], S[2 * k2 + 1][1]); pa.w = pk2(S[2 * k2 + 1][2], S[2 * k2 + 1][3]);
            const bf16x8 af = __builtin_bit_cast(bf16x8, pa);
#pragma unroll
            for (int nd = 0; nd < 4; ++nd) { const LAS bf16_t* vp = Vn + (32 * rg + 32 * k2 + 4 * fq + (fr >> 2)) * VP + 16 * nd + 4 * (fr & 3);
                O[nd] = MFMA16(cat8(vtr(vp), vtr(vp + 16 * VP)), af, O[nd]); } }
#pragma unroll
        for (int nd = 0; nd < 4; ++nd) { const f32x4 o = O[nd] * inv; u32x2 wv; wv.x = pk2(o[0], o[1]); wv.y = pk2(o[2], o[3]); *(u32x2*)(MIX + row * DMIX + 2048 + head * 64 + 16 * nd + 4 * fq) = wv; }
    }
    __syncthreads();
}

DI void swa_sample_pair(const Ctx& c, int P) {
    int tid_ = c.tid; asm volatile("" : "+v"(tid_)); const int tid = tid_, lane = tid & 63, w = __builtin_amdgcn_readfirstlane(tid >> 6);
    const int combo = 2 * P + (w >> 2), q4 = w & 3, b = combo >> 2, kvh = combo & 3;
    LAS float* qs = (LAS float*)(c.lds + w * 4096); LAS float* ps = qs + 256; LAS float* po = qs + 384; LAS float* pm = qs + 640; LAS float* psm = qs + 644;
    const bf16_t* pr = (const bf16_t*)(c.ws + WS_PROJ) + (size_t)(MP + b) * DINP; bf16_t* MIX = (bf16_t*)(c.ws + WS_MIX);
    const float* ck = IN_(I_CSK); const float* cv = IN_(I_CSV); float* ok = c.out + O_SKS; float* ov = c.out + O_SVS;
#pragma unroll
    for (int g = 0; g < 4; ++g) { const float qr = bf1(pr[C_Q + (kvh * 4 + g) * 64 + lane]); const float s2 = wave_sum(qr * qr); qs[g * 64 + lane] = qr * rsqrtf(s2 * (1.f / 64.f) + EPS) * IN_(I_QG)[lane] * 0.125f; }
    LDS_FENCE();
    const int s = 32 * q4 + (lane & 31), half = lane >> 5;
    float lg[4];
    {
        const float* kr = ck + ((size_t)(b * 128 + s) * 4 + kvh) * 64 + half * 32; f32x4 kv[8];
#pragma unroll
        for (int i = 0; i < 8; ++i) kv[i] = *(const f32x4*)(kr + 4 * i);
        if (s >= 1) { float* kw = ok + ((size_t)(b * 128 + s - 1) * 4 + kvh) * 64 + half * 32;
#pragma unroll
            for (int i = 0; i < 8; ++i) *(f32x4*)(kw + 4 * i) = kv[i]; }
#pragma unroll
        for (int g = 0; g < 4; ++g) { float a = 0.f;
#pragma unroll
            for (int i = 0; i < 8; ++i) { const f32x4 qv = *(const LAS f32x4*)(qs + g * 64 + half * 32 + 4 * i); a += (kv[i].x * qv.x + kv[i].y * qv.y) + (kv[i].z * qv.z + kv[i].w * qv.w); }
            a += __shfl_xor(a, 32); lg[g] = a; }
    }
#pragma unroll
    for (int g = 0; g < 4; ++g) { const float mx = wave_max(lg[g]); const float p = __expf(lg[g] - mx); const float sm = wave_sum(lane < 32 ? p : 0.f);
        if (lane < 32) ps[g * 32 + lane] = p; if (lane == 0) { pm[g] = mx; psm[g] = sm; } }
    LDS_FENCE();
    {
        float o[4] = {0.f, 0.f, 0.f, 0.f};
#pragma unroll 1
        for (int i0 = 0; i0 < 32; i0 += 8) { float v[8];
#pragma unroll
            for (int i = 0; i < 8; ++i) v[i] = cv[((size_t)(b * 128 + 32 * q4 + i0 + i) * 4 + kvh) * 64 + lane];
#pragma unroll
            for (int i = 0; i < 8; ++i) { const int sk = 32 * q4 + i0 + i; if (sk >= 1) ov[((size_t)(b * 128 + sk - 1) * 4 + kvh) * 64 + lane] = v[i];
#pragma unroll
                for (int g = 0; g < 4; ++g) o[g] += ps[g * 32 + i0 + i] * v[i]; } }
#pragma unroll
        for (int g = 0; g < 4; ++g) po[g * 64 + lane] = o[g];
    }
    __syncthreads();
    if (q4 == 0) {
        const float kraw = bf1(pr[C_K + kvh * 64 + lane]); const float ss = wave_sum(kraw * kraw); const float knew = kraw * rsqrtf(ss * (1.f / 64.f) + EPS) * IN_(I_KG)[lane];
        const float vnew = bf1(pr[C_V + kvh * 64 + lane]);
        ok[((size_t)(b * 128 + 127) * 4 + kvh) * 64 + lane] = knew; ov[((size_t)(b * 128 + 127) * 4 + kvh) * 64 + lane] = vnew;
#pragma unroll
        for (int g = 0; g < 4; ++g) { const float lnew = wave_sum(qs[g * 64 + lane] * knew), sink = IN_(I_SINK)[kvh * 4 + g];
            float m[4], sm[4]; float M = fmaxf(lnew, sink);
#pragma unroll
            for (int j = 0; j < 4; ++j) { const LAS float* qj = qs + j * 1024; m[j] = qj[640 + g]; sm[j] = qj[644 + g]; M = fmaxf(M, m[j]); }
            float S = __expf(lnew - M) + __expf(sink - M), o = __expf(lnew - M) * vnew;
#pragma unroll
            for (int j = 0; j < 4; ++j) { const float e = __expf(m[j] - M); S += sm[j] * e; o += (qs + j * 1024)[384 + g * 64 + lane] * e; }
            MIX[(size_t)(MP + b) * DMIX + 2048 + (kvh * 4 + g) * 64 + lane] = f2bf(o / S); }
    }
    __syncthreads();
}

DI void ssd_sample_wave(const Ctx& c, int wu) {
    int lane_ = c.lane; asm volatile("" : "+v"(lane_)); const int b = wu >> 5, h = wu & 31, g = h >> 3, lane = lane_;
    LAS float* xs = (LAS float*)(c.lds + c.wave * 4096); LAS float* Bsm = xs + 64; LAS float* Csm = xs + 192;
    const bf16_t* pr = (const bf16_t*)(c.ws + WS_PROJ) + (size_t)(MP + b) * DINP; bf16_t* MIX = (bf16_t*)(c.ws + WS_MIX);
    const float* cw = IN_(I_SCW); const float* cb = IN_(I_SCB); const float* scs = IN_(I_SSC) + (size_t)b * 3 * CONVD;
#pragma unroll
    for (int q = 0; q < 5; ++q) { const int cch = q == 0 ? h * 64 + lane : (q < 3 ? 2048 + g * 128 + (q - 1) * 64 + lane : 2560 + g * 128 + (q - 3) * 64 + lane);
        float v = cb[cch] + cw[cch] * scs[cch] + cw[CONVD + cch] * scs[CONVD + cch] + cw[2 * CONVD + cch] * scs[2 * CONVD + cch] + cw[3 * CONVD + cch] * bf1(pr[C_XBC + cch]);
        v = silu_f(v); if (q == 0) xs[lane] = v; else if (q < 3) Bsm[(q - 1) * 64 + lane] = v; else Csm[(q - 3) * 64 + lane] = v; }
    LDS_FENCE();
    const float dt = softplus_f(((const float*)(c.ws + WS_DT))[(size_t)(MP + b) * 32 + h] + IN_(I_DTB)[h]); const float dA = __expf(-dt * __expf(IN_(I_ALOG)[h])), Dh = IN_(I_DSK)[h];
    const int n4 = (lane & 31) * 4, psub = lane >> 5;
    const f32x4 Bv = *(const LAS f32x4*)(Bsm + n4), Cv = *(const LAS f32x4*)(Csm + n4);
    const float* hs = IN_(I_SS) + (size_t)(b * 32 + h) * 64 * 128; float* ho = c.out + O_SSS + (size_t)(b * 32 + h) * 64 * 128;
    float sq = 0.f;
#pragma unroll 1
    for (int it0 = 0; it0 < 32; it0 += 16) { f32x4 hv[16];
#pragma unroll
        for (int i = 0; i < 16; ++i) hv[i] = *(const f32x4*)(hs + (2 * (it0 + i) + psub) * 128 + n4);
#pragma unroll
        for (int i = 0; i < 16; ++i) { const int p = 2 * (it0 + i) + psub; const float xv = xs[p], xb = dt * xv;
            const f32x4 hn = hv[i] * dA + Bv * xb; *(f32x4*)(ho + p * 128 + n4) = hn;
            float part = (hn.x * Cv.x + hn.y * Cv.y) + (hn.z * Cv.z + hn.w * Cv.w);
#pragma unroll
            for (int o = 1; o < 32; o <<= 1) part += __shfl_xor(part, o);
            if ((lane & 31) == 0) { float yv = part + Dh * xv; yv *= silu_f(bf1(pr[C_Z + h * 64 + p])); sq += yv * yv; MIX[(size_t)(MP + b) * DMIX + h * 64 + p] = f2bf(yv); } } }
    sq = wave_sum(sq); if (lane == 0) atomicAdd((float*)(c.ws + WS_SSQ) + (c.dry ? 3 * MPAD : 0) + MP + b, sq);
    LDS_FENCE();
}

DI void p2_mixers(const Ctx& c) {
#ifndef P2SEL
#define P2SEL 15
#endif
#ifndef DRYSEL
#define DRYSEL 15
#endif
    const int sel_ = c.dry ? (DRYSEL) : (P2SEL);
    if (sel_ & 1) for (int u = c.bid; u < 256; u += c.G) ssd_prompt_unit(c, u);
    if (sel_ & 2) for (int u = c.bid; u < 256; u += c.G) swa_prompt_unit(c, u);
    const int gw = c.bid * 8 + c.wave, NGW = c.G * 8, lane = c.lane;
    if (sel_ & 4) for (int u = gw; u < 4096; u += NGW) ssd_sample_wave(c, u);
    if (sel_ & 8) for (int u = c.bid; u < 256; u += c.G) swa_sample_pair(c, u);
    if (!c.dry) for (int u = gw; u < 4096; u += NGW) { float* p = c.out + O_MKP + (size_t)u * 128; f32x2 v = ((f32x2*)p)[lane]; const float rs = rsqrtf(wave_sum(v.x * v.x + v.y * v.y) * (1.f / 128.f) + EPS);
        const f32x2 gg = ((const f32x2*)IN_(I_CKG))[lane]; v.x *= rs * gg.x; v.y *= rs * gg.y; ((f32x2*)p)[lane] = v; }
    const bf16_t* PROJ = (const bf16_t*)(c.ws + WS_PROJ);
    for (int i = c.bid * 512 + c.tid; i < NB * 3 * CONVD; i += c.G * 512) { const int b = i / (3 * CONVD), j = (i / CONVD) % 3, ch = i % CONVD; c.out[O_SCP + i] = bf1(PROJ[((size_t)b * SEQ + 2045 + j) * DINP + C_XBC + ch]); }
    for (int i = c.bid * 512 + c.tid; i < MS * 3 * CONVD; i += c.G * 512) { const int b = i / (3 * CONVD), j = (i / CONVD) % 3, ch = i % CONVD;
        c.out[O_SCS + i] = j < 2 ? IN_(I_SSC)[((size_t)b * 3 + j + 1) * CONVD + ch] : bf1(PROJ[(size_t)(MP + b) * DINP + C_XBC + ch]); }
}

DI void xattn_prompt_unit(const Ctx& c, int unit) {
    const int b = unit >> 6, head = (unit >> 4) & 3, qb = unit & 15;
    int tid_ = c.tid; asm volatile("" : "+v"(tid_)); const int tid = tid_, lane = tid & 63, w = __builtin_amdgcn_readfirstlane(tid >> 6), fr = lane & 15, fq = lane >> 4;
    constexpr int KP = 136, VP = 136;
    LAS bf16_t* Ks = (LAS bf16_t*)(c.lds); LAS bf16_t* Vn = (LAS bf16_t*)(c.lds + 69632);
    {
        const int key = tid >> 1, half = tid & 1; const float* kp = c.out + O_MKP + ((size_t)(b * 256 + key) * 4 + head) * 128 + half * 64; const float* vp = c.out + O_MVP + ((size_t)(b * 256 + key) * 4 + head) * 128 + half * 64;
#pragma unroll
        for (int i = 0; i < 8; ++i) { const f32x4 a = *(const f32x4*)(kp + 8 * i), bb = *(const f32x4*)(kp + 8 * i + 4); u32x4 q; q.x = pk2(a.x, a.y); q.y = pk2(a.z, a.w); q.z = pk2(bb.x, bb.y); q.w = pk2(bb.z, bb.w);
            *(LAS u32x4*)(Ks + key * KP + half * 64 + 8 * i) = q; }
#pragma unroll
        for (int i = 0; i < 8; ++i) { const f32x4 a = *(const f32x4*)(vp + 8 * i), bb = *(const f32x4*)(vp + 8 * i + 4); u32x4 q; q.x = pk2(a.x, a.y); q.y = pk2(a.z, a.w); q.z = pk2(bb.x, bb.y); q.w = pk2(bb.z, bb.w);
            *(LAS u32x4*)(Vn + key * VP + half * 64 + 8 * i) = q; }
    }
    __syncthreads();
    const bf16_t* QC = (const bf16_t*)(c.ws + WS_QC); bf16_t* OC = (bf16_t*)(c.ws + WS_OC);
    const size_t row = (size_t)b * SEQ + qb * 128 + 16 * w + fr;
    bf16x8 qf[4];
    { float f[32]; float sq = 0.f;
#pragma unroll
        for (int kk = 0; kk < 4; ++kk) unpack8(*(const u32x4*)(QC + row * DXA + head * 128 + kk * 32 + fq * 8), f + 8 * kk);
#pragma unroll
        for (int i = 0; i < 32; ++i) sq += f[i] * f[i];
        sq += __shfl_xor(sq, 16); sq += __shfl_xor(sq, 32); const float rs = rsqrtf(sq * (1.f / 128.f) + EPS) * 0.08838834764831845f;
#pragma unroll
        for (int kk = 0; kk < 4; ++kk) { const float* qg = IN_(I_CQG) + kk * 32 + fq * 8; u32x4 q; q.x = pk2(f[8 * kk] * rs * qg[0], f[8 * kk + 1] * rs * qg[1]); q.y = pk2(f[8 * kk + 2] * rs * qg[2], f[8 * kk + 3] * rs * qg[3]);
            q.z = pk2(f[8 * kk + 4] * rs * qg[4], f[8 * kk + 5] * rs * qg[5]); q.w = pk2(f[8 * kk + 6] * rs * qg[6], f[8 * kk + 7] * rs * qg[7]); qf[kk] = __builtin_bit_cast(bf16x8, q); } }
    f32x4 S[16];
#pragma unroll
    for (int ni = 0; ni < 16; ++ni) S[ni] = (f32x4){0.f, 0.f, 0.f, 0.f};
#pragma unroll
    for (int ni = 0; ni < 16; ++ni)
#pragma unroll
        for (int kk = 0; kk < 4; ++kk) { __builtin_amdgcn_sched_barrier(0); const bf16x8 bf = *(const LAS bf16x8*)(Ks + (16 * ni + fr) * KP + kk * 32 + fq * 8); S[ni] = MFMA16(bf, qf[kk], S[ni]); }
    float mx = -1e30f;
#pragma unroll
    for (int ni = 0; ni < 16; ++ni)
#pragma unroll
        for (int j = 0; j < 4; ++j) mx = fmaxf(mx, S[ni][j]);
    mx = fmaxf(mx, __shfl_xor(mx, 16)); mx = fmaxf(mx, __shfl_xor(mx, 32));
    float sm = 0.f;
#pragma unroll
    for (int ni = 0; ni < 16; ++ni)
#pragma unroll
        for (int j = 0; j < 4; ++j) { const float p = __expf(S[ni][j] - mx); S[ni][j] = p; sm += p; }
    sm += __shfl_xor(sm, 16); sm += __shfl_xor(sm, 32); const float inv = 1.f / sm;
    f32x4 O[8];
#pragma unroll
    for (int nd = 0; nd < 8; ++nd) O[nd] = (f32x4){0.f, 0.f, 0.f, 0.f};
#pragma unroll
    for (int k2 = 0; k2 < 8; ++k2) { __builtin_amdgcn_sched_barrier(0); u32x4 pa; pa.x = pk2(S[2 * k2][0], S[2 * k2][1]); pa.y = pk2(S[2 * k2][2], S[2 * k2][3]); pa.z = pk2(S[2 * k2 + 1][0], S[2 * k2 + 1][1]); pa.w = pk2(S[2 * k2 + 1][2], S[2 * k2 + 1][3]);
        const bf16x8 af = __builtin_bit_cast(bf16x8, pa);
#pragma unroll
        for (int nd = 0; nd < 8; ++nd) { const LAS bf16_t* vp = Vn + (32 * k2 + 4 * fq + (fr >> 2)) * VP + 16 * nd + 4 * (fr & 3);
            O[nd] = MFMA16(cat8(vtr(vp), vtr(vp + 16 * VP)), af, O[nd]); } }
#pragma unroll
    for (int nd = 0; nd < 8; ++nd) { const f32x4 o = O[nd] * inv; u32x2 wv; wv.x = pk2(o[0], o[1]); wv.y = pk2(o[2], o[3]); *(u32x2*)(OC + row * DXA + head * 128 + 16 * nd + 4 * fq) = wv; }
    __syncthreads();
}
DI void xattn_sample_pair(const Ctx& c, int P) {
    int tid_ = c.tid; asm volatile("" : "+v"(tid_)); const int tid = tid_, lane = tid & 63, w = __builtin_amdgcn_readfirstlane(tid >> 6);
    const int combo = 2 * P + (w >> 2), q4 = w & 3, b = combo >> 2, head = combo & 3;
    LAS float* qs = (LAS float*)(c.lds + w * 4096); LAS float* ps = qs + 128; LAS float* po = qs + 192; LAS float* pm = qs + 320;
    const bf16_t* QC = (const bf16_t*)(c.ws + WS_QC); bf16_t* OC = (bf16_t*)(c.ws + WS_OC);
    const unsigned qw = *(const unsigned*)(QC + (size_t)(MP + b) * DXA + head * 128 + 2 * lane); const float q0 = bflo(qw), q1 = bfhi(qw);
    const float rs = rsqrtf(wave_sum(q0 * q0 + q1 * q1) * (1.f / 128.f) + EPS) * 0.08838834764831845f; const f32x2 gg = ((const f32x2*)IN_(I_CQG))[lane];
    qs[2 * lane] = q0 * rs * gg.x; qs[2 * lane + 1] = q1 * rs * gg.y;
    LDS_FENCE();
    const int m0 = 64 * q4;
    float lg;
    { const float* kr = IN_(I_CMK) + ((size_t)(b * 256 + m0 + lane) * 4 + head) * 128; float a = 0.f;
#pragma unroll 1
        for (int d0 = 0; d0 < 32; d0 += 8) { f32x4 kv[8];
#pragma unroll
            for (int i = 0; i < 8; ++i) kv[i] = *(const f32x4*)(kr + 4 * (d0 + i));
#pragma unroll
            for (int i = 0; i < 8; ++i) { const f32x4 qv = *(const LAS f32x4*)(qs + 4 * (d0 + i)); a += (kv[i].x * qv.x + kv[i].y * qv.y) + (kv[i].z * qv.z + kv[i].w * qv.w); } }
        lg = a; }
    const float mx = wave_max(lg); const float p = __expf(lg - mx); const float sm = wave_sum(p);
    ps[lane] = p; if (lane == 0) { pm[0] = mx; pm[1] = sm; }
    LDS_FENCE();
    { float o0 = 0.f, o1 = 0.f; const float* vr = IN_(I_CMV) + ((size_t)(b * 256 + m0) * 4 + head) * 128 + 2 * lane;
#pragma unroll 1
        for (int i0 = 0; i0 < 64; i0 += 16) { f32x2 v[16];
#pragma unroll
            for (int i = 0; i < 16; ++i) v[i] = *(const f32x2*)(vr + (size_t)(i0 + i) * 512);
#pragma unroll
            for (int i = 0; i < 16; ++i) { const float pp = ps[i0 + i]; o0 += pp * v[i].x; o1 += pp * v[i].y; } }
        po[2 * lane] = o0; po[2 * lane + 1] = o1; }
    __syncthreads();
    if (q4 == 0) {
        float m[4], sm4[4]; float M = -1e30f;
#pragma unroll
        for (int j = 0; j < 4; ++j) { const LAS float* qj = qs + j * 1024; m[j] = qj[320]; sm4[j] = qj[321]; M = fmaxf(M, m[j]); }
        float S = 0.f, o0 = 0.f, o1 = 0.f;
#pragma unroll
        for (int j = 0; j < 4; ++j) { const float e = __expf(m[j] - M); S += sm4[j] * e; o0 += (qs + j * 1024)[192 + 2 * lane] * e; o1 += (qs + j * 1024)[192 + 2 * lane + 1] * e; }
        const float inv = 1.f / S;
        *(unsigned*)(OC + (size_t)(MP + b) * DXA + head * 128 + 2 * lane) = pk2(o0 * inv, o1 * inv);
    }
    __syncthreads();
}

DI void p8_convgate(const Ctx& c) {
    const bf16_t* U = (const bf16_t*)(c.ws + WS_USMP) - (size_t)MP * DFF2;
    bf16_t* H = (bf16_t*)(c.ws + WS_H);
    const float* UF = (const float*)(c.ws + WS_UF); const float* UL = (const float*)(c.ws + WS_UL);
    const float* fw = IN_(I_FCW); const float* fb = IN_(I_FCB);
    for (int i = c.bid * 512 + c.tid; i < 31 * 2 * (DFF / 4); i += c.G * 512) { const int j4 = (i % (DFF / 4)) * 4, rr = (i / (DFF / 4)) & 1, pm = 1 + i / (2 * (DFF / 4));
        if ((pm & 7) == 0) continue;
        const size_t row = (size_t)pm * 256 + rr; float o[4];
#pragma unroll
        for (int hf = 0; hf < 2; ++hf) { const int col = hf * DFF + j4;
            const f32x4 ut = *(const f32x4*)(UF + (size_t)(pm * 2 + rr) * DFF2 + col);
            const f32x4 u1 = rr ? *(const f32x4*)(UF + (size_t)(pm * 2) * DFF2 + col) : *(const f32x4*)(UL + (size_t)((pm - 1) * 2 + 1) * DFF2 + col);
            const f32x4 u2 = rr ? *(const f32x4*)(UL + (size_t)((pm - 1) * 2 + 1) * DFF2 + col) : *(const f32x4*)(UL + (size_t)((pm - 1) * 2) * DFF2 + col);
            const f32x4 cv = *(const f32x4*)(fb + col) + *(const f32x4*)(fw + col) * u2 + *(const f32x4*)(fw + DFF2 + col) * u1 + *(const f32x4*)(fw + 2 * DFF2 + col) * ut;
#pragma unroll
            for (int j = 0; j < 4; ++j) o[j] = hf == 0 ? silu_f(cv[j]) : o[j] * cv[j]; }
        u32x2 q; q.x = pk2(o[0], o[1]); q.y = pk2(o[2], o[3]); *(u32x2*)(H + row * DFF + j4) = q; }
    for (int i = c.bid * 512 + c.tid; i < MS * 704; i += c.G * 512) { const int b = i / 704, j8 = i % 704; const size_t row = MP + b; const float* st = IN_(I_SFC) + (size_t)b * 2 * DFF2; float* fo = c.out + O_FCS + (size_t)b * 2 * DFF2;
        float g3[8], v3[8], o[8]; const bf16_t* up = U + row * DFF2 + j8 * 8; unpack8(*(const u32x4*)up, g3); unpack8(*(const u32x4*)(up + DFF), v3);
#pragma unroll
        for (int j = 0; j < 8; ++j) { const int cg_ = j8 * 8 + j, cv_ = DFF + cg_; const float g1 = st[cg_], g2 = st[DFF2 + cg_], v1 = st[cv_], v2 = st[DFF2 + cv_];
            const float cgv = fb[cg_] + fw[cg_] * g1 + fw[DFF2 + cg_] * g2 + fw[2 * DFF2 + cg_] * g3[j], cvv = fb[cv_] + fw[cv_] * v1 + fw[DFF2 + cv_] * v2 + fw[2 * DFF2 + cv_] * v3[j];
            o[j] = silu_f(cgv) * cvv; fo[cg_] = g2; fo[cv_] = v2; fo[DFF2 + cg_] = g3[j]; fo[DFF2 + cv_] = v3[j]; }
        u32x4 q; q.x = pk2(o[0], o[1]); q.y = pk2(o[2], o[3]); q.z = pk2(o[4], o[5]); q.w = pk2(o[6], o[7]); *(u32x4*)(H + row * DFF + j8 * 8) = q; }
}

struct Skinny { const bf16_t* A; const bf16_t* Bt; int K; int ksplit; const float* ssq_in; const float* base; const bf16_t* baseB; float* out; bf16_t* abf; float* ssq; };
DI void skinny_tile(const Ctx& c, const Skinny& g, int ct) {
    int tid_ = c.tid; asm volatile("" : "+v"(tid_)); const int tid = tid_, lane = tid & 63, w = __builtin_amdgcn_readfirstlane(tid >> 6), fr = lane & 15, fq = lane >> 4;
    const int K = g.K, kw = K >> 3, k0 = w * kw;
    f32x4 acc[8];
#pragma unroll
    for (int mi = 0; mi < 8; ++mi) acc[mi] = (f32x4){0.f, 0.f, 0.f, 0.f};
    const bf16_t* ap = g.A + (size_t)fr * K + k0 + fq * 8; const bf16_t* bp = g.Bt + (size_t)(16 * ct + fr) * K + k0 + fq * 8;
#pragma unroll 2
    for (int ks = 0; ks < kw; ks += 32) {
        if (k0 + ks == g.ksplit && ks != 0) {
#pragma unroll
            for (int mi = 0; mi < 8; ++mi) acc[mi] = acc[mi] * rsqrtf(g.ssq_in[16 * mi + fr] * (1.f / 2048.f) + EPS);
        }
        const bf16x8 bf = *(const bf16x8*)(bp + ks);
#pragma unroll
        for (int mi = 0; mi < 8; ++mi) { const bf16x8 af = *(const bf16x8*)(ap + (size_t)mi * 16 * K + ks); acc[mi] = MFMA16(bf, af, acc[mi]); }
    }
    if (k0 + kw <= g.ksplit) {
#pragma unroll
        for (int mi = 0; mi < 8; ++mi) acc[mi] = acc[mi] * rsqrtf(g.ssq_in[16 * mi + fr] * (1.f / 2048.f) + EPS);
    }
    LAS f32x4* red = (LAS f32x4*)c.lds;
#pragma unroll
    for (int mi = 0; mi < 8; ++mi) red[(w * 8 + mi) * 64 + lane] = acc[mi];
    __syncthreads();
    f32x4 sum = (f32x4){0.f, 0.f, 0.f, 0.f};
#pragma unroll
    for (int ww = 0; ww < 8; ++ww) sum = sum + red[(ww * 8 + w) * 64 + lane];
    const int row = 16 * w + fr, col = 16 * ct + 4 * fq;
    f32x4 bs;
    if (g.baseB) { const u32x2 r = *(const u32x2*)(g.baseB + (size_t)row * DM + col); bs = (f32x4){bflo(r.x), bfhi(r.x), bflo(r.y), bfhi(r.y)}; } else bs = *(const f32x4*)(g.base + (size_t)row * DM + col);
    const f32x4 o = bs + sum;
    if (g.out) *(f32x4*)(g.out + (size_t)row * DM + col) = o;
    if (g.abf) { u32x2 wv; wv.x = pk2(o[0], o[1]); wv.y = pk2(o[2], o[3]); *(u32x2*)(g.abf + (size_t)row * DM + col) = wv;
        float sq = (o[0] * o[0] + o[1] * o[1]) + (o[2] * o[2] + o[3] * o[3]); sq += __shfl_xor(sq, 16); sq += __shfl_xor(sq, 32); if (fq == 0) atomicAdd(g.ssq + row, sq); }
    __syncthreads();
}

__global__ void __launch_bounds__(512, 2) fwd_mega(Args args) {
    extern __shared__ __attribute__((aligned(16))) unsigned char lds_raw[];
    cg::grid_group grid = cg::this_grid();
    Ctx c; c.lds = (LAS unsigned char*)lds_raw; c.tid = threadIdx.x; c.lane = c.tid & 63; c.wave = __builtin_amdgcn_readfirstlane(c.tid >> 6); c.G = gridDim.x; c.bid = blockIdx.x;
    c.in = args.in; c.out = args.out; c.ws = args.ws; c.dry = 0;
    unsigned char* ws = args.ws;
    const int lo = args.ph_lo, hi = args.ph_hi;
#ifndef PHMASK
#define PHMASK 0x3ff
#endif
#define PH(k) ((((PHMASK) >> (k)) & 1) && lo <= (k) && (k) < hi)
    volatile LAS unsigned* bst = (volatile LAS unsigned*)(c.lds + LDS_BYTES - 64);
    if (c.tid < 2) bst[c.tid] = 0u;
    __syncthreads();
    XcdBarrier xbar = xcd_barrier_post((unsigned*)(ws + WS_BAR), bst);
    if (lo > 1000) grid.sync();
#define GSYNC() xcd_barrier(xbar)
#define SYNC(k) do { if (PH(k) && PH((k) + 1)) GSYNC(); } while (0)
#ifndef REPEAT_MASK
#define REPEAT_MASK 0
#endif
#define REP(k) (((REPEAT_MASK) >> (k)) & 1)
    float* SSQ = (float*)(ws + WS_SSQ);
    if (PH(0)) p0_prologue(c);
    if (REP(0)) { GSYNC(); p0_prologue(c); }
    SYNC(0);
    if (PH(1)) {
        { pg8::Gemm g{(const bf16_t*)(ws + WS_A0), (const bf16_t*)(ws + WS_WIN), MPAD, DINP, 2048}; pg8::StaticOrder S; S.init(MPAD, DINP, c.G, c.bid);
            EpiProj E{(bf16_t*)(ws + WS_PROJ), (float*)(ws + WS_DT), 0}; pg8::gemm_phase(c.lds, g, S, E); }
        { pg8::Gemm g{(const bf16_t*)(ws + WS_MEMN), (const bf16_t*)(ws + WS_WCKV), 1024, 1024, 2048}; pg8::StaticOrder S; S.init(1024, 1024, c.G, c.G - 1 - c.bid);
            EpiMem E{c.out + O_MKP, c.out + O_MVP, 0}; pg8::gemm_phase(c.lds, g, S, E); }
    }
    SYNC(1);
    if (PH(2)) { p1b_conv(c); GSYNC(); }
    if (PH(2)) p2_mixers(c);
    if (REP(2)) { GSYNC(); c.dry = 1; p2_mixers(c); c.dry = 0; }
    SYNC(2);
    if (PH(3)) { pg8::Gemm g{(const bf16_t*)(ws + WS_MIX), (const bf16_t*)(ws + WS_WOUT), MP, 2048, 3072}; pg8::StaticOrder S; S.init(MP, 2048, c.G, c.bid);
        EpiRes<true> E{IN_(I_XP), IN_(I_XS), nullptr, nullptr, nullptr, (bf16_t*)(ws + WS_A0), SSQ + MPAD, SSQ, 32}; pg8::gemm_phase(c.lds, g, S, E);
        const Skinny sk{(const bf16_t*)(ws + WS_MIX) + (size_t)MP * DMIX, (const bf16_t*)(ws + WS_WOUT), 3072, 2048, SSQ + MP, IN_(I_XS), nullptr, nullptr, (bf16_t*)(ws + WS_A0) + (size_t)MP * DM, SSQ + MPAD + MP};
        for (int t = c.bid; t < 256; t += c.G) if ((t & 1) == 0) skinny_tile(c, sk, t >> 1); }
    SYNC(3);
    if (PH(4)) { pg8::Gemm g{(const bf16_t*)(ws + WS_A0), (const bf16_t*)(ws + WS_WCQ), MPAD, 512, 2048}; pg8::StaticOrder S; S.init(MPAD, 512, c.G, c.bid);
        EpiScale E{(bf16_t*)(ws + WS_QC), DXA, SSQ + MPAD, 0}; pg8::gemm_phase(c.lds, g, S, E);
        constexpr int NT3 = (MPAD / 256) * 2;
        if (c.G == 256 && c.bid >= NT3) p0_transposes(c, TT_P4_START, TT_ALL, c.bid - NT3, c.G - NT3); }
    SYNC(4);
    for (int rep = 0; rep < 1 + REP(5); ++rep) if (PH(5)) {
        if (rep) GSYNC();
        for (int u = c.bid; u < 256; u += c.G) xattn_prompt_unit(c, u);
        for (int u = c.bid; u < 256; u += c.G) xattn_sample_pair(c, u);
    }
    SYNC(5);
    if (PH(6)) { pg8::Gemm g{(const bf16_t*)(ws + WS_OC), (const bf16_t*)(ws + WS_WCO), MP, 2048, 512}; pg8::StaticOrder S; S.init(MP, 2048, c.G, c.bid);
        bf16_t* XB = (bf16_t*)(ws + WS_A0);
        EpiRes<false> E{nullptr, nullptr, XB, nullptr, nullptr, XB, SSQ + 2 * MPAD, nullptr, 0}; pg8::gemm_phase(c.lds, g, S, E);
        const Skinny sk{(const bf16_t*)(ws + WS_OC) + (size_t)MP * DXA, (const bf16_t*)(ws + WS_WCO), 512, -1, nullptr, nullptr, XB + (size_t)MP * DM, nullptr, XB + (size_t)MP * DM, SSQ + 2 * MPAD + MP};
        for (int t = c.bid; t < 256; t += c.G) if ((t & 1) == 0) skinny_tile(c, sk, t >> 1); }
    SYNC(6);
    if (PH(7)) { pg8::Gemm g{(const bf16_t*)(ws + WS_A0), (const bf16_t*)(ws + WS_WUP), MPAD, DFF2, 2048}; pg8::StaticOrder S; S.init(MPAD, DFF2, c.G, c.bid);
        EpiGate E{(bf16_t*)(ws + WS_H), SSQ + 2 * MPAD, IN_(I_FCW), IN_(I_FCB), (float*)(ws + WS_UF), (float*)(ws + WS_UL), (bf16_t*)(ws + WS_USMP), c.out + O_FCP, (LAS float*)(c.lds + 131072), 0}; pg8::gemm_phase(c.lds, g, S, E); }
    SYNC(7);
    if (PH(8)) p8_convgate(c);
    if (REP(8)) { GSYNC(); p8_convgate(c); }
    SYNC(8);
#ifdef EXTRA_SYNCS
    for (int i = 0; i < EXTRA_SYNCS; ++i) GSYNC();
#endif
    if (PH(9)) { pg8::Gemm g{(const bf16_t*)(ws + WS_H), (const bf16_t*)(ws + WS_WDN), MP, 2048, DFF}; pg8::StaticOrder S; S.init(MP, 2048, c.G, c.bid);
        const bf16_t* XB = (const bf16_t*)(ws + WS_A0);
        EpiRes<false> E{nullptr, nullptr, XB, c.out + O_Y, c.out + O_YS, nullptr, nullptr, nullptr, 0}; pg8::gemm_phase(c.lds, g, S, E);
        const Skinny sk{(const bf16_t*)(ws + WS_H) + (size_t)MP * DFF, (const bf16_t*)(ws + WS_WDN), DFF, -1, nullptr, nullptr, XB + (size_t)MP * DM, c.out + O_YS, nullptr, nullptr};
        for (int t = c.bid; t < 256; t += c.G) if ((t & 1) == 0) skinny_tile(c, sk, t >> 1); }
}

extern "C" void kernel_launch(void* const* d_in, const int* in_sizes, int n_in, void* d_out, int out_size, void* d_ws, size_t ws_size, hipStream_t stream) {
    static int grid = 0;
    if (grid == 0) {
        if (n_in != 35 || (size_t)out_size != O_END || ws_size < WS_END) { fprintf(stderr, "kernel_launch: unexpected shapes n_in %d out %d ws %zu (need %zu)\n", n_in, out_size, ws_size, (size_t)WS_END); grid = -1; return; }
        int dev = 0, cus = 0, per_cu = 0;
        hipGetDevice(&dev);
        hipDeviceGetAttribute(&cus, hipDeviceAttributeMultiprocessorCount, dev);
        hipFuncSetAttribute((const void*)fwd_mega, hipFuncAttributeMaxDynamicSharedMemorySize, LDS_BYTES);
        hipOccupancyMaxActiveBlocksPerMultiprocessor(&per_cu, (const void*)fwd_mega, 512, LDS_BYTES);
        if (per_cu < 1) fprintf(stderr, "kernel_launch: occupancy query says %d blocks/CU\n", per_cu);
        grid = cus;
    }
    if (grid < 0) return;
    if (hipMemsetAsync((char*)d_ws + WS_BAR, 0, WS_BAR_BYTES, stream) != hipSuccess) { fprintf(stderr, "kernel_launch: hipMemsetAsync failed\n"); return; }
    Args a{};
    for (int i = 0; i < 35; ++i) a.in[i] = (const float*)d_in[i];
    a.out = (float*)d_out; a.ws = (unsigned char*)d_ws; a.ph_lo = 0; a.ph_hi = 10;
    void* args[] = {&a};
    hipError_t e = hipLaunchCooperativeKernel((const void*)fwd_mega, dim3(grid), dim3(512), args, LDS_BYTES, stream);
    if (e != hipSuccess) fprintf(stderr, "cooperative launch failed: %s (grid %d)\n", hipGetErrorString(e), grid);
}
```

```cpp
#include <hip/hip_runtime.h>
#include <hip/hip_cooperative_groups.h>
#include <cstdio>
#include <cstdint>
namespace cg = cooperative_groups;

#define DI __device__ __forceinline__
#define LAS __attribute__((address_space(3)))
typedef unsigned short bf16_t;
typedef short bf16x8 __attribute__((ext_vector_type(8)));
typedef short s16x4 __attribute__((ext_vector_type(4)));
typedef float f32x4 __attribute__((ext_vector_type(4)));
typedef float f32x2 __attribute__((ext_vector_type(2)));
typedef unsigned u32x4 __attribute__((ext_vector_type(4)));
typedef unsigned u32x2 __attribute__((ext_vector_type(2)));
typedef __bf16 bf16x2_t __attribute__((ext_vector_type(2)));

DI unsigned pk2(float lo, float hi) { f32x2 v = {lo, hi}; bf16x2_t b = __builtin_convertvector(v, bf16x2_t); return __builtin_bit_cast(unsigned, b); }
DI float bflo(unsigned w) { return __uint_as_float(w << 16); }
DI float bfhi(unsigned w) { return __uint_as_float(w & 0xffff0000u); }
DI float bf1(bf16_t h) { return __uint_as_float(((unsigned)h) << 16); }
DI bf16_t f2bf(float f) { return (bf16_t)(pk2(f, 0.f) & 0xffffu); }
DI void unpack8(u32x4 r, float* o) { o[0] = bflo(r.x); o[1] = bfhi(r.x); o[2] = bflo(r.y); o[3] = bfhi(r.y); o[4] = bflo(r.z); o[5] = bfhi(r.z); o[6] = bflo(r.w); o[7] = bfhi(r.w); }
DI float wave_sum(float v) {
#pragma unroll
    for (int o = 1; o < 64; o <<= 1) v += __shfl_xor(v, o);
    return v;
}
DI float wave_max(float v) {
#pragma unroll
    for (int o = 1; o < 64; o <<= 1) v = fmaxf(v, __shfl_xor(v, o));
    return v;
}
DI float silu_f(float x) { return x / (1.f + __expf(-x)); }
DI float softplus_f(float x) { return x > 20.f ? x : log1pf(__expf(x)); }
#define MFMA16(a, b, c) __builtin_amdgcn_mfma_f32_16x16x32_bf16((a), (b), (c), 0, 0, 0)
#define LDS_FENCE() asm volatile("s_waitcnt lgkmcnt(0)" ::: "memory")
typedef short v4i16_t __attribute__((ext_vector_type(4)));
DI s16x4 vtr(const LAS bf16_t* p) { return __builtin_bit_cast(s16x4, __builtin_amdgcn_ds_read_tr16_b64_v4i16((LAS v4i16_t*)p)); }
DI bf16x8 cat8(s16x4 lo, s16x4 hi) { return __builtin_shufflevector(lo, hi, 0, 1, 2, 3, 4, 5, 6, 7); }

constexpr int DM = 2048, MP = 8192, MS = 128, MTOK = MP + MS, MPAD = 8448, SEQ = 2048, NB = 4;
constexpr int DIN = 6688, DINP = 6912, DMIX = 3072, DXA = 512, DFF = 5632, DFF2 = 11264, CONVD = 3072;
constexpr int C_Q = 0, C_K = 1024, C_V = 1280, C_Z = 1536, C_XBC = 3584, C_DT = 6656;
constexpr float EPS = 1e-6f;
constexpr size_t O_Y = 0, O_YS = O_Y + (size_t)MP * DM, O_SKP = O_YS + (size_t)MS * DM, O_SVP = O_SKP + 131072, O_SKS = O_SVP + 131072,
    O_SVS = O_SKS + 4194304, O_SCP = O_SVS + 4194304, O_SCS = O_SCP + 36864, O_SSP = O_SCS + 1179648, O_SSS = O_SSP + 1048576,
    O_MKP = O_SSS + 33554432, O_MVP = O_MKP + 524288, O_FCP = O_MVP + 524288, O_FCS = O_FCP + 90112, O_END = O_FCS + 2883584;
constexpr size_t MiB = 1u << 20;
constexpr size_t WS_SSQ = 0;
constexpr size_t WS_BAR = 512 * 1024, WS_BAR_BYTES = 16384;
constexpr size_t WS_WIN = 1 * MiB;
constexpr size_t WS_WOUT = WS_WIN + 27 * MiB;
constexpr size_t WS_WCQ = WS_WOUT + 12 * MiB;
constexpr size_t WS_WCKV = WS_WCQ + 2 * MiB;
constexpr size_t WS_WCO = WS_WCKV + 4 * MiB;
constexpr size_t WS_WUP = WS_WCO + 2 * MiB;
constexpr size_t WS_WDN = WS_WUP + 44 * MiB;
constexpr size_t WS_A0 = WS_WDN + 22 * MiB;
constexpr size_t WS_MEMN = WS_A0 + 33 * MiB;
constexpr size_t WS_X1 = WS_MEMN + 4 * MiB;
constexpr size_t WS_QC = WS_X1 + 66 * MiB;
constexpr size_t WS_OC = WS_QC + 9 * MiB;
constexpr size_t WS_DT = WS_OC + 9 * MiB;
constexpr size_t WS_H = WS_DT + 2 * MiB;
constexpr size_t WS_R1 = WS_H + 91 * MiB;
constexpr size_t WS_PROJ = WS_R1, WS_MIX = WS_R1 + 112 * MiB, WS_U = WS_R1;
constexpr size_t WS_UF = WS_R1, WS_UL = WS_R1 + 4 * MiB, WS_USMP = WS_R1 + 8 * MiB;
constexpr size_t WS_END = WS_R1 + 182 * MiB;
constexpr int LDS_BYTES = 147456;

namespace pg8 {
constexpr int BM = 256, BK = 64, HALF = 128, HTB = HALF * BK * 2, STAGE_BYTES = 8 * HTB, NXCD = 8, WGM = 8;
__host__ __device__ __forceinline__ int lds_byte(int r, int c) { const int st = (r >> 4) * 2 + (c >> 5), rr = r & 15, cc = c & 31, ob = rr * 64 + cc * 2; return st * 1024 + (ob ^ (((ob >> 9) & 1) << 5)); }
__host__ __device__ __forceinline__ void stage_rc(int b, int& R, int& C) { const int st = b / 1024, sb = b % 1024, swz = sb ^ (((sb >> 9) & 1) << 5); R = (st >> 1) * 16 + swz / 64; C = (st & 1) * 32 + (swz % 64) / 2; }
__host__ __device__ __forceinline__ int perm32(int rho) { const int n = rho >> 4, i = rho & 15; return 8 * (i >> 2) + 4 * n + (i & 3); }
struct Unit { int pm, pn; };
struct Gemm { const bf16_t* A; const bf16_t* Bt; int M, N, K; };
struct StaticOrder {
    int nM, nN, nwg, G, c;
    __host__ __device__ void init(int M, int N, int G_, int c_) { nM = M / BM; nN = N / BM; nwg = nM * nN; G = G_; c = c_; }
    __host__ __device__ bool next(int i, Unit& u) const {
        const long L = (long)i * G + c; if (L >= nwg) return false;
        int wgid = (int)L; { const int q = nwg / NXCD, r = nwg % NXCD, xcd = wgid % NXCD, off = wgid / NXCD; wgid = (xcd < r ? xcd * (q + 1) : r * (q + 1) + (xcd - r) * q) + off; }
        const int nig = WGM * nN, gid = wgid / nig, fm = gid * WGM, gsz = (nM - fm) < WGM ? (nM - fm) : WGM;
        u.pm = fm + ((wgid % nig) % gsz); u.pn = (wgid % nig) / gsz; return true;
    }
};
template <class Epi, class Sched>
__device__ __forceinline__ void gemm_phase(LAS unsigned char* lds, const Gemm g, const Sched& S, const Epi& E) {
    const int tid = threadIdx.x, wid = __builtin_amdgcn_readfirstlane(tid >> 6), lane = tid & 63, wr = wid >> 2, wc = wid & 3, fr = lane & 15, fq = lane >> 4;
    const int K = g.K, nt = K / BK;
    unsigned voffA[2], voffB[2];
#pragma unroll
    for (int i = 0; i < 2; ++i) { int R, C; stage_rc(tid * 16 + i * 8192, R, C); const int Rb = Epi::PERM ? ((R & ~31) + perm32(R & 31)) : R;
        voffA[i] = (unsigned)(R * K + C) * 2u; voffB[i] = (unsigned)(Rb * K + C) * 2u; }
    const size_t kstep = (size_t)(BK * 2);
    const size_t hstep = (size_t)HALF * K * 2;
    const size_t tstep = 2 * hstep;
    const unsigned ldsw = (unsigned)wid * 1024u;
    const int aoff = lds_byte(wr * 64 + fr, fq * 8), boff = lds_byte(wc * 32 + fr, fq * 8);
#define PG8_SA(b, h) (((b) * 2 + (h)) * HTB)
#define PG8_SB(b, h) ((4 + (b) * 2 + (h)) * HTB)
#define PG8_STAGE(bufoff, gbase, voff) do { _Pragma("unroll") for (int _i = 0; _i < 2; ++_i) \
        __builtin_amdgcn_global_load_lds((const unsigned*)((const char*)(gbase) + (voff)[_i]), (LAS unsigned*)(lds + (bufoff) + ldsw + _i * 8192), 16, 0, 0); } while (0)
#define PG8_LDA(dst, b, h) do { _Pragma("unroll") for (int m = 0; m < 4; ++m) _Pragma("unroll") for (int k = 0; k < 2; ++k) dst[m][k] = *(const LAS bf16x8*)(lds + PG8_SA(b, h) + aoff + m * 2048 + k * 1024); } while (0)
#define PG8_LDB(dst, b, h) do { _Pragma("unroll") for (int n = 0; n < 2; ++n) _Pragma("unroll") for (int k = 0; k < 2; ++k) dst[n][k] = *(const LAS bf16x8*)(lds + PG8_SB(b, h) + boff + n * 2048 + k * 1024); } while (0)
#define PG8_MMA(ai, bj, At, Bt) do { __builtin_amdgcn_s_setprio(1); _Pragma("unroll") for (int m = 0; m < 4; ++m) _Pragma("unroll") for (int n = 0; n < 2; ++n) _Pragma("unroll") for (int k = 0; k < 2; ++k) \
        acc[ai][bj][m][n] = Epi::SWAP ? __builtin_amdgcn_mfma_f32_16x16x32_bf16(At[m][k], Bt[n][k], acc[ai][bj][m][n], 0, 0, 0) : __builtin_amdgcn_mfma_f32_16x16x32_bf16(Bt[n][k], At[m][k], acc[ai][bj][m][n], 0, 0, 0); __builtin_amdgcn_s_setprio(0); } while (0)
#define PG8_WAIT_V(n) asm volatile("s_waitcnt vmcnt(" #n ")" ::: "memory")
#define PG8_WAIT_L(n) asm volatile("s_waitcnt lgkmcnt(" #n ")" ::: "memory")
#define PG8_BAR __builtin_amdgcn_s_barrier()
#define PG8_SCHED __builtin_amdgcn_sched_barrier(0)
    Unit cur, nxt; int ui = 0;
    if (!S.next(0, cur)) return;
    f32x4 acc[2][2][4][2];
#pragma unroll
    for (int a = 0; a < 2; ++a)
#pragma unroll
        for (int b = 0; b < 2; ++b)
#pragma unroll
            for (int m = 0; m < 4; ++m)
#pragma unroll
                for (int n = 0; n < 2; ++n) acc[a][b][m][n] = (f32x4){0.f, 0.f, 0.f, 0.f};
    bf16x8 At[4][2], B0[2][2], B1[2][2];
    const char* cA = (const char*)g.A + (size_t)cur.pm * tstep; const char* cB = (const char*)g.Bt + (size_t)cur.pn * tstep;
    PG8_STAGE(PG8_SB(0, 0), cB, voffB); PG8_STAGE(PG8_SB(0, 1), cB + hstep, voffB); PG8_STAGE(PG8_SA(0, 0), cA, voffA); PG8_STAGE(PG8_SA(0, 1), cA + hstep, voffA);
    if (wr == 1) PG8_BAR;
    PG8_WAIT_V(2); PG8_BAR;
    PG8_STAGE(PG8_SB(1, 0), cB + kstep, voffB); PG8_STAGE(PG8_SA(1, 0), cA + kstep, voffA); PG8_STAGE(PG8_SB(1, 1), cB + hstep + kstep, voffB);
    PG8_WAIT_V(6); PG8_BAR;
    for (;;) {
        const bool has_next = S.next(ui + 1, nxt);
        const char* nA = has_next ? (const char*)g.A + (size_t)nxt.pm * tstep : cA; const char* nB = has_next ? (const char*)g.Bt + (size_t)nxt.pn * tstep : cB;
        for (int t = 0; t < nt; t += 2) {
            const bool last = (t == nt - 2);
            const char* a1 = cA + (size_t)(t + 1) * kstep;
            const char* a2 = last ? nA : cA + (size_t)(t + 2) * kstep; const char* b2 = last ? nB : cB + (size_t)(t + 2) * kstep;
            const char* a3 = a2 + kstep; const char* b3 = b2 + kstep;
            if constexpr (Epi::MID) { if (t == E.tsplit) E.midscale(acc, cur, wr, fr); }
            PG8_LDB(B0, 0, 0); PG8_LDB(B1, 0, 1); PG8_SCHED; PG8_LDA(At, 0, 0); PG8_STAGE(PG8_SA(1, 1), a1 + hstep, voffA);
            PG8_WAIT_V(8); PG8_WAIT_L(0); PG8_BAR; PG8_MMA(0, 0, At, B0); PG8_MMA(0, 1, At, B1); PG8_BAR; PG8_SCHED;
            PG8_LDA(At, 0, 1); PG8_STAGE(PG8_SB(0, 0), b2, voffB); PG8_STAGE(PG8_SB(0, 1), b2 + hstep, voffB); PG8_STAGE(PG8_SA(0, 0), a2, voffA);
            PG8_WAIT_V(8); PG8_WAIT_L(0); PG8_BAR; PG8_MMA(1, 0, At, B0); PG8_MMA(1, 1, At, B1); PG8_BAR; PG8_SCHED;
            PG8_LDB(B0, 1, 0); PG8_LDB(B1, 1, 1); PG8_SCHED; PG8_LDA(At, 1, 0); PG8_STAGE(PG8_SA(0, 1), a2 + hstep, voffA);
            PG8_WAIT_V(8); PG8_WAIT_L(0); PG8_BAR; PG8_MMA(0, 0, At, B0); PG8_MMA(0, 1, At, B1); PG8_BAR; PG8_SCHED;
            PG8_LDA(At, 1, 1); PG8_STAGE(PG8_SB(1, 0), b3, voffB); PG8_STAGE(PG8_SB(1, 1), b3 + hstep, voffB); PG8_STAGE(PG8_SA(1, 0), a3, voffA);
            PG8_WAIT_V(8); PG8_WAIT_L(0); PG8_BAR; PG8_MMA(1, 0, At, B0); PG8_MMA(1, 1, At, B1); PG8_BAR; PG8_SCHED;
        }
        if (wr == 0) PG8_BAR;
        E(acc, cur, wr, wc, fr, fq);
        if (!has_next) break;
#pragma unroll
        for (int a = 0; a < 2; ++a)
#pragma unroll
            for (int b = 0; b < 2; ++b)
#pragma unroll
                for (int m = 0; m < 4; ++m)
#pragma unroll
                    for (int n = 0; n < 2; ++n) acc[a][b][m][n] = (f32x4){0.f, 0.f, 0.f, 0.f};
        cur = nxt; cA = nA; cB = nB; ++ui;
        if (wr == 1) PG8_BAR;
    }
    PG8_WAIT_V(0);
    PG8_BAR;
#undef PG8_SA
#undef PG8_SB
#undef PG8_STAGE
#undef PG8_LDA
#undef PG8_LDB
#undef PG8_MMA
#undef PG8_WAIT_V
#undef PG8_WAIT_L
#undef PG8_BAR
#undef PG8_SCHED
}
}
using pg8::Unit;
typedef f32x4 Acc[2][2][4][2];

struct EpiProj {
    static constexpr bool PERM = true, MID = false, SWAP = false; bf16_t* O; float* dt; int tsplit;
    DI void midscale(Acc&, const Unit&, int, int) const {}
    DI void operator()(const Acc& acc, const Unit& u, int wr, int wc, int fr, int fq) const {
        const int row0 = u.pm * 256 + wr * 64 + fr, col0 = u.pn * 256 + wc * 32 + 8 * fq;
#pragma unroll
        for (int ai = 0; ai < 2; ++ai)
#pragma unroll
            for (int m = 0; m < 4; ++m) { const int row = row0 + ai * 128 + m * 16; bf16_t* rowp = O + (size_t)row * DINP + col0;
#pragma unroll
                for (int bj = 0; bj < 2; ++bj) { const f32x4 v0 = acc[ai][bj][m][0], v1 = acc[ai][bj][m][1]; u32x4 w; w.x = pk2(v0[0], v0[1]); w.y = pk2(v0[2], v0[3]); w.z = pk2(v1[0], v1[1]); w.w = pk2(v1[2], v1[3]);
                    *(u32x4*)(rowp + bj * 128) = w; }
                if (u.pn == 26 && wc == 0) { float* d = dt + (size_t)row * 32 + 8 * fq; *(f32x4*)d = acc[ai][0][m][0]; *(f32x4*)(d + 4) = acc[ai][0][m][1]; } }
    }
};
struct EpiMem {
    static constexpr bool PERM = false, MID = false, SWAP = false; float* outK; float* outV; int tsplit;
    DI void midscale(Acc&, const Unit&, int, int) const {}
    DI void operator()(const Acc& acc, const Unit& u, int wr, int wc, int fr, int fq) const {
        float* base = (u.pn < 2) ? outK : outV; const int colt = (u.pn & 1) * 256 + wc * 32 + 4 * fq;
#pragma unroll
        for (int ai = 0; ai < 2; ++ai)
#pragma unroll
            for (int m = 0; m < 4; ++m) { const int row = u.pm * 256 + ai * 128 + wr * 64 + m * 16 + fr;
#pragma unroll
                for (int bj = 0; bj < 2; ++bj)
#pragma unroll
                    for (int n = 0; n < 2; ++n) *(f32x4*)(base + (size_t)row * 512 + colt + bj * 128 + n * 16) = acc[ai][bj][m][n]; }
    }
};
template <bool MIDS> struct EpiRes {
    static constexpr bool PERM = false, MID = MIDS, SWAP = false;
    const float* baseP; const float* baseS; const bf16_t* baseB; float* outP; float* outS; bf16_t* abf; float* ssq; const float* ssq_in; int tsplit;
    DI void midscale(Acc& acc, const Unit& u, int wr, int fr) const {
        int rbase = u.pm * 256 + wr * 64 + fr; asm volatile("" : "+v"(rbase));
#pragma unroll
        for (int ai = 0; ai < 2; ++ai)
#pragma unroll
            for (int m = 0; m < 4; ++m) { const int row = rbase + ai * 128 + m * 16; const float s = rsqrtf(ssq_in[row] * (1.f / 2048.f) + EPS);
#pragma unroll
                for (int bj = 0; bj < 2; ++bj)
#pragma unroll
                    for (int n = 0; n < 2; ++n) acc[ai][bj][m][n] = acc[ai][bj][m][n] * s; }
    }
    DI void operator()(const Acc& acc, const Unit& u, int wr, int wc, int fr, int fq) const {
        const int col0 = u.pn * 256 + wc * 32 + 4 * fq;
#pragma unroll
        for (int ai = 0; ai < 2; ++ai)
#pragma unroll
            for (int m = 0; m < 4; ++m) { const int row = u.pm * 256 + ai * 128 + wr * 64 + m * 16 + fr;
                if (row < MTOK) {
                    const float* bp = baseB ? nullptr : (row < MP ? baseP + (size_t)row * DM : baseS + (size_t)(row - MP) * DM);
                    float* op = outP ? (row < MP ? outP + (size_t)row * DM : outS + (size_t)(row - MP) * DM) : nullptr;
                    float sq = 0.f;
#pragma unroll
                    for (int bj = 0; bj < 2; ++bj)
#pragma unroll
                        for (int n = 0; n < 2; ++n) { const int c = col0 + bj * 128 + n * 16; f32x4 bs;
                            if (baseB) { const u32x2 r = *(const u32x2*)(baseB + (size_t)row * DM + c); bs = (f32x4){bflo(r.x), bfhi(r.x), bflo(r.y), bfhi(r.y)}; } else bs = *(const f32x4*)(bp + c);
                            const f32x4 o = bs + acc[ai][bj][m][n]; if (op) *(f32x4*)(op + c) = o;
                            if (abf) { u32x2 w; w.x = pk2(o[0], o[1]); w.y = pk2(o[2], o[3]); *(u32x2*)(abf + (size_t)row * DM + c) = w; sq += (o[0] * o[0] + o[1] * o[1]) + (o[2] * o[2] + o[3] * o[3]); } }
                    if (abf) { sq += __shfl_xor(sq, 16); sq += __shfl_xor(sq, 32); if (fq == 0) atomicAdd(ssq + row, sq); }
                }
                asm volatile("" ::: "memory"); }
    }
};
struct EpiScale {
    static constexpr bool PERM = true, MID = false, SWAP = false; bf16_t* O; int ldc; const float* ssq_in; int tsplit;
    DI void midscale(Acc&, const Unit&, int, int) const {}
    DI void operator()(const Acc& acc, const Unit& u, int wr, int wc, int fr, int fq) const {
        const int row0 = u.pm * 256 + wr * 64 + fr, col0 = u.pn * 256 + wc * 32 + 8 * fq;
#pragma unroll
        for (int ai = 0; ai < 2; ++ai)
#pragma unroll
            for (int m = 0; m < 4; ++m) { const int row = row0 + ai * 128 + m * 16; bf16_t* rowp = O + (size_t)row * ldc + col0; const float s = rsqrtf(ssq_in[row] * (1.f / 2048.f) + EPS);
#pragma unroll
                for (int bj = 0; bj < 2; ++bj) { const f32x4 v0 = acc[ai][bj][m][0] * s, v1 = acc[ai][bj][m][1] * s; u32x4 w; w.x = pk2(v0[0], v0[1]); w.y = pk2(v0[2], v0[3]); w.z = pk2(v1[0], v1[1]); w.w = pk2(v1[2], v1[3]);
                    *(u32x4*)(rowp + bj * 128) = w; } }
    }
};

struct EpiGate {
    static constexpr bool PERM = false, MID = false, SWAP = true;
    bf16_t* H; const float* ssq_in; const float* fw; const float* fb; float* UF; float* UL; bf16_t* USMP; float* fcp; LAS float* ex; int tsplit;
    DI void midscale(Acc&, const Unit&, int, int) const {}
    DI void operator()(const Acc& acc, const Unit& u, int wr, int wc, int fr_in, int fq_in) const {
        int fr = fr_in, fq = fq_in; asm volatile("" : "+v"(fr), "+v"(fq));
        const int w = wr * 4 + wc, lane = fq * 16 + fr;
        const int rowq = u.pm * 256 + wr * 64 + 4 * fq;
        const int chan = u.pn * 128 + wc * 32 + fr;
        if (u.pm == 32) {
#pragma unroll
            for (int m = 0; m < 4; ++m) { const int rl = wr * 64 + 16 * m + 4 * fq; const f32x4 sq = *(const f32x4*)(ssq_in + MP + rl);
#pragma unroll
                for (int jj = 0; jj < 4; ++jj) { const float rsv = rsqrtf(sq[jj] * (1.f / 2048.f) + EPS);
#pragma unroll
                    for (int bj = 0; bj < 2; ++bj)
#pragma unroll
                        for (int n = 0; n < 2; ++n) USMP[(size_t)(rl + jj) * DFF2 + bj * DFF + chan + 16 * n] = f2bf(acc[0][bj][m][n][jj] * rsv); } }
            return;
        }
        if (fq == 3) {
#pragma unroll
            for (int ai = 0; ai < 2; ++ai) { const f32x4 sq = *(const f32x4*)(ssq_in + rowq + 128 * ai + 48);
                const float r2 = rsqrtf(sq[2] * (1.f / 2048.f) + EPS), r3 = rsqrtf(sq[3] * (1.f / 2048.f) + EPS);
#pragma unroll
                for (int bj = 0; bj < 2; ++bj)
#pragma unroll
                    for (int n = 0; n < 2; ++n) { const float v2 = acc[ai][bj][3][n][2] * r2, v3 = acc[ai][bj][3][n][3] * r3;
                        LAS float* e = ex + ((w * 2 + ai) * 2) * 64 + bj * 32 + n * 16 + fr; e[0] = v2; e[64] = v3;
                        if (ai == 1 && wr == 1) { float* ul = UL + (size_t)(u.pm * 2) * DFF2 + bj * DFF + chan + 16 * n; ul[0] = v2; ul[DFF2] = v3;
                            if ((u.pm & 7) == 7) { float* fo = fcp + (size_t)((u.pm >> 3) * 2) * DFF2 + bj * DFF + chan + 16 * n; fo[0] = v2; fo[DFF2] = v3; } } } }
        }
        if (fq == 0 && wr == 0) { const f32x4 sq = *(const f32x4*)(ssq_in + rowq);
            const float r0 = rsqrtf(sq[0] * (1.f / 2048.f) + EPS), r1 = rsqrtf(sq[1] * (1.f / 2048.f) + EPS);
#pragma unroll
            for (int bj = 0; bj < 2; ++bj)
#pragma unroll
                for (int n = 0; n < 2; ++n) { float* uf = UF + (size_t)(u.pm * 2) * DFF2 + bj * DFF + chan + 16 * n; uf[0] = acc[0][bj][0][n][0] * r0; uf[DFF2] = acc[0][bj][0][n][1] * r1; } }
        asm volatile("s_waitcnt lgkmcnt(0)" ::: "memory"); __builtin_amdgcn_s_barrier(); asm volatile("" ::: "memory");
        float wg[2][3], wv[2][3], bg[2], bv[2];
#pragma unroll
        for (int n = 0; n < 2; ++n) {
#pragma unroll
            for (int t = 0; t < 3; ++t) { wg[n][t] = fw[(size_t)t * DFF2 + chan + 16 * n]; wv[n][t] = fw[(size_t)t * DFF2 + DFF + chan + 16 * n]; }
            bg[n] = fb[chan + 16 * n]; bv[n] = fb[DFF + chan + 16 * n]; }
        const int srcl = (lane + 48) & 63;
#pragma unroll
        for (int ai = 0; ai < 2; ++ai) {
            const bool hal = (wr == 1 || ai == 1);
            const LAS float* hb = ex + (wr == 1 ? ((w - 4) * 2 + ai) * 2 : ((w + 4) * 2 + 0) * 2) * 64 + fr;
            f32x4 gl[2], vl[2];
#pragma unroll
            for (int m = 0; m < 4; ++m) {
                const f32x4 sq = *(const f32x4*)(ssq_in + rowq + 128 * ai + 16 * m); f32x4 rs4;
#pragma unroll
                for (int jj = 0; jj < 4; ++jj) rs4[jj] = rsqrtf(sq[jj] * (1.f / 2048.f) + EPS);
#pragma unroll
                for (int n = 0; n < 2; ++n) {
                    const f32x4 g = acc[ai][0][m][n] * rs4, v = acc[ai][1][m][n] * rs4;
                    float g2 = __shfl(g[2], srcl), g3 = __shfl(g[3], srcl), v2 = __shfl(v[2], srcl), v3 = __shfl(v[3], srcl);
                    if (m > 0) { const float a2 = __shfl(gl[n][2], srcl), a3 = __shfl(gl[n][3], srcl), c2 = __shfl(vl[n][2], srcl), c3 = __shfl(vl[n][3], srcl);
                        if (fq == 0) { g2 = a2; g3 = a3; v2 = c2; v3 = c3; } }
                    else { const float t0 = hb[n * 16], t1 = hb[32 + n * 16], t2 = hb[64 + n * 16], t3 = hb[96 + n * 16];
                        if (fq == 0) { g2 = hal ? t0 : 0.f; v2 = hal ? t1 : 0.f; g3 = hal ? t2 : 0.f; v3 = hal ? t3 : 0.f; } }
                    gl[n] = g; vl[n] = v;
                    float hh[4];
                    { const float c0 = bg[n] + wg[n][0] * g2 + wg[n][1] * g3 + wg[n][2] * g[0], d0 = bv[n] + wv[n][0] * v2 + wv[n][1] * v3 + wv[n][2] * v[0]; hh[0] = silu_f(c0) * d0; }
                    { const float c1 = bg[n] + wg[n][0] * g3 + wg[n][1] * g[0] + wg[n][2] * g[1], d1 = bv[n] + wv[n][0] * v3 + wv[n][1] * v[0] + wv[n][2] * v[1]; hh[1] = silu_f(c1) * d1; }
                    { const float c2 = bg[n] + wg[n][0] * g[0] + wg[n][1] * g[1] + wg[n][2] * g[2], d2 = bv[n] + wv[n][0] * v[0] + wv[n][1] * v[1] + wv[n][2] * v[2]; hh[2] = silu_f(c2) * d2; }
                    { const float c3 = bg[n] + wg[n][0] * g[1] + wg[n][1] * g[2] + wg[n][2] * g[3], d3 = bv[n] + wv[n][0] * v[1] + wv[n][1] * v[2] + wv[n][2] * v[3]; hh[3] = silu_f(c3) * d3; }
                    bf16_t* hp = H + (size_t)(rowq + 128 * ai + 16 * m) * DFF + chan + 16 * n;
                    const bool skip01 = (ai == 0 && m == 0 && wr == 0 && fq == 0 && (u.pm & 7) != 0);
                    if (!skip01) { hp[0] = f2bf(hh[0]); hp[DFF] = f2bf(hh[1]); }
                    hp[2 * DFF] = f2bf(hh[2]); hp[3 * DFF] = f2bf(hh[3]);
                }
            }
        }
    }
};

#define XB_TMO      128
#define XB_XCNT(j)  (256  + 64 * (j))
#define XB_XSUB(j)  (1280 + 64 * (j))
#define XB_XGEN(j)  (2304 + 64 * (j))
#define XB_TOP      3328
#define XB_TOPGEN   3392
#define XCD_BAR_WORDS 3456
#define XB_SPIN_CAP (1u << 18)

__device__ __forceinline__ unsigned xb_ld(unsigned* p)              { return __hip_atomic_load(p, __ATOMIC_RELAXED, __HIP_MEMORY_SCOPE_AGENT); }
__device__ __forceinline__ unsigned xb_add(unsigned* p, unsigned v) { return __hip_atomic_fetch_add(p, v, __ATOMIC_RELAXED, __HIP_MEMORY_SCOPE_AGENT); }
__device__ __forceinline__ unsigned xb_xcc_id() { return (unsigned)__builtin_amdgcn_s_getreg((3 << 11) | 20) & 0xFu; }
#define XB_SPIN(cond, bar) do { unsigned _sp = 0; while (cond) { __builtin_amdgcn_s_sleep(1); \
    if ((++_sp & 255u) == 0u) { if (xb_ld(&(bar)[XB_TMO])) break; if (_sp > XB_SPIN_CAP) { atomicAdd(&(bar)[XB_TMO], 1u); break; } } } } while (0)

struct XcdBarrier {
    unsigned* bar; unsigned x;
    volatile LAS unsigned* st;
};

__device__ __forceinline__ XcdBarrier xcd_barrier_post(unsigned* bar, volatile LAS unsigned* st) {
    XcdBarrier b; b.bar = bar; b.x = xb_xcc_id(); b.st = st;
    if (threadIdx.x == 0) (void)xb_add(&bar[XB_XCNT(b.x)], 1u);
    return b;
}
__device__ __forceinline__ void xcd_barrier_complete(unsigned* bar, unsigned x, unsigned& nloc, unsigned& nx) {
    const unsigned G = gridDim.x * gridDim.y * gridDim.z;
    unsigned sum, cnt, mine, sp = 0u;
    for (;;) {
        sum = 0u; cnt = 0u; mine = 0u;
#pragma unroll
        for (unsigned j = 0; j < 16; ++j) { const unsigned c = xb_ld(&bar[XB_XCNT(j)]); sum += c; cnt += (c > 0u) ? 1u : 0u; mine = (j == x) ? c : mine; }
        if (sum == G) break;
        __builtin_amdgcn_s_sleep(1);
        if ((++sp & 255u) == 0u) { if (xb_ld(&bar[XB_TMO])) break; if (sp > XB_SPIN_CAP) { atomicAdd(&bar[XB_TMO], 1u); break; } }
    }
    nloc = mine > 0u ? mine : 1u; nx = cnt > 0u ? cnt : 1u;
}

__device__ __forceinline__ void xcd_barrier(const XcdBarrier& b) {
    asm volatile("s_waitcnt vmcnt(0)" ::: "memory");
    __syncthreads();
    if (threadIdx.x == 0) {
        unsigned* bar = b.bar;
        __builtin_amdgcn_s_waitcnt(0);
        unsigned nloc = b.st[0], nx = b.st[1];
        if (nloc == 0u) { xcd_barrier_complete(bar, b.x, nloc, nx); b.st[0] = nloc; b.st[1] = nx; }
        const unsigned old = xb_add(&bar[XB_XSUB(b.x)], 1u);
        const unsigned gen = old / nloc;
        if (old + 1u == (gen + 1u) * nloc) {
            __builtin_amdgcn_fence(__ATOMIC_RELEASE, "agent");
            asm volatile("s_waitcnt vmcnt(0)" ::: "memory");
            const unsigned og = xb_add(&bar[XB_TOP], 1u);
            const unsigned tg = og / nx;
            if (og + 1u == (tg + 1u) * nx) xb_add(&bar[XB_TOPGEN], 1u);
            else XB_SPIN(xb_ld(&bar[XB_TOPGEN]) == tg, bar);
            __builtin_amdgcn_fence(__ATOMIC_ACQUIRE, "agent");
            xb_add(&bar[XB_XGEN(b.x)], 1u);
            asm volatile("s_waitcnt vmcnt(0)" ::: "memory");
        } else {
            XB_SPIN(xb_ld(&bar[XB_XGEN(b.x)]) == gen, bar);
            __builtin_amdgcn_fence(__ATOMIC_ACQUIRE, "agent");
            asm volatile("s_waitcnt vmcnt(0)" ::: "memory");
        }
    }
    __syncthreads();
}

struct Args { const float* in[35]; float* out; unsigned char* ws; int ph_lo, ph_hi; };
struct Ctx {
    LAS unsigned char* lds; int tid, lane, wave, G, bid;
    const float* const* in; float* out; unsigned char* ws; int dry;
};
#define IN_(i) (c.in[i])
enum { I_XP = 0, I_XS, I_CSK, I_CSV, I_SSC, I_SS, I_CMK, I_CMV, I_SFC, I_MEM, I_GMIX, I_WIN, I_QG, I_KG, I_SINK, I_SCW, I_SCB, I_DTB, I_ALOG, I_DSK, I_SNG, I_WOUT, I_GCR, I_GMEM, I_WCQ, I_WCK, I_WCV, I_CQG, I_CKG, I_WCO, I_GFFN, I_WUP, I_FCW, I_FCB, I_WDN };

struct TItem { const float* W; bf16_t* WT; const float* gain; int N, ldk, ksrc0, kdst0, n0, nrow_off, dn0; };
constexpr int TT_IN = 16 * 53, TT_OUT = 24 * 16, TT_C = 16 * 4, TT_CO = 4 * 16, TT_UP = 16 * 88, TT_DN = 44 * 16;
constexpr int TT_ALL = TT_IN + TT_OUT + 3 * TT_C + TT_CO + TT_UP + TT_DN;
constexpr int TT_P4_START = TT_ALL - 1400;
DI bool p0_decode(const Ctx& c, int it, TItem& t) {
    int r = it; t.nrow_off = 0;
    if (r < TT_IN) { const int kb = r / 53, nb = r % 53; t.W = IN_(I_WIN); t.N = DIN; t.WT = (bf16_t*)(c.ws + WS_WIN); t.ldk = 2048; t.ksrc0 = kb * 128; t.kdst0 = kb * 128; t.n0 = nb * 128; t.gain = IN_(I_GMIX) + kb * 128; t.dn0 = t.nrow_off + t.n0; return true; } r -= TT_IN;
    if (r < TT_OUT) { const int kb = r / 16, nb = r % 16, ks = kb * 128; const bool ssd = ks >= 1024; t.W = IN_(I_WOUT); t.N = 2048; t.WT = (bf16_t*)(c.ws + WS_WOUT); t.ldk = 3072; t.ksrc0 = ks; t.kdst0 = ssd ? ks - 1024 : ks + 2048; t.n0 = nb * 128;
        t.gain = ssd ? IN_(I_SNG) + (ks - 1024) : nullptr; t.dn0 = t.nrow_off + t.n0; return true; } r -= TT_OUT;
    if (r < TT_C) { const int kb = r / 4, nb = r % 4; t.W = IN_(I_WCQ); t.N = 512; t.WT = (bf16_t*)(c.ws + WS_WCQ); t.ldk = 2048; t.ksrc0 = kb * 128; t.kdst0 = kb * 128; t.n0 = nb * 128; t.gain = IN_(I_GCR) + kb * 128; t.dn0 = t.nrow_off + t.n0; return true; } r -= TT_C;
    if (r < TT_C) { const int kb = r / 4, nb = r % 4; t.W = IN_(I_WCK); t.N = 512; t.WT = (bf16_t*)(c.ws + WS_WCKV); t.ldk = 2048; t.ksrc0 = kb * 128; t.kdst0 = kb * 128; t.n0 = nb * 128; t.gain = IN_(I_GMEM) + kb * 128; t.dn0 = t.nrow_off + t.n0; return true; } r -= TT_C;
    if (r < TT_C) { const int kb = r / 4, nb = r % 4; t.W = IN_(I_WCV); t.N = 512; t.WT = (bf16_t*)(c.ws + WS_WCKV); t.ldk = 2048; t.ksrc0 = kb * 128; t.kdst0 = kb * 128; t.n0 = nb * 128; t.nrow_off = 512; t.gain = IN_(I_GMEM) + kb * 128; t.dn0 = t.nrow_off + t.n0; return true; } r -= TT_C;
    if (r < TT_CO) { const int kb = r / 16, nb = r % 16; t.W = IN_(I_WCO); t.N = 2048; t.WT = (bf16_t*)(c.ws + WS_WCO); t.ldk = 512; t.ksrc0 = kb * 128; t.kdst0 = kb * 128; t.n0 = nb * 128; t.gain = nullptr; t.dn0 = t.nrow_off + t.n0; return true; } r -= TT_CO;
    if (r < TT_UP) { const int kb = r / 88, nb = r % 88; t.W = IN_(I_WUP); t.N = DFF2; t.WT = (bf16_t*)(c.ws + WS_WUP); t.ldk = 2048; t.ksrc0 = kb * 128; t.kdst0 = kb * 128; t.n0 = nb * 128; t.gain = IN_(I_GFFN) + kb * 128; { const int half = nb >= 44 ? 1 : 0; t.dn0 = 256 * (nb - 44 * half) + 128 * half; } return true; } r -= TT_UP;
    if (r < TT_DN) { const int kb = r / 16, nb = r % 16; t.W = IN_(I_WDN); t.N = 2048; t.WT = (bf16_t*)(c.ws + WS_WDN); t.ldk = DFF; t.ksrc0 = kb * 128; t.kdst0 = kb * 128; t.n0 = nb * 128; t.gain = nullptr; t.dn0 = t.nrow_off + t.n0; return true; }
    return false;
}
DI void p0_load(const TItem& t, int tid, f32x4 (&buf)[8], float (&gv)[8]) {
    const int kr = tid >> 5, n4 = (tid & 31) * 4; const bool ok = t.n0 + n4 < t.N;
    const float* p = t.W + (size_t)(t.ksrc0 + kr) * t.N + t.n0 + (ok ? n4 : 0);
#pragma unroll
    for (int i = 0; i < 8; ++i) { buf[i] = *(const f32x4*)(p + (size_t)(16 * i) * t.N); gv[i] = t.gain ? t.gain[16 * i + kr] : 1.f; if (!ok) gv[i] = 0.f; }
}
DI void p0_transposes(const Ctx& c, int it_lo, int it_hi, int vb, int nvb) {
    int tid_ = c.tid; asm volatile("" : "+v"(tid_)); const int tid = tid_;
    f32x4 buf[8]; float gv[8]; TItem cur, nxt;
    int it = it_lo + vb; bool have = (it < it_hi) && p0_decode(c, it, cur);
    if (have) p0_load(cur, tid, buf, gv);
    const int kr = tid >> 5, n4 = (tid & 31) * 4, cc = tid & 15, nr = tid >> 4; int pb = 0;
    while (have) {
        const int itn = it + nvb; const bool hn = (itn < it_hi) && p0_decode(c, itn, nxt);
        LAS float* scr = (LAS float*)(c.lds + pb * 66048);
#pragma unroll
        for (int i = 0; i < 8; ++i) { LAS float* d = scr + (16 * i + kr) * 129 + n4; const f32x4 v = buf[i] * gv[i]; d[0] = v.x; d[1] = v.y; d[2] = v.z; d[3] = v.w; }
        if (hn) p0_load(nxt, tid, buf, gv);
        __syncthreads();
#pragma unroll
        for (int j = 0; j < 4; ++j) { const int n = nr + 32 * j; const LAS float* sp = scr + (8 * cc) * 129 + n;
            u32x4 o; o.x = pk2(sp[0 * 129], sp[1 * 129]); o.y = pk2(sp[2 * 129], sp[3 * 129]); o.z = pk2(sp[4 * 129], sp[5 * 129]); o.w = pk2(sp[6 * 129], sp[7 * 129]);
            *(u32x4*)(cur.WT + (size_t)(cur.dn0 + n) * cur.ldk + cur.kdst0 + 8 * cc) = o; }
        pb ^= 1; cur = nxt; it = itn; have = hn;
    }
    __syncthreads();
}
DI void norm_row_to_bf16(const float* xrow, bf16_t* orow, int lane) {
    f32x4 v[8]; float s = 0.f;
    if (xrow) {
#pragma unroll
        for (int j = 0; j < 8; ++j) { v[j] = ((const f32x4*)xrow)[lane + 64 * j]; s += (v[j].x * v[j].x + v[j].y * v[j].y) + (v[j].z * v[j].z + v[j].w * v[j].w); }
    } else {
#pragma unroll
        for (int j = 0; j < 8; ++j) v[j] = (f32x4){0.f, 0.f, 0.f, 0.f};
    }
    const float rs = rsqrtf(wave_sum(s) * (1.f / 2048.f) + EPS);
#pragma unroll
    for (int j = 0; j < 8; ++j) { u32x2 w; w.x = pk2(v[j].x * rs, v[j].y * rs); w.y = pk2(v[j].z * rs, v[j].w * rs); ((u32x2*)orow)[lane + 64 * j] = w; }
}
DI void p0_prologue(const Ctx& c) {
    const int gw = c.bid * 8 + c.wave, NGW = c.G * 8, lane = c.lane;
    bf16_t* WINT = (bf16_t*)(c.ws + WS_WIN);
    p0_transposes(c, 0, c.G == 256 ? TT_P4_START : TT_ALL, c.bid, c.G);
    { u32x4* z = (u32x4*)(WINT + (size_t)6784 * 2048); const int n16 = (DINP - 6784) * 2048 * 2 / 16;
        for (int i = c.bid * 512 + c.tid; i < n16; i += c.G * 512) z[i] = (u32x4){0u, 0u, 0u, 0u}; }
    { float* z = (float*)(c.ws + WS_SSQ); for (int i = c.bid * 512 + c.tid; i < 3 * MPAD; i += c.G * 512) z[i] = 0.f; }
    bf16_t* A0 = (bf16_t*)(c.ws + WS_A0); bf16_t* MEMN = (bf16_t*)(c.ws + WS_MEMN);
    for (int m = gw; m < MPAD + 1024; m += NGW) {
        if (m < MPAD) { const float* xr = m < MP ? IN_(I_XP) + (size_t)m * DM : (m < MTOK ? IN_(I_XS) + (size_t)(m - MP) * DM : nullptr); norm_row_to_bf16(xr, A0 + (size_t)m * DM, lane); }
        else { const int r = m - MPAD; norm_row_to_bf16(IN_(I_MEM) + (size_t)r * DM, MEMN + (size_t)r * DM, lane); }
    }
}

constexpr int SP = 136;
DI void p1b_conv(const Ctx& c) {
    const bf16_t* PROJ = (const bf16_t*)(c.ws + WS_PROJ); bf16_t* XBC = (bf16_t*)(c.ws + WS_H);
    const float* cw = IN_(I_SCW); const float* cb = IN_(I_SCB);
    const int gw = c.bid * 8 + c.wave, NGW = c.G * 8, lane = c.lane;
    for (int task = gw; task < 512 * 6; task += NGW) {
        const int seg = task / 6, c8 = (task % 6) * 64 + lane, r0 = seg * 16, tl0 = r0 & (SEQ - 1), cch = c8 * 8;
        float w[4][8], bias[8];
#pragma unroll
        for (int i = 0; i < 4; ++i) { const f32x4 a = *(const f32x4*)(cw + (size_t)i * CONVD + cch), a2 = *(const f32x4*)(cw + (size_t)i * CONVD + cch + 4);
            w[i][0] = a.x; w[i][1] = a.y; w[i][2] = a.z; w[i][3] = a.w; w[i][4] = a2.x; w[i][5] = a2.y; w[i][6] = a2.z; w[i][7] = a2.w; }
        { const f32x4 a = *(const f32x4*)(cb + cch), a2 = *(const f32x4*)(cb + cch + 4); bias[0] = a.x; bias[1] = a.y; bias[2] = a.z; bias[3] = a.w; bias[4] = a2.x; bias[5] = a2.y; bias[6] = a2.z; bias[7] = a2.w; }
        float h1[8], h2[8], h3[8];
        if (tl0 == 0) {
#pragma unroll
            for (int j = 0; j < 8; ++j) { h1[j] = 0.f; h2[j] = 0.f; h3[j] = 0.f; }
        } else { const bf16_t* p = PROJ + (size_t)(r0 - 3) * DINP + C_XBC + cch; unpack8(*(const u32x4*)p, h1); unpack8(*(const u32x4*)(p + DINP), h2); unpack8(*(const u32x4*)(p + 2 * DINP), h3); }
#pragma unroll 1
        for (int rb = 0; rb < 16; rb += 4) { u32x4 lr_[4];
#pragma unroll
          for (int r4 = 0; r4 < 4; ++r4) lr_[r4] = *(const u32x4*)(PROJ + ((size_t)r0 + rb + r4) * DINP + C_XBC + cch);
#pragma unroll
          for (int r4 = 0; r4 < 4; ++r4) { const size_t row = (size_t)r0 + rb + r4; float cur[8], o[8]; unpack8(lr_[r4], cur);
#pragma unroll
            for (int j = 0; j < 8; ++j) { o[j] = silu_f(bias[j] + w[0][j] * h1[j] + w[1][j] * h2[j] + w[2][j] * h3[j] + w[3][j] * cur[j]); h1[j] = h2[j]; h2[j] = h3[j]; h3[j] = cur[j]; }
            u32x4 q; q.x = pk2(o[0], o[1]); q.y = pk2(o[2], o[3]); q.z = pk2(o[4], o[5]); q.w = pk2(o[6], o[7]); *(u32x4*)(XBC + row * CONVD + cch) = q; } }
    }
}
template <int W> DI void ssd_causal(const LAS bf16_t* Cs, const LAS bf16_t* Bs, const LAS bf16_t* Xn, const LAS float* las, const LAS float* dts, int l, float la_l, int fr, int fq, f32x4 (&y)[2]) {
    constexpr int XP = 40;
    f32x4 cbm[8];
#pragma unroll
    for (int ni = 0; ni < 8; ++ni) cbm[ni] = (f32x4){0.f, 0.f, 0.f, 0.f};
#pragma unroll
    for (int kk = 0; kk < 4; ++kk) { __builtin_amdgcn_sched_barrier(0); const bf16x8 af = *(const LAS bf16x8*)(Cs + l * SP + kk * 32 + fq * 8);
#pragma unroll
        for (int ni = 0; ni < 8; ++ni) if (ni <= W) { const bf16x8 bf = *(const LAS bf16x8*)(Bs + (16 * ni + fr) * SP + kk * 32 + fq * 8); cbm[ni] = MFMA16(bf, af, cbm[ni]); } }
    int lim = l - 4 * fq; asm volatile("" : "+v"(lim));
#pragma unroll
    for (int ni = 0; ni < 8; ++ni) if (ni <= W) { const int s = 16 * ni + 4 * fq; const f32x4 ls = *(const LAS f32x4*)(las + s), ds = *(const LAS f32x4*)(dts + s);
#pragma unroll
        for (int j = 0; j < 4; ++j) cbm[ni][j] = (16 * ni + j <= lim) ? cbm[ni][j] * __expf(la_l - ls[j]) * ds[j] : 0.f; }
#pragma unroll
    for (int k2 = 0; k2 < 4; ++k2) if (2 * k2 <= W) { __builtin_amdgcn_sched_barrier(0); u32x4 pa; pa.x = pk2(cbm[2 * k2][0], cbm[2 * k2][1]); pa.y = pk2(cbm[2 * k2][2], cbm[2 * k2][3]); pa.z = pk2(cbm[2 * k2 + 1][0], cbm[2 * k2 + 1][1]); pa.w = pk2(cbm[2 * k2 + 1][2], cbm[2 * k2 + 1][3]);
        const bf16x8 af = __builtin_bit_cast(bf16x8, pa);
#pragma unroll
        for (int np = 0; np < 2; ++np) { const LAS bf16_t* xp = Xn + (32 * k2 + 4 * fq + (fr >> 2)) * XP + 16 * np + 4 * (fr & 3);
            y[np] = MFMA16(cat8(vtr(xp), vtr(xp + 16 * XP)), af, y[np]); } }
}
DI void ssd_prompt_unit(const Ctx& c, int unit) {
    const int b = unit >> 6, h = (unit >> 1) & 31, ph = unit & 1, g = h >> 3;
    int tid_ = c.tid; asm volatile("" : "+v"(tid_)); const int tid = tid_, lane = tid & 63, w = __builtin_amdgcn_readfirstlane(tid >> 6), fr = lane & 15, fq = lane >> 4;
    constexpr int XP = 40;
    LAS bf16_t* Cs = (LAS bf16_t*)(c.lds); LAS bf16_t* Bs = (LAS bf16_t*)(c.lds + 34816); LAS bf16_t* Xn = (LAS bf16_t*)(c.lds + 69632); LAS bf16_t* Hb = (LAS bf16_t*)(c.lds + 90112);
    LAS float* dts = (LAS float*)(c.lds + 98816); LAS float* las = (LAS float*)(c.lds + 99328); LAS float* scl = (LAS float*)(c.lds + 99840);
    const bf16_t* PROJ = (const bf16_t*)(c.ws + WS_PROJ); const bf16_t* XBC = (const bf16_t*)(c.ws + WS_H); const float* DTR = (const float*)(c.ws + WS_DT);
    bf16_t* MIX = (bf16_t*)(c.ws + WS_MIX); float* SSQS = (float*)(c.ws + WS_SSQ) + (c.dry ? 3 * MPAD : 0);
    const float av = -__expf(IN_(I_ALOG)[h]), dtb = IN_(I_DTB)[h], Dh = IN_(I_DSK)[h];
    f32x4 st[2] = {(f32x4){0.f, 0.f, 0.f, 0.f}, (f32x4){0.f, 0.f, 0.f, 0.f}};
    for (int i = tid; i < 32 * SP / 2; i += 512) ((LAS unsigned*)Hb)[i] = 0u;
    const int sx = tid >> 2, c8 = tid & 3, cb8 = tid & 15, s0 = tid >> 4;
    u32x4 xq, bq[4], cq[4]; float dtrA = 0.f, dtrB = 0.f; u32x2 zn[2], zc[2];
#define SSD_LOADS(CK) do { const size_t r0_ = (size_t)b * SEQ + (CK) * 128; xq = *(const u32x4*)(XBC + (r0_ + sx) * CONVD + h * 64 + ph * 32 + c8 * 8); \
        _Pragma("unroll") for (int i = 0; i < 4; ++i) { const bf16_t* p_ = XBC + (r0_ + s0 + 32 * i) * CONVD + 2048 + g * 128 + cb8 * 8; bq[i] = *(const u32x4*)p_; cq[i] = *(const u32x4*)(p_ + 512); } \
        if (w < 2) { dtrA = DTR[(r0_ + lane) * 32 + h]; dtrB = DTR[(r0_ + 64 + lane) * 32 + h]; } \
        _Pragma("unroll") for (int np = 0; np < 2; ++np) zn[np] = *(const u32x2*)(PROJ + (r0_ + 16 * w + fr) * DINP + C_Z + h * 64 + ph * 32 + 16 * np + 4 * fq); } while (0)
    SSD_LOADS(0);
    for (int ck = 0; ck < 16; ++ck) {
        const size_t row0 = (size_t)b * SEQ + ck * 128;
        {
            if (w < 2) {
                const float dA = softplus_f(dtrA + dtb), dB = softplus_f(dtrB + dtb);
                float sA = dA, sB = dB;
#pragma unroll
                for (int o = 1; o < 64; o <<= 1) { const float tA = __shfl_up(sA, o), tB = __shfl_up(sB, o); if (lane >= o) { sA += tA; sB += tB; } }
                const float totA = __shfl(sA, 63), tot = totA + __shfl(sB, 63);
                if (w == 0) { dts[lane] = dA; las[lane] = av * sA; scl[lane] = dA * __expf(av * (tot - sA)); }
                else { dts[64 + lane] = dB; las[64 + lane] = av * (totA + sB); scl[64 + lane] = dB * __expf(av * (tot - totA - sB)); }
            }
            *(LAS u32x4*)(Xn + sx * XP + c8 * 8) = xq;
#pragma unroll
            for (int i = 0; i < 4; ++i) { *(LAS u32x4*)(Bs + (s0 + 32 * i) * SP + cb8 * 8) = bq[i]; *(LAS u32x4*)(Cs + (s0 + 32 * i) * SP + cb8 * 8) = cq[i]; }
        }
        zc[0] = zn[0]; zc[1] = zn[1];
        __syncthreads();
        if (ck + 1 < 16) SSD_LOADS(ck + 1);
        asm volatile("" ::: "memory");
        const int l = 16 * w + fr; const float la_l = las[l];
        f32x4 y[2] = {(f32x4){0.f, 0.f, 0.f, 0.f}, (f32x4){0.f, 0.f, 0.f, 0.f}}, yi[2] = {(f32x4){0.f, 0.f, 0.f, 0.f}, (f32x4){0.f, 0.f, 0.f, 0.f}};
        switch (w) {
            case 0: ssd_causal<0>(Cs, Bs, Xn, las, dts, l, la_l, fr, fq, y); break;
            case 1: ssd_causal<1>(Cs, Bs, Xn, las, dts, l, la_l, fr, fq, y); break;
            case 2: ssd_causal<2>(Cs, Bs, Xn, las, dts, l, la_l, fr, fq, y); break;
            case 3: ssd_causal<3>(Cs, Bs, Xn, las, dts, l, la_l, fr, fq, y); break;
            case 4: ssd_causal<4>(Cs, Bs, Xn, las, dts, l, la_l, fr, fq, y); break;
            case 5: ssd_causal<5>(Cs, Bs, Xn, las, dts, l, la_l, fr, fq, y); break;
            case 6: ssd_causal<6>(Cs, Bs, Xn, las, dts, l, la_l, fr, fq, y); break;
            default: ssd_causal<7>(Cs, Bs, Xn, las, dts, l, la_l, fr, fq, y); break;
        }
#pragma unroll
        for (int kk = 0; kk < 4; ++kk) { const bf16x8 af = *(const LAS bf16x8*)(Cs + l * SP + kk * 32 + fq * 8);
#pragma unroll
            for (int np = 0; np < 2; ++np) { const bf16x8 bf = *(const LAS bf16x8*)(Hb + (16 * np + fr) * SP + kk * 32 + fq * 8); yi[np] = MFMA16(bf, af, yi[np]); } }
        {
            const float el = __expf(la_l); const size_t row = row0 + l; float sq = 0.f;
#pragma unroll
            for (int np = 0; np < 2; ++np) { const int p0 = 16 * np + 4 * fq; const u32x2 zr = zc[np];
                const u32x2 xr = *(const LAS u32x2*)(Xn + l * XP + p0);
                const float zf[4] = {bflo(zr.x), bfhi(zr.x), bflo(zr.y), bfhi(zr.y)}, xf[4] = {bflo(xr.x), bfhi(xr.x), bflo(xr.y), bfhi(xr.y)}; float o[4];
#pragma unroll
                for (int j = 0; j < 4; ++j) { float v = y[np][j] + el * yi[np][j] + Dh * xf[j]; v *= silu_f(zf[j]); o[j] = v; sq += v * v; }
                u32x2 wv; wv.x = pk2(o[0], o[1]); wv.y = pk2(o[2], o[3]); *(u32x2*)(MIX + row * DMIX + h * 64 + ph * 32 + p0) = wv; }
            sq += __shfl_xor(sq, 16); sq += __shfl_xor(sq, 32); if (fq == 0) atomicAdd(SSQS + row, sq);
        }
        {
            f32x4 sa[2] = {(f32x4){0.f, 0.f, 0.f, 0.f}, (f32x4){0.f, 0.f, 0.f, 0.f}};
#pragma unroll
            for (int kk = 0; kk < 4; ++kk) { __builtin_amdgcn_sched_barrier(0); const int sb = 32 * kk + 8 * fq;
                const LAS bf16_t* bp = Bs + (sb + (fr >> 2)) * SP + 16 * w + 4 * (fr & 3); const s16x4 b0 = vtr(bp), b1 = vtr(bp + 4 * SP);
                const f32x4 s0 = *(const LAS f32x4*)(scl + sb), s1 = *(const LAS f32x4*)(scl + sb + 4);
                const u32x2 a0 = __builtin_bit_cast(u32x2, b0), a1 = __builtin_bit_cast(u32x2, b1); u32x4 q;
                q.x = pk2(bflo(a0.x) * s0[0], bfhi(a0.x) * s0[1]); q.y = pk2(bflo(a0.y) * s0[2], bfhi(a0.y) * s0[3]); q.z = pk2(bflo(a1.x) * s1[0], bfhi(a1.x) * s1[1]); q.w = pk2(bflo(a1.y) * s1[2], bfhi(a1.y) * s1[3]);
                const bf16x8 bf = __builtin_bit_cast(bf16x8, q);
#pragma unroll
                for (int mi = 0; mi < 2; ++mi) { const LAS bf16_t* xp = Xn + (sb + (fr >> 2)) * XP + 16 * mi + 4 * (fr & 3);
                    sa[mi] = MFMA16(bf, cat8(vtr(xp), vtr(xp + 4 * XP)), sa[mi]); } }
            const float ee = __expf(las[127]);
#pragma unroll
            for (int mi = 0; mi < 2; ++mi) st[mi] = st[mi] * ee + sa[mi];
        }
        __syncthreads();
#pragma unroll
        for (int mi = 0; mi < 2; ++mi) { u32x2 wv; wv.x = pk2(st[mi][0], st[mi][1]); wv.y = pk2(st[mi][2], st[mi][3]); *(LAS u32x2*)(Hb + (16 * mi + fr) * SP + 16 * w + 4 * fq) = wv; }
    }
    float* so = c.out + O_SSP;
#pragma unroll
    for (int mi = 0; mi < 2; ++mi) *(f32x4*)(so + ((size_t)(b * 32 + h) * 64 + ph * 32 + 16 * mi + fr) * 128 + 16 * w + 4 * fq) = st[mi];
    __syncthreads();
}

DI void swa_prompt_unit(const Ctx& c, int unit) {
    const int b = unit >> 6, blk = (unit >> 2) & 15, kvh = unit & 3;
    int tid_ = c.tid; asm volatile("" : "+v"(tid_)); const int tid = tid_, lane = tid & 63, w = __builtin_amdgcn_readfirstlane(tid >> 6), fr = lane & 15, fq = lane >> 4;
    constexpr int KP = 72, VP = 72;
    LAS bf16_t* Ks = (LAS bf16_t*)(c.lds); LAS bf16_t* Vn = (LAS bf16_t*)(c.lds + 36864);
    const bf16_t* PROJ = (const bf16_t*)(c.ws + WS_PROJ); bf16_t* MIX = (bf16_t*)(c.ws + WS_MIX);
    u32x4 qraw[4][2];
#pragma unroll
    for (int it = 0; it < 4; ++it) { const int combo = w * 2 + (it >> 1), mi = it & 1, gq = combo & 3, rg = combo >> 2; const size_t row = (size_t)b * SEQ + blk * 128 + 32 * rg + 16 * mi + fr;
#pragma unroll
        for (int kk = 0; kk < 2; ++kk) qraw[it][kk] = *(const u32x4*)(PROJ + row * DINP + C_Q + (kvh * 4 + gq) * 64 + kk * 32 + fq * 8); }
    {
        const int key = tid >> 1, half = tid & 1, tk = blk * 128 - 128 + key;
        const bf16_t* pr = PROJ + ((size_t)b * SEQ + (tk >= 0 ? tk : 0)) * DINP;
        const bool wout = (blk == 15 && key >= 128);
        unsigned ooff = (unsigned)(((b * 128 + (key & 127)) * 4 + kvh) * 64 + half * 32); asm volatile("" : "+v"(ooff));
        {
            float kf[32]; float sq = 0.f;
#pragma unroll
            for (int i = 0; i < 4; ++i) unpack8(*(const u32x4*)(pr + C_K + kvh * 64 + half * 32 + i * 8), kf + 8 * i);
#pragma unroll
            for (int i = 0; i < 32; ++i) sq += kf[i] * kf[i];
            sq += __shfl_xor(sq, 1); const float rs = (tk >= 0) ? rsqrtf(sq * (1.f / 64.f) + EPS) : 0.f; const float* kg = IN_(I_KG) + half * 32;
#pragma unroll
            for (int i = 0; i < 4; ++i) { const f32x4 g0 = *(const f32x4*)(kg + 8 * i), g1 = *(const f32x4*)(kg + 8 * i + 4);
                const f32x4 k0 = (f32x4){kf[8 * i], kf[8 * i + 1], kf[8 * i + 2], kf[8 * i + 3]} * g0 * rs, k1 = (f32x4){kf[8 * i + 4], kf[8 * i + 5], kf[8 * i + 6], kf[8 * i + 7]} * g1 * rs;
                u32x4 q; q.x = pk2(k0[0], k0[1]); q.y = pk2(k0[2], k0[3]); q.z = pk2(k1[0], k1[1]); q.w = pk2(k1[2], k1[3]);
                *(LAS u32x4*)(Ks + key * KP + half * 32 + i * 8) = q;
                if (wout) { float* ok = c.out + O_SKP + ooff; *(f32x4*)(ok + 8 * i) = k0; *(f32x4*)(ok + 8 * i + 4) = k1; } }
        }
        asm volatile("" ::: "memory");
        {
            float vf[32];
#pragma unroll
            for (int i = 0; i < 4; ++i) unpack8(*(const u32x4*)(pr + C_V + kvh * 64 + half * 32 + i * 8), vf + 8 * i);
            if (tk < 0) {
#pragma unroll
                for (int i = 0; i < 32; ++i) vf[i] = 0.f;
            }
#pragma unroll
            for (int i = 0; i < 4; ++i) { u32x4 q; q.x = pk2(vf[8 * i], vf[8 * i + 1]); q.y = pk2(vf[8 * i + 2], vf[8 * i + 3]); q.z = pk2(vf[8 * i + 4], vf[8 * i + 5]); q.w = pk2(vf[8 * i + 6], vf[8 * i + 7]);
                *(LAS u32x4*)(Vn + key * VP + half * 32 + i * 8) = q; }
            if (wout) { float* ov = c.out + O_SVP + ooff;
#pragma unroll
                for (int i = 0; i < 8; ++i) *(f32x4*)(ov + 4 * i) = (f32x4){vf[4 * i], vf[4 * i + 1], vf[4 * i + 2], vf[4 * i + 3]}; }
        }
    }
    __syncthreads();
#pragma unroll
    for (int it = 0; it < 4; ++it) {
        asm volatile("" ::: "memory");
        const int combo = w * 2 + (it >> 1), mi = it & 1, gq = combo & 3, rg = combo >> 2, head = kvh * 4 + gq; const float sink = IN_(I_SINK)[head];
        const int r = 16 * mi + fr; const size_t row = (size_t)b * SEQ + blk * 128 + 32 * rg + r;
        bf16x8 qf[2];
        { float f[16]; float sq = 0.f;
#pragma unroll
            for (int kk = 0; kk < 2; ++kk) unpack8(qraw[it][kk], f + 8 * kk);
#pragma unroll
            for (int i = 0; i < 16; ++i) sq += f[i] * f[i];
            sq += __shfl_xor(sq, 16); sq += __shfl_xor(sq, 32); const float rs = rsqrtf(sq * (1.f / 64.f) + EPS) * 0.125f;
#pragma unroll
            for (int kk = 0; kk < 2; ++kk) { const float* qg = IN_(I_QG) + kk * 32 + fq * 8; u32x4 q; q.x = pk2(f[8 * kk] * rs * qg[0], f[8 * kk + 1] * rs * qg[1]); q.y = pk2(f[8 * kk + 2] * rs * qg[2], f[8 * kk + 3] * rs * qg[3]);
                q.z = pk2(f[8 * kk + 4] * rs * qg[4], f[8 * kk + 5] * rs * qg[5]); q.w = pk2(f[8 * kk + 6] * rs * qg[6], f[8 * kk + 7] * rs * qg[7]); qf[kk] = __builtin_bit_cast(bf16x8, q); } }
        f32x4 S[10];
#pragma unroll
        for (int ni = 0; ni < 10; ++ni) S[ni] = (f32x4){0.f, 0.f, 0.f, 0.f};
#pragma unroll
        for (int ni = 0; ni < 10; ++ni)
#pragma unroll
            for (int kk = 0; kk < 2; ++kk) { __builtin_amdgcn_sched_barrier(0); const bf16x8 bf = *(const LAS bf16x8*)(Ks + (32 * rg + 16 * ni + fr) * KP + kk * 32 + fq * 8); S[ni] = MFMA16(bf, qf[kk], S[ni]); }
        float mx = sink;
        const int lowlim = blk > 0 ? -100000 : 128 - 32 * rg; const int lo_ = r > lowlim ? r : lowlim;
        int xoff = 4 * fq - lo_; const unsigned hi_ = (unsigned)(r + 128 - lo_); asm volatile("" : "+v"(xoff));
#pragma unroll
        for (int ni = 0; ni < 10; ++ni)
#pragma unroll
            for (int j = 0; j < 4; ++j) { const bool ok = (unsigned)(xoff + (16 * ni + j)) <= hi_;
                S[ni][j] = ok ? S[ni][j] : -1e30f; mx = fmaxf(mx, S[ni][j]); }
        mx = fmaxf(mx, __shfl_xor(mx, 16)); mx = fmaxf(mx, __shfl_xor(mx, 32));
        float sm = 0.f;
#pragma unroll
        for (int ni = 0; ni < 10; ++ni)
#pragma unroll
            for (int j = 0; j < 4; ++j) { const float p = __expf(S[ni][j] - mx); S[ni][j] = p; sm += p; }
        sm += __shfl_xor(sm, 16); sm += __shfl_xor(sm, 32); sm += __expf(sink - mx);
        const float inv = 1.f / sm;
        f32x4 O[4];
#pragma unroll
        for (int nd = 0; nd < 4; ++nd) O[nd] = (f32x4){0.f, 0.f, 0.f, 0.f};
#pragma unroll
        for (int k2 = 0; k2 < 5; ++k2) { __builtin_amdgcn_sched_barrier(0); u32x4 pa; pa.x = pk2(S[2 * k2][0], S[2 * k2][1]); pa.y = pk2(S[2 * k2][2], S[2 * k2][3]); pa.z = pk2(S[2 * k2 + 1][0], S[2 * k2 + 1][1]); pa.w = pk2(S[2 * k2 + 1][2], S[2 * k2 + 1][3]);
            const bf16x8 af = __builtin_bit_cast(bf16x8, pa);
#pragma unroll
            for (int nd = 0; nd < 4; ++nd) { const LAS bf16_t* vp = Vn + (32 * rg + 32 * k2 + 4 * fq + (fr >> 2)) * VP + 16 * nd + 4 * (fr & 3);
                O[nd] = MFMA16(cat8(vtr(vp), vtr(vp + 16 * VP)), af, O[nd]); } }
#pragma unroll
        for (int nd = 0; nd < 4; ++nd) { const f32x4 o = O[nd] * inv; u32x2 wv; wv.x = pk2(o[0], o[1]); wv.y = pk2(o[2], o[3]); *(u32x2*)(MIX + row * DMIX + 2048 + head * 64 + 16 * nd + 4 * fq) = wv; }
    }
    __syncthreads();
}

DI void swa_sample_pair(const Ctx& c, int P) {
    int tid_ = c.tid; asm volatile("" : "+v"(tid_)); const int tid = tid_, lane = tid & 63, w = __builtin_amdgcn_readfirstlane(tid >> 6);
    const int combo = 2 * P + (w >> 2), q4 = w & 3, b = combo >> 2, kvh = combo & 3;
    LAS float* qs = (LAS float*)(c.lds + w * 4096); LAS float* ps = qs + 256; LAS float* po = qs + 384; LAS float* pm = qs + 640; LAS float* psm = qs + 644;
    const bf16_t* pr = (const bf16_t*)(c.ws + WS_PROJ) + (size_t)(MP + b) * DINP; bf16_t* MIX = (bf16_t*)(c.ws + WS_MIX);
    const float* ck = IN_(I_CSK); const float* cv = IN_(I_CSV); float* ok = c.out + O_SKS; float* ov = c.out + O_SVS;
#pragma unroll
    for (int g = 0; g < 4; ++g) { const float qr = bf1(pr[C_Q + (kvh * 4 + g) * 64 + lane]); const float s2 = wave_sum(qr * qr); qs[g * 64 + lane] = qr * rsqrtf(s2 * (1.f / 64.f) + EPS) * IN_(I_QG)[lane] * 0.125f; }
    LDS_FENCE();
    const int s = 32 * q4 + (lane & 31), half = lane >> 5;
    float lg[4];
    {
        const float* kr = ck + ((size_t)(b * 128 + s) * 4 + kvh) * 64 + half * 32; f32x4 kv[8];
#pragma unroll
        for (int i = 0; i < 8; ++i) kv[i] = *(const f32x4*)(kr + 4 * i);
        if (s >= 1) { float* kw = ok + ((size_t)(b * 128 + s - 1) * 4 + kvh) * 64 + half * 32;
#pragma unroll
            for (int i = 0; i < 8; ++i) *(f32x4*)(kw + 4 * i) = kv[i]; }
#pragma unroll
        for (int g = 0; g < 4; ++g) { float a = 0.f;
#pragma unroll
            for (int i = 0; i < 8; ++i) { const f32x4 qv = *(const LAS f32x4*)(qs + g * 64 + half * 32 + 4 * i); a += (kv[i].x * qv.x + kv[i].y * qv.y) + (kv[i].z * qv.z + kv[i].w * qv.w); }
            a += __shfl_xor(a, 32); lg[g] = a; }
    }
#pragma unroll
    for (int g = 0; g < 4; ++g) { const float mx = wave_max(lg[g]); const float p = __expf(lg[g] - mx); const float sm = wave_sum(lane < 32 ? p : 0.f);
        if (lane < 32) ps[g * 32 + lane] = p; if (lane == 0) { pm[g] = mx; psm[g] = sm; } }
    LDS_FENCE();
    {
        float o[4] = {0.f, 0.f, 0.f, 0.f};
#pragma unroll 1
        for (int i0 = 0; i0 < 32; i0 += 8) { float v[8];
#pragma unroll
            for (int i = 0; i < 8; ++i) v[i] = cv[((size_t)(b * 128 + 32 * q4 + i0 + i) * 4 + kvh) * 64 + lane];
#pragma unroll
            for (int i = 0; i < 8; ++i) { const int sk = 32 * q4 + i0 + i; if (sk >= 1) ov[((size_t)(b * 128 + sk - 1) * 4 + kvh) * 64 + lane] = v[i];
#pragma unroll
                for (int g = 0; g < 4; ++g) o[g] += ps[g * 32 + i0 + i] * v[i]; } }
#pragma unroll
        for (int g = 0; g < 4; ++g) po[g * 64 + lane] = o[g];
    }
    __syncthreads();
    if (q4 == 0) {
        const float kraw = bf1(pr[C_K + kvh * 64 + lane]); const float ss = wave_sum(kraw * kraw); const float knew = kraw * rsqrtf(ss * (1.f / 64.f) + EPS) * IN_(I_KG)[lane];
        const float vnew = bf1(pr[C_V + kvh * 64 + lane]);
        ok[((size_t)(b * 128 + 127) * 4 + kvh) * 64 + lane] = knew; ov[((size_t)(b * 128 + 127) * 4 + kvh) * 64 + lane] = vnew;
#pragma unroll
        for (int g = 0; g < 4; ++g) { const float lnew = wave_sum(qs[g * 64 + lane] * knew), sink = IN_(I_SINK)[kvh * 4 + g];
            float m[4], sm[4]; float M = fmaxf(lnew, sink);
#pragma unroll
            for (int j = 0; j < 4; ++j) { const LAS float* qj = qs + j * 1024; m[j] = qj[640 + g]; sm[j] = qj[644 + g]; M = fmaxf(M, m[j]); }
            float S = __expf(lnew - M) + __expf(sink - M), o = __expf(lnew - M) * vnew;
#pragma unroll
            for (int j = 0; j < 4; ++j) { const float e = __expf(m[j] - M); S += sm[j] * e; o += (qs + j * 1024)[384 + g * 64 + lane] * e; }
            MIX[(size_t)(MP + b) * DMIX + 2048 + (kvh * 4 + g) * 64 + lane] = f2bf(o / S); }
    }
    __syncthreads();
}

DI void ssd_sample_wave(const Ctx& c, int wu) {
    int lane_ = c.lane; asm volatile("" : "+v"(lane_)); const int b = wu >> 5, h = wu & 31, g = h >> 3, lane = lane_;
    LAS float* xs = (LAS float*)(c.lds + c.wave * 4096); LAS float* Bsm = xs + 64; LAS float* Csm = xs + 192;
    const bf16_t* pr = (const bf16_t*)(c.ws + WS_PROJ) + (size_t)(MP + b) * DINP; bf16_t* MIX = (bf16_t*)(c.ws + WS_MIX);
    const float* cw = IN_(I_SCW); const float* cb = IN_(I_SCB); const float* scs = IN_(I_SSC) + (size_t)b * 3 * CONVD;
#pragma unroll
    for (int q = 0; q < 5; ++q) { const int cch = q == 0 ? h * 64 + lane : (q < 3 ? 2048 + g * 128 + (q - 1) * 64 + lane : 2560 + g * 128 + (q - 3) * 64 + lane);
        float v = cb[cch] + cw[cch] * scs[cch] + cw[CONVD + cch] * scs[CONVD + cch] + cw[2 * CONVD + cch] * scs[2 * CONVD + cch] + cw[3 * CONVD + cch] * bf1(pr[C_XBC + cch]);
        v = silu_f(v); if (q == 0) xs[lane] = v; else if (q < 3) Bsm[(q - 1) * 64 + lane] = v; else Csm[(q - 3) * 64 + lane] = v; }
    LDS_FENCE();
    const float dt = softplus_f(((const float*)(c.ws + WS_DT))[(size_t)(MP + b) * 32 + h] + IN_(I_DTB)[h]); const float dA = __expf(-dt * __expf(IN_(I_ALOG)[h])), Dh = IN_(I_DSK)[h];
    const int n4 = (lane & 31) * 4, psub = lane >> 5;
    const f32x4 Bv = *(const LAS f32x4*)(Bsm + n4), Cv = *(const LAS f32x4*)(Csm + n4);
    const float* hs = IN_(I_SS) + (size_t)(b * 32 + h) * 64 * 128; float* ho = c.out + O_SSS + (size_t)(b * 32 + h) * 64 * 128;
    float sq = 0.f;
#pragma unroll 1
    for (int it0 = 0; it0 < 32; it0 += 16) { f32x4 hv[16];
#pragma unroll
        for (int i = 0; i < 16; ++i) hv[i] = *(const f32x4*)(hs + (2 * (it0 + i) + psub) * 128 + n4);
#pragma unroll
        for (int i = 0; i < 16; ++i) { const int p = 2 * (it0 + i) + psub; const float xv = xs[p], xb = dt * xv;
            const f32x4 hn = hv[i] * dA + Bv * xb; *(f32x4*)(ho + p * 128 + n4) = hn;
            float part = (hn.x * Cv.x + hn.y * Cv.y) + (hn.z * Cv.z + hn.w * Cv.w);
#pragma unroll
            for (int o = 1; o < 32; o <<= 1) part += __shfl_xor(part, o);
            if ((lane & 31) == 0) { float yv = part + Dh * xv; yv *= silu_f(bf1(pr[C_Z + h * 64 + p])); sq += yv * yv; MIX[(size_t)(MP + b) * DMIX + h * 64 + p] = f2bf(yv); } } }
    sq = wave_sum(sq); if (lane == 0) atomicAdd((float*)(c.ws + WS_SSQ) + (c.dry ? 3 * MPAD : 0) + MP + b, sq);
    LDS_FENCE();
}

DI void p2_mixers(const Ctx& c) {
#ifndef P2SEL
#define P2SEL 15
#endif
#ifndef DRYSEL
#define DRYSEL 15
#endif
    const int sel_ = c.dry ? (DRYSEL) : (P2SEL);
    if (sel_ & 1) for (int u = c.bid; u < 256; u += c.G) ssd_prompt_unit(c, u);
    if (sel_ & 2) for (int u = c.bid; u < 256; u += c.G) swa_prompt_unit(c, u);
    const int gw = c.bid * 8 + c.wave, NGW = c.G * 8, lane = c.lane;
    if (sel_ & 4) for (int u = gw; u < 4096; u += NGW) ssd_sample_wave(c, u);
    if (sel_ & 8) for (int u = c.bid; u < 256; u += c.G) swa_sample_pair(c, u);
    if (!c.dry) for (int u = gw; u < 4096; u += NGW) { float* p = c.out + O_MKP + (size_t)u * 128; f32x2 v = ((f32x2*)p)[lane]; const float rs = rsqrtf(wave_sum(v.x * v.x + v.y * v.y) * (1.f / 128.f) + EPS);
        const f32x2 gg = ((const f32x2*)IN_(I_CKG))[lane]; v.x *= rs * gg.x; v.y *= rs * gg.y; ((f32x2*)p)[lane] = v; }
    const bf16_t* PROJ = (const bf16_t*)(c.ws + WS_PROJ);
    for (int i = c.bid * 512 + c.tid; i < NB * 3 * CONVD; i += c.G * 512) { const int b = i / (3 * CONVD), j = (i / CONVD) % 3, ch = i % CONVD; c.out[O_SCP + i] = bf1(PROJ[((size_t)b * SEQ + 2045 + j) * DINP + C_XBC + ch]); }
    for (int i = c.bid * 512 + c.tid; i < MS * 3 * CONVD; i += c.G * 512) { const int b = i / (3 * CONVD), j = (i / CONVD) % 3, ch = i % CONVD;
        c.out[O_SCS + i] = j < 2 ? IN_(I_SSC)[((size_t)b * 3 + j + 1) * CONVD + ch] : bf1(PROJ[(size_t)(MP + b) * DINP + C_XBC + ch]); }
}

DI void xattn_prompt_unit(const Ctx& c, int unit) {
    const int b = unit >> 6, head = (unit >> 4) & 3, qb = unit & 15;
    int tid_ = c.tid; asm volatile("" : "+v"(tid_)); const int tid = tid_, lane = tid & 63, w = __builtin_amdgcn_readfirstlane(tid >> 6), fr = lane & 15, fq = lane >> 4;
    constexpr int KP = 136, VP = 136;
    LAS bf16_t* Ks = (LAS bf16_t*)(c.lds); LAS bf16_t* Vn = (LAS bf16_t*)(c.lds + 69632);
    {
        const int key = tid >> 1, half = tid & 1; const float* kp = c.out + O_MKP + ((size_t)(b * 256 + key) * 4 + head) * 128 + half * 64; const float* vp = c.out + O_MVP + ((size_t)(b * 256 + key) * 4 + head) * 128 + half * 64;
#pragma unroll
        for (int i = 0; i < 8; ++i) { const f32x4 a = *(const f32x4*)(kp + 8 * i), bb = *(const f32x4*)(kp + 8 * i + 4); u32x4 q; q.x = pk2(a.x, a.y); q.y = pk2(a.z, a.w); q.z = pk2(bb.x, bb.y); q.w = pk2(bb.z, bb.w);
            *(LAS u32x4*)(Ks + key * KP + half * 64 + 8 * i) = q; }
#pragma unroll
        for (int i = 0; i < 8; ++i) { const f32x4 a = *(const f32x4*)(vp + 8 * i), bb = *(const f32x4*)(vp + 8 * i + 4); u32x4 q; q.x = pk2(a.x, a.y); q.y = pk2(a.z, a.w); q.z = pk2(bb.x, bb.y); q.w = pk2(bb.z, bb.w);
            *(LAS u32x4*)(Vn + key * VP + half * 64 + 8 * i) = q; }
    }
    __syncthreads();
    const bf16_t* QC = (const bf16_t*)(c.ws + WS_QC); bf16_t* OC = (bf16_t*)(c.ws + WS_OC);
    const size_t row = (size_t)b * SEQ + qb * 128 + 16 * w + fr;
    bf16x8 qf[4];
    { float f[32]; float sq = 0.f;
#pragma unroll
        for (int kk = 0; kk < 4; ++kk) unpack8(*(const u32x4*)(QC + row * DXA + head * 128 + kk * 32 + fq * 8), f + 8 * kk);
#pragma unroll
        for (int i = 0; i < 32; ++i) sq += f[i] * f[i];
        sq += __shfl_xor(sq, 16); sq += __shfl_xor(sq, 32); const float rs = rsqrtf(sq * (1.f / 128.f) + EPS) * 0.08838834764831845f;
#pragma unroll
        for (int kk = 0; kk < 4; ++kk) { const float* qg = IN_(I_CQG) + kk * 32 + fq * 8; u32x4 q; q.x = pk2(f[8 * kk] * rs * qg[0], f[8 * kk + 1] * rs * qg[1]); q.y = pk2(f[8 * kk + 2] * rs * qg[2], f[8 * kk + 3] * rs * qg[3]);
            q.z = pk2(f[8 * kk + 4] * rs * qg[4], f[8 * kk + 5] * rs * qg[5]); q.w = pk2(f[8 * kk + 6] * rs * qg[6], f[8 * kk + 7] * rs * qg[7]); qf[kk] = __builtin_bit_cast(bf16x8, q); } }
    f32x4 S[16];
#pragma unroll
    for (int ni = 0; ni < 16; ++ni) S[ni] = (f32x4){0.f, 0.f, 0.f, 0.f};
#pragma unroll
    for (int ni = 0; ni < 16; ++ni)
#pragma unroll
        for (int kk = 0; kk < 4; ++kk) { __builtin_amdgcn_sched_barrier(0); const bf16x8 bf = *(const LAS bf16x8*)(Ks + (16 * ni + fr) * KP + kk * 32 + fq * 8); S[ni] = MFMA16(bf, qf[kk], S[ni]); }
    float mx = -1e30f;
#pragma unroll
    for (int ni = 0; ni < 16; ++ni)
#pragma unroll
        for (int j = 0; j < 4; ++j) mx = fmaxf(mx, S[ni][j]);
    mx = fmaxf(mx, __shfl_xor(mx, 16)); mx = fmaxf(mx, __shfl_xor(mx, 32));
    float sm = 0.f;
#pragma unroll
    for (int ni = 0; ni < 16; ++ni)
#pragma unroll
        for (int j = 0; j < 4; ++j) { const float p = __expf(S[ni][j] - mx); S[ni][j] = p; sm += p; }
    sm += __shfl_xor(sm, 16); sm += __shfl_xor(sm, 32); const float inv = 1.f / sm;
    f32x4 O[8];
#pragma unroll
    for (int nd = 0; nd < 8; ++nd) O[nd] = (f32x4){0.f, 0.f, 0.f, 0.f};
#pragma unroll
    for (int k2 = 0; k2 < 8; ++k2) { __builtin_amdgcn_sched_barrier(0); u32x4 pa; pa.x = pk2(S[2 * k2][0], S[2 * k2][1]); pa.y = pk2(S[2 * k2][2], S[2 * k2][3]); pa.z = pk2(S[2 * k2 + 1][0], S[2 * k2 + 1][1]); pa.w = pk2(S[2 * k2 + 1][2], S[2 * k2 + 1][3]);
        const bf16x8 af = __builtin_bit_cast(bf16x8, pa);
#pragma unroll
        for (int nd = 0; nd < 8; ++nd) { const LAS bf16_t* vp = Vn + (32 * k2 + 4 * fq + (fr >> 2)) * VP + 16 * nd + 4 * (fr & 3);
            O[nd] = MFMA16(cat8(vtr(vp), vtr(vp + 16 * VP)), af, O[nd]); } }
#pragma unroll
    for (int nd = 0; nd < 8; ++nd) { const f32x4 o = O[nd] * inv; u32x2 wv; wv.x = pk2(o[0], o[1]); wv.y = pk2(o[2], o[3]); *(u32x2*)(OC + row * DXA + head * 128 + 16 * nd + 4 * fq) = wv; }
    __syncthreads();
}
DI void xattn_sample_pair(const Ctx& c, int P) {
    int tid_ = c.tid; asm volatile("" : "+v"(tid_)); const int tid = tid_, lane = tid & 63, w = __builtin_amdgcn_readfirstlane(tid >> 6);
    const int combo = 2 * P + (w >> 2), q4 = w & 3, b = combo >> 2, head = combo & 3;
    LAS float* qs = (LAS float*)(c.lds + w * 4096); LAS float* ps = qs + 128; LAS float* po = qs + 192; LAS float* pm = qs + 320;
    const bf16_t* QC = (const bf16_t*)(c.ws + WS_QC); bf16_t* OC = (bf16_t*)(c.ws + WS_OC);
    const unsigned qw = *(const unsigned*)(QC + (size_t)(MP + b) * DXA + head * 128 + 2 * lane); const float q0 = bflo(qw), q1 = bfhi(qw);
    const float rs = rsqrtf(wave_sum(q0 * q0 + q1 * q1) * (1.f / 128.f) + EPS) * 0.08838834764831845f; const f32x2 gg = ((const f32x2*)IN_(I_CQG))[lane];
    qs[2 * lane] = q0 * rs * gg.x; qs[2 * lane + 1] = q1 * rs * gg.y;
    LDS_FENCE();
    const int m0 = 64 * q4;
    float lg;
    { const float* kr = IN_(I_CMK) + ((size_t)(b * 256 + m0 + lane) * 4 + head) * 128; float a = 0.f;
#pragma unroll 1
        for (int d0 = 0; d0 < 32; d0 += 8) { f32x4 kv[8];
#pragma unroll
            for (int i = 0; i < 8; ++i) kv[i] = *(const f32x4*)(kr + 4 * (d0 + i));
#pragma unroll
            for (int i = 0; i < 8; ++i) { const f32x4 qv = *(const LAS f32x4*)(qs + 4 * (d0 + i)); a += (kv[i].x * qv.x + kv[i].y * qv.y) + (kv[i].z * qv.z + kv[i].w * qv.w); } }
        lg = a; }
    const float mx = wave_max(lg); const float p = __expf(lg - mx); const float sm = wave_sum(p);
    ps[lane] = p; if (lane == 0) { pm[0] = mx; pm[1] = sm; }
    LDS_FENCE();
    { float o0 = 0.f, o1 = 0.f; const float* vr = IN_(I_CMV) + ((size_t)(b * 256 + m0) * 4 + head) * 128 + 2 * lane;
#pragma unroll 1
        for (int i0 = 0; i0 < 64; i0 += 16) { f32x2 v[16];
#pragma unroll
            for (int i = 0; i < 16; ++i) v[i] = *(const f32x2*)(vr + (size_t)(i0 + i) * 512);
#pragma unroll
            for (int i = 0; i < 16; ++i) { const float pp = ps[i0 + i]; o0 += pp * v[i].x; o1 += pp * v[i].y; } }
        po[2 * lane] = o0; po[2 * lane + 1] = o1; }
    __syncthreads();
    if (q4 == 0) {
        float m[4], sm4[4]; float M = -1e30f;
#pragma unroll
        for (int j = 0; j < 4; ++j) { const LAS float* qj = qs + j * 1024; m[j] = qj[320]; sm4[j] = qj[321]; M = fmaxf(M, m[j]); }
        float S = 0.f, o0 = 0.f, o1 = 0.f;
#pragma unroll
        for (int j = 0; j < 4; ++j) { const float e = __expf(m[j] - M); S += sm4[j] * e; o0 += (qs + j * 1024)[192 + 2 * lane] * e; o1 += (qs + j * 1024)[192 + 2 * lane + 1] * e; }
        const float inv = 1.f / S;
        *(unsigned*)(OC + (size_t)(MP + b) * DXA + head * 128 + 2 * lane) = pk2(o0 * inv, o1 * inv);
    }
    __syncthreads();
}

DI void p8_convgate(const Ctx& c) {
    const bf16_t* U = (const bf16_t*)(c.ws + WS_USMP) - (size_t)MP * DFF2;
    bf16_t* H = (bf16_t*)(c.ws + WS_H);
    const float* UF = (const float*)(c.ws + WS_UF); const float* UL = (const float*)(c.ws + WS_UL);
    const float* fw = IN_(I_FCW); const float* fb = IN_(I_FCB);
    for (int i = c.bid * 512 + c.tid; i < 31 * 2 * (DFF / 4); i += c.G * 512) { const int j4 = (i % (DFF / 4)) * 4, rr = (i / (DFF / 4)) & 1, pm = 1 + i / (2 * (DFF / 4));
        if ((pm & 7) == 0) continue;
        const size_t row = (size_t)pm * 256 + rr; float o[4];
#pragma unroll
        for (int hf = 0; hf < 2; ++hf) { const int col = hf * DFF + j4;
            const f32x4 ut = *(const f32x4*)(UF + (size_t)(pm * 2 + rr) * DFF2 + col);
            const f32x4 u1 = rr ? *(const f32x4*)(UF + (size_t)(pm * 2) * DFF2 + col) : *(const f32x4*)(UL + (size_t)((pm - 1) * 2 + 1) * DFF2 + col);
            const f32x4 u2 = rr ? *(const f32x4*)(UL + (size_t)((pm - 1) * 2 + 1) * DFF2 + col) : *(const f32x4*)(UL + (size_t)((pm - 1) * 2) * DFF2 + col);
            const f32x4 cv = *(const f32x4*)(fb + col) + *(const f32x4*)(fw + col) * u2 + *(const f32x4*)(fw + DFF2 + col) * u1 + *(const f32x4*)(fw + 2 * DFF2 + col) * ut;
#pragma unroll
            for (int j = 0; j < 4; ++j) o[j] = hf == 0 ? silu_f(cv[j]) : o[j] * cv[j]; }
        u32x2 q; q.x = pk2(o[0], o[1]); q.y = pk2(o[2], o[3]); *(u32x2*)(H + row * DFF + j4) = q; }
    for (int i = c.bid * 512 + c.tid; i < MS * 704; i += c.G * 512) { const int b = i / 704, j8 = i % 704; const size_t row = MP + b; const float* st = IN_(I_SFC) + (size_t)b * 2 * DFF2; float* fo = c.out + O_FCS + (size_t)b * 2 * DFF2;
        float g3[8], v3[8], o[8]; const bf16_t* up = U + row * DFF2 + j8 * 8; unpack8(*(const u32x4*)up, g3); unpack8(*(const u32x4*)(up + DFF), v3);
#pragma unroll
        for (int j = 0; j < 8; ++j) { const int cg_ = j8 * 8 + j, cv_ = DFF + cg_; const float g1 = st[cg_], g2 = st[DFF2 + cg_], v1 = st[cv_], v2 = st[DFF2 + cv_];
            const float cgv = fb[cg_] + fw[cg_] * g1 + fw[DFF2 + cg_] * g2 + fw[2 * DFF2 + cg_] * g3[j], cvv = fb[cv_] + fw[cv_] * v1 + fw[DFF2 + cv_] * v2 + fw[2 * DFF2 + cv_] * v3[j];
            o[j] = silu_f(cgv) * cvv; fo[cg_] = g2; fo[cv_] = v2; fo[DFF2 + cg_] = g3[j]; fo[DFF2 + cv_] = v3[j]; }
        u32x4 q; q.x = pk2(o[0], o[1]); q.y = pk2(o[2], o[3]); q.z = pk2(o[4], o[5]); q.w = pk2(o[6], o[7]); *(u32x4*)(H + row * DFF + j8 * 8) = q; }
}

struct Skinny { const bf16_t* A; const bf16_t* Bt; int K; int ksplit; const float* ssq_in; const float* base; const bf16_t* baseB; float* out; bf16_t* abf; float* ssq; };
DI void skinny_tile(const Ctx& c, const Skinny& g, int ct) {
    int tid_ = c.tid; asm volatile("" : "+v"(tid_)); const int tid = tid_, lane = tid & 63, w = __builtin_amdgcn_readfirstlane(tid >> 6), fr = lane & 15, fq = lane >> 4;
    const int K = g.K, kw = K >> 3, k0 = w * kw;
    f32x4 acc[8];
#pragma unroll
    for (int mi = 0; mi < 8; ++mi) acc[mi] = (f32x4){0.f, 0.f, 0.f, 0.f};
    const bf16_t* ap = g.A + (size_t)fr * K + k0 + fq * 8; const bf16_t* bp = g.Bt + (size_t)(16 * ct + fr) * K + k0 + fq * 8;
#pragma unroll 2
    for (int ks = 0; ks < kw; ks += 32) {
        if (k0 + ks == g.ksplit && ks != 0) {
#pragma unroll
            for (int mi = 0; mi < 8; ++mi) acc[mi] = acc[mi] * rsqrtf(g.ssq_in[16 * mi + fr] * (1.f / 2048.f) + EPS);
        }
        const bf16x8 bf = *(const bf16x8*)(bp + ks);
#pragma unroll
        for (int mi = 0; mi < 8; ++mi) { const bf16x8 af = *(const bf16x8*)(ap + (size_t)mi * 16 * K + ks); acc[mi] = MFMA16(bf, af, acc[mi]); }
    }
    if (k0 + kw <= g.ksplit) {
#pragma unroll
        for (int mi = 0; mi < 8; ++mi) acc[mi] = acc[mi] * rsqrtf(g.ssq_in[16 * mi + fr] * (1.f / 2048.f) + EPS);
    }
    LAS f32x4* red = (LAS f32x4*)c.lds;
#pragma unroll
    for (int mi = 0; mi < 8; ++mi) red[(w * 8 + mi) * 64 + lane] = acc[mi];
    __syncthreads();
    f32x4 sum = (f32x4){0.f, 0.f, 0.f, 0.f};
#pragma unroll
    for (int ww = 0; ww < 8; ++ww) sum = sum + red[(ww * 8 + w) * 64 + lane];
    const int row = 16 * w + fr, col = 16 * ct + 4 * fq;
    f32x4 bs;
    if (g.baseB) { const u32x2 r = *(const u32x2*)(g.baseB + (size_t)row * DM + col); bs = (f32x4){bflo(r.x), bfhi(r.x), bflo(r.y), bfhi(r.y)}; } else bs = *(const f32x4*)(g.base + (size_t)row * DM + col);
    const f32x4 o = bs + sum;
    if (g.out) *(f32x4*)(g.out + (size_t)row * DM + col) = o;
    if (g.abf) { u32x2 wv; wv.x = pk2(o[0], o[1]); wv.y = pk2(o[2], o[3]); *(u32x2*)(g.abf + (size_t)row * DM + col) = wv;
        float sq = (o[0] * o[0] + o[1] * o[1]) + (o[2] * o[2] + o[3] * o[3]); sq += __shfl_xor(sq, 16); sq += __shfl_xor(sq, 32); if (fq == 0) atomicAdd(g.ssq + row, sq); }
    __syncthreads();
}

__global__ void __launch_bounds__(512, 2) fwd_mega(Args args) {
    extern __shared__ __attribute__((aligned(16))) unsigned char lds_raw[];
    cg::grid_group grid = cg::this_grid();
    Ctx c; c.lds = (LAS unsigned char*)lds_raw; c.tid = threadIdx.x; c.lane = c.tid & 63; c.wave = __builtin_amdgcn_readfirstlane(c.tid >> 6); c.G = gridDim.x; c.bid = blockIdx.x;
    c.in = args.in; c.out = args.out; c.ws = args.ws; c.dry = 0;
    unsigned char* ws = args.ws;
    const int lo = args.ph_lo, hi = args.ph_hi;
#ifndef PHMASK
#define PHMASK 0x3ff
#endif
#define PH(k) ((((PHMASK) >> (k)) & 1) && lo <= (k) && (k) < hi)
    volatile LAS unsigned* bst = (volatile LAS unsigned*)(c.lds + LDS_BYTES - 64);
    if (c.tid < 2) bst[c.tid] = 0u;
    __syncthreads();
    XcdBarrier xbar = xcd_barrier_post((unsigned*)(ws + WS_BAR), bst);
    if (lo > 1000) grid.sync();
#define GSYNC() xcd_barrier(xbar)
#define SYNC(k) do { if (PH(k) && PH((k) + 1)) GSYNC(); } while (0)
#ifndef REPEAT_MASK
#define REPEAT_MASK 0
#endif
#define REP(k) (((REPEAT_MASK) >> (k)) & 1)
    float* SSQ = (float*)(ws + WS_SSQ);
    if (PH(0)) p0_prologue(c);
    if (REP(0)) { GSYNC(); p0_prologue(c); }
    SYNC(0);
    if (PH(1)) {
        { pg8::Gemm g{(const bf16_t*)(ws + WS_A0), (const bf16_t*)(ws + WS_WIN), MPAD, DINP, 2048}; pg8::StaticOrder S; S.init(MPAD, DINP, c.G, c.bid);
            EpiProj E{(bf16_t*)(ws + WS_PROJ), (float*)(ws + WS_DT), 0}; pg8::gemm_phase(c.lds, g, S, E); }
        { pg8::Gemm g{(const bf16_t*)(ws + WS_MEMN), (const bf16_t*)(ws + WS_WCKV), 1024, 1024, 2048}; pg8::StaticOrder S; S.init(1024, 1024, c.G, c.G - 1 - c.bid);
            EpiMem E{c.out + O_MKP, c.out + O_MVP, 0}; pg8::gemm_phase(c.lds, g, S, E); }
    }
    SYNC(1);
    if (PH(2)) { p1b_conv(c); GSYNC(); }
    if (PH(2)) p2_mixers(c);
    if (REP(2)) { GSYNC(); c.dry = 1; p2_mixers(c); c.dry = 0; }
    SYNC(2);
    if (PH(3)) { pg8::Gemm g{(const bf16_t*)(ws + WS_MIX), (const bf16_t*)(ws + WS_WOUT), MP, 2048, 3072}; pg8::StaticOrder S; S.init(MP, 2048, c.G, c.bid);
        EpiRes<true> E{IN_(I_XP), IN_(I_XS), nullptr, nullptr, nullptr, (bf16_t*)(ws + WS_A0), SSQ + MPAD, SSQ, 32}; pg8::gemm_phase(c.lds, g, S, E);
        const Skinny sk{(const bf16_t*)(ws + WS_MIX) + (size_t)MP * DMIX, (const bf16_t*)(ws + WS_WOUT), 3072, 2048, SSQ + MP, IN_(I_XS), nullptr, nullptr, (bf16_t*)(ws + WS_A0) + (size_t)MP * DM, SSQ + MPAD + MP};
        for (int t = c.bid; t < 256; t += c.G) if ((t & 1) == 0) skinny_tile(c, sk, t >> 1); }
    SYNC(3);
    if (PH(4)) { pg8::Gemm g{(const bf16_t*)(ws + WS_A0), (const bf16_t*)(ws + WS_WCQ), MPAD, 512, 2048}; pg8::StaticOrder S; S.init(MPAD, 512, c.G, c.bid);
        EpiScale E{(bf16_t*)(ws + WS_QC), DXA, SSQ + MPAD, 0}; pg8::gemm_phase(c.lds, g, S, E);
        constexpr int NT3 = (MPAD / 256) * 2;
        if (c.G == 256 && c.bid >= NT3) p0_transposes(c, TT_P4_START, TT_ALL, c.bid - NT3, c.G - NT3); }
    SYNC(4);
    for (int rep = 0; rep < 1 + REP(5); ++rep) if (PH(5)) {
        if (rep) GSYNC();
        for (int u = c.bid; u < 256; u += c.G) xattn_prompt_unit(c, u);
        for (int u = c.bid; u < 256; u += c.G) xattn_sample_pair(c, u);
    }
    SYNC(5);
    if (PH(6)) { pg8::Gemm g{(const bf16_t*)(ws + WS_OC), (const bf16_t*)(ws + WS_WCO), MP, 2048, 512}; pg8::StaticOrder S; S.init(MP, 2048, c.G, c.bid);
        bf16_t* XB = (bf16_t*)(ws + WS_A0);
        EpiRes<false> E{nullptr, nullptr, XB, nullptr, nullptr, XB, SSQ + 2 * MPAD, nullptr, 0}; pg8::gemm_phase(c.lds, g, S, E);
        const Skinny sk{(const bf16_t*)(ws + WS_OC) + (size_t)MP * DXA, (const bf16_t*)(ws + WS_WCO), 512, -1, nullptr, nullptr, XB + (size_t)MP * DM, nullptr, XB + (size_t)MP * DM, SSQ + 2 * MPAD + MP};
        for (int t = c.bid; t < 256; t += c.G) if ((t & 1) == 0) skinny_tile(c, sk, t >> 1); }
    SYNC(6);
    if (PH(7)) { pg8::Gemm g{(const bf16_t*)(ws + WS_A0), (const bf16_t*)(ws + WS_WUP), MPAD, DFF2, 2048}; pg8::StaticOrder S; S.init(MPAD, DFF2, c.G, c.bid);
        EpiGate E{(bf16_t*)(ws + WS_H), SSQ + 2 * MPAD, IN_(I_FCW), IN_(I_FCB), (float*)(ws + WS_UF), (float*)(ws + WS_UL), (bf16_t*)(ws + WS_USMP), c.out + O_FCP, (LAS float*)(c.lds + 131072), 0}; pg8::gemm_phase(c.lds, g, S, E); }
    SYNC(7);
    if (PH(8)) p8_convgate(c);
    if (REP(8)) { GSYNC(); p8_convgate(c); }
    SYNC(8);
#ifdef EXTRA_SYNCS
    for (int i = 0; i < EXTRA_SYNCS; ++i) GSYNC();
#endif
    if (PH(9)) { pg8::Gemm g{(const bf16_t*)(ws + WS_H), (const bf16_t*)(ws + WS_WDN), MP, 2048, DFF}; pg8::StaticOrder S; S.init(MP, 2048, c.G, c.bid);
        const bf16_t* XB = (const bf16_t*)(ws + WS_A0);
        EpiRes<false> E{nullptr, nullptr, XB, c.out + O_Y, c.out + O_YS, nullptr, nullptr, nullptr, 0}; pg8::gemm_phase(c.lds, g, S, E);
        const Skinny sk{(const bf16_t*)(ws + WS_H) + (size_t)MP * DFF, (const bf16_t*)(ws + WS_WDN), DFF, -1, nullptr, nullptr, XB + (size_t)MP * DM, c.out + O_YS, nullptr, nullptr};
        for (int t = c.bid; t < 256; t += c.G) if ((t & 1) == 0) skinny_tile(c, sk, t >> 1); }
}

extern "C" void kernel_launch(void* const* d_in, const int* in_sizes, int n_in, void* d_out, int out_size, void* d_ws, size_t ws_size, hipStream_t stream) {
    static int grid = 0;
    if (grid == 0) {
        if (n_in != 35 || (size_t)out_size != O_END || ws_size < WS_END) { fprintf(stderr, "kernel_launch: unexpected shapes n_in %d out %d ws %zu (need %zu)\n", n_in, out_size, ws_size, (size_t)WS_END); grid = -1; return; }
        int dev = 0, cus = 0, per_cu = 0;
        hipGetDevice(&dev);
        hipDeviceGetAttribute(&cus, hipDeviceAttributeMultiprocessorCount, dev);
        hipFuncSetAttribute((const void*)fwd_mega, hipFuncAttributeMaxDynamicSharedMemorySize, LDS_BYTES);
        hipOccupancyMaxActiveBlocksPerMultiprocessor(&per_cu, (const void*)fwd_mega, 512, LDS_BYTES);
        if (per_cu < 1) fprintf(stderr, "kernel_launch: occupancy query says %d blocks/CU\n", per_cu);
        grid = cus;
    }
    if (grid < 0) return;
    if (hipMemsetAsync((char*)d_ws + WS_BAR, 0, WS_BAR_BYTES, stream) != hipSuccess) { fprintf(stderr, "kernel_launch: hipMemsetAsync failed\n"); return; }
    Args a{};
    for (int i = 0; i < 35; ++i) a.in[i] = (const float*)d_in[i];
    a.out = (float*)d_out; a.ws = (unsigned char*)d_ws; a.ph_lo = 0; a.ph_hi = 10;
    void* args[] = {&a};
    hipError_t e = hipLaunchCooperativeKernel((const void*)fwd_mega, dim3(grid), dim3(512), args, LDS_BYTES, stream);
    if (e != hipSuccess) fprintf(stderr, "cooperative launch failed: %s (grid %d)\n", hipGetErrorString(e), grid);
}
```
